# Optimizing an MI355X kernel written in HIP

```python
import math
import jax
import jax.numpy as jnp
from jax import lax
import numpy as np

D_MODEL = 1024
BATCH = 8
SEQ = 4096
DEPTH = 2

GRID_W = 64
CTX_LEN = 256
HEAD_DIM = 64
MIX_HEADS = D_MODEL // HEAD_DIM
A_Q_HEADS = MIX_HEADS // 2
A_KV_HEADS = A_Q_HEADS // 4
B_Q_HEADS = MIX_HEADS - A_Q_HEADS
B_KV_HEADS = B_Q_HEADS // 4
WINDOW = 128
BLOCK = 128
NA_ROWS = 8
NA_COLS = 16
NA_QCOLS = 16
NA_KCOLS = NA_QCOLS + NA_COLS
C_HEADS = D_MODEL // (2 * HEAD_DIM)
C_V_DIM = 2 * HEAD_DIM
D_FF = 4 * D_MODEL
ROPE_THETA = 10000.0
EPS = 1e-6

A_QW = A_Q_HEADS * HEAD_DIM
A_KVW = A_KV_HEADS * HEAD_DIM
B_QW = B_Q_HEADS * HEAD_DIM
B_KVW = B_KV_HEADS * HEAD_DIM
EVEN_WIDTHS = (A_QW, A_KVW, A_KVW, B_QW, B_KVW, B_KVW)
EVEN_IN = A_QW + 2 * A_KVW + B_QW + 2 * B_KVW
EVEN_OUT = A_QW + B_QW
C_QKW = C_HEADS * 2 * HEAD_DIM
C_VW = C_HEADS * C_V_DIM
ODD_IN = 2 * C_QKW + C_VW

kernel_name = 'hybrid_dit_window_natten_diffattn'


def _rms_norm(x, g):
    xf = x.astype(jnp.float32)
    y = xf * lax.rsqrt(jnp.mean(xf * xf, axis=-1, keepdims=True) + EPS)
    return (y * g.astype(jnp.float32)).astype(x.dtype)


def _modulate(x, g, shift, scale):
    return _rms_norm(x, g) * (1 + scale) + shift


def _rope_tables(n):
    t = jnp.arange(n, dtype=jnp.int32)
    row = (t // GRID_W).astype(jnp.float32)
    col = (t % GRID_W).astype(jnp.float32)
    quarter = HEAD_DIM // 4
    inv_freq = ROPE_THETA ** (-jnp.arange(quarter, dtype=jnp.float32) / quarter)
    ar = row[:, None] * inv_freq[None, :]
    ac = col[:, None] * inv_freq[None, :]
    ang = jnp.concatenate([ar, ar, ac, ac], axis=-1)
    return jnp.cos(ang), jnp.sin(ang)


def _apply_rope(x, cos, sin):
    xs = x.reshape(x.shape[:-1] + (2, 2, HEAD_DIM // 4))
    rot = jnp.stack([-xs[..., 1, :], xs[..., 0, :]], axis=-2).reshape(x.shape)
    return x * cos[:, None, :].astype(x.dtype) + rot * sin[:, None, :].astype(x.dtype)


def _ctx_attn(q, k, v, sink):
    b, n, hq, d = q.shape
    hkv = k.shape[2]
    g = hq // hkv
    qg = q.reshape(b, n, hkv, g, d)
    s = jnp.einsum('bqhgd,bkhd->bhgqk', qg, k).astype(jnp.float32) * d ** -0.5
    if sink is not None:
        sk = jnp.broadcast_to(sink.astype(jnp.float32).reshape(1, hkv, g, 1, 1), s.shape[:-1] + (1,))
        s = jnp.concatenate([s, sk], axis=-1)
    p = jax.nn.softmax(s, axis=-1)[..., :n].astype(v.dtype)
    return jnp.einsum('bhgqk,bkhd->bqhgd', p, v).reshape(b, n, hq * d)


def _window_attn(q, k, v, kc, vc, sink):
    b, n, hq, d = q.shape
    hkv = k.shape[2]
    g = hq // hkv
    nb = n // BLOCK
    qb = q.reshape(b, nb, BLOCK, hkv, g, d)
    pad = ((0, 0), (BLOCK, BLOCK), (0, 0), (0, 0))

    def band(t):
        tp = jnp.pad(t, pad).reshape(b, nb + 2, BLOCK, hkv, d)
        return jnp.concatenate([tp[:, :-2], tp[:, 1:-1], tp[:, 2:]], axis=2)

    kb, vb = band(k), band(v)
    scale = d ** -0.5
    s_lat = jnp.einsum('bnqhgd,bnkhd->bhgnqk', qb, kb).astype(jnp.float32) * scale
    blk = jnp.arange(nb)[:, None, None] * BLOCK
    qpos = blk + jnp.arange(BLOCK)[None, :, None]
    kpos = blk - BLOCK + jnp.arange(3 * BLOCK)[None, None, :]
    valid = (jnp.abs(qpos - kpos) <= WINDOW) & (kpos >= 0) & (kpos < n)
    s_lat = jnp.where(valid, s_lat, -jnp.inf)
    s_ctx = jnp.einsum('bnqhgd,bchd->bhgnqc', qb, kc).astype(jnp.float32) * scale
    s_sink = jnp.broadcast_to(sink.astype(jnp.float32).reshape(1, hkv, g, 1, 1, 1), s_ctx.shape[:-1] + (1,))
    p = jax.nn.softmax(jnp.concatenate([s_lat, s_ctx, s_sink], axis=-1), axis=-1).astype(v.dtype)
    nk, nc = 3 * BLOCK, kc.shape[1]
    out = (jnp.einsum('bhgnqk,bnkhd->bnqhgd', p[..., :nk], vb)
           + jnp.einsum('bhgnqc,bchd->bnqhgd', p[..., nk:nk + nc], vc))
    return out.reshape(b, n, hq * d)


def _neighbourhood_attn(q, k, v, kc, vc, rpb):
    b, n, hq, d = q.shape
    hkv = k.shape[2]
    g = hq // hkv
    rows = n // GRID_W
    kr = min(NA_ROWS, rows)
    ncb = GRID_W // NA_QCOLS
    nkey = kr * NA_KCOLS
    r = jnp.arange(rows)
    row_idx = jnp.clip(r - kr // 2, 0, rows - kr)[:, None] + jnp.arange(kr)[None, :]
    m = jnp.arange(ncb)
    col_idx = jnp.clip(m * NA_QCOLS - NA_COLS // 2, 0, GRID_W - NA_KCOLS)[:, None] + jnp.arange(NA_KCOLS)[None, :]
    qcol = m[:, None] * NA_QCOLS + jnp.arange(NA_QCOLS)[None, :]
    cstart = jnp.clip(qcol - NA_COLS // 2, 0, GRID_W - NA_COLS)
    kcol = col_idx[:, None, :]
    col_ok = (kcol >= cstart[..., None]) & (kcol < cstart[..., None] + NA_COLS)
    mask = jnp.broadcast_to(col_ok[:, :, None, :], (ncb, NA_QCOLS, kr, NA_KCOLS)).reshape(ncb, NA_QCOLS, nkey)

    def gather(t):
        tg = t.reshape(b, rows, GRID_W, hkv, d)
        tb = tg[:, row_idx[:, None, :, None], col_idx[None, :, None, :]]
        return tb.reshape(b, rows, ncb, nkey, hkv, d)

    kb, vb = gather(k), gather(v)
    roff = row_idx - r[:, None] + (NA_ROWS - 1)
    coff = jnp.clip(kcol - qcol[..., None], 1 - NA_COLS, NA_COLS - 1) + (NA_COLS - 1)
    bias = rpb[:, roff[:, :, None, None, None], coff[None, None]]
    bias = jnp.transpose(bias, (0, 1, 3, 4, 2, 5)).reshape(hkv, g, rows, ncb, NA_QCOLS, nkey).astype(jnp.float32)
    qb = q.reshape(b, rows, ncb, NA_QCOLS, hkv, g, d)
    scale = d ** -0.5
    s_nb = jnp.einsum('brmqhgd,brmkhd->bhgrmqk', qb, kb).astype(jnp.float32) * scale + bias
    s_nb = jnp.where(mask, s_nb, -jnp.inf)
    s_ctx = jnp.einsum('brmqhgd,bchd->bhgrmqc', qb, kc).astype(jnp.float32) * scale
    p = jax.nn.softmax(jnp.concatenate([s_nb, s_ctx], axis=-1), axis=-1).astype(v.dtype)
    out = (jnp.einsum('bhgrmqk,brmkhd->brmqhgd', p[..., :nkey], vb)
           + jnp.einsum('bhgrmqc,bchd->brmqhgd', p[..., nkey:], vc))
    return out.reshape(b, n, hq * d)


def _split_even(p):
    b, n, _ = p.shape
    idx = np.cumsum(EVEN_WIDTHS)[:-1].tolist()
    parts = jnp.split(p, idx, axis=-1)
    return [t.reshape(b, n, -1, HEAD_DIM) for t in parts]


def _even_mixer(hx, hc, w_in, w_out, sink, rpb, cos, sin, with_ctx):
    aq, ak, av, bq, bk, bv = _split_even(hx @ w_in)
    caq, cak, cav, cbq, cbk, cbv = _split_even(hc @ w_in)
    aq = _apply_rope(aq, cos, sin)
    ak = _apply_rope(ak, cos, sin)
    ya = _window_attn(aq, ak, av, cak, cav, sink)
    yb = _neighbourhood_attn(bq, bk, bv, cbk, cbv, rpb)
    y_x = jnp.concatenate([ya, yb], axis=-1) @ w_out
    if not with_ctx:
        return y_x, None
    y_c = jnp.concatenate([_ctx_attn(caq, cak, cav, sink), _ctx_attn(cbq, cbk, cbv, None)], axis=-1) @ w_out
    return y_x, y_c


def _split_odd(p):
    b, n, _ = p.shape
    q, k, v = jnp.split(p, [C_QKW, 2 * C_QKW], axis=-1)
    return (q.reshape(b, n, C_HEADS, 2, HEAD_DIM), k.reshape(b, n, C_HEADS, 2, HEAD_DIM),
            v.reshape(b, n, C_HEADS, C_V_DIM))


def _diff_core(q, k, v, lam, sub_g, lam_init):
    b, nq, h, _, d = q.shape
    s = jnp.einsum('bqhmd,bkhmd->bhmqk', q, k).astype(jnp.float32) * d ** -0.5
    p = jax.nn.softmax(s, axis=-1)
    a = (p[:, :, 0] - lam * p[:, :, 1]).astype(v.dtype)
    o = jnp.einsum('bhqk,bkhe->bqhe', a, v)
    o = _rms_norm(o, sub_g) * (1.0 - lam_init)
    return o.reshape(b, nq, h * v.shape[-1])


def _odd_mixer(hx, hc, w_in, w_out, lq1, lk1, lq2, lk2, sub_g, lam_init, cos, sin, with_ctx):
    q, k, v = _split_odd(hx @ w_in)
    cq, ck, cv = _split_odd(hc @ w_in)
    b, n = q.shape[:2]
    q = _apply_rope(q.reshape(b, n, 2 * C_HEADS, HEAD_DIM), cos, sin).reshape(q.shape)
    k = _apply_rope(k.reshape(b, n, 2 * C_HEADS, HEAD_DIM), cos, sin).reshape(k.shape)
    f32 = jnp.float32
    lam = (jnp.exp(jnp.sum(lq1.astype(f32) * lk1.astype(f32)))
           - jnp.exp(jnp.sum(lq2.astype(f32) * lk2.astype(f32))) + lam_init)
    kf = jnp.concatenate([k, ck], axis=1)
    vf = jnp.concatenate([v, cv], axis=1)
    nb = n // BLOCK
    qb = jnp.swapaxes(q.reshape(b, nb, BLOCK, C_HEADS, 2, HEAD_DIM), 0, 1)
    yx = lax.map(lambda qblk: _diff_core(qblk, kf, vf, lam, sub_g, lam_init), qb)
    yx = jnp.swapaxes(yx, 0, 1).reshape(b, n, C_VW) @ w_out
    if not with_ctx:
        return yx, None
    yc = _diff_core(cq, ck, cv, lam, sub_g, lam_init) @ w_out
    return yx, yc


def _mlp(h, w1, w2):
    a = jax.nn.relu(h @ w1)
    return (a * a) @ w2


def setup_inputs(seed: int = 0) -> dict:
    key = jax.random.key(seed)
    ks = jax.random.split(key, 22)
    n_even = (DEPTH + 1) // 2
    n_odd = DEPTH // 2

    def nrm(k, shape, s):
        return jax.random.normal(k, shape, jnp.float32) * s

    return {
        'x': nrm(ks[0], (BATCH, SEQ, D_MODEL), 1.0),
        'c': nrm(ks[1], (BATCH, D_MODEL), 1.0),
        'ctx': nrm(ks[2], (BATCH, CTX_LEN, D_MODEL), 1.0),
        'c_ctx': nrm(ks[3], (D_MODEL,), 1.0),
        'ada_w': nrm(ks[4], (DEPTH, D_MODEL, 6 * D_MODEL), 0.5 * D_MODEL ** -0.5),
        'ada_b': nrm(ks[5], (DEPTH, 6 * D_MODEL), 0.01),
        'norm1_g': 1.0 + nrm(ks[6], (DEPTH, D_MODEL), 0.05),
        'norm2_g': 1.0 + nrm(ks[7], (DEPTH, D_MODEL), 0.05),
        'even_w_in': nrm(ks[8], (n_even, D_MODEL, EVEN_IN), D_MODEL ** -0.5),
        'even_w_out': nrm(ks[9], (n_even, EVEN_OUT, D_MODEL), EVEN_OUT ** -0.5),
        'a_sink': nrm(ks[10], (n_even, A_Q_HEADS), 0.5),
        'b_rpb': nrm(ks[11], (n_even, B_Q_HEADS, 2 * NA_ROWS - 1, 2 * NA_COLS - 1), 0.1),
        'odd_w_in': nrm(ks[12], (n_odd, D_MODEL, ODD_IN), D_MODEL ** -0.5),
        'odd_w_out': nrm(ks[13], (n_odd, C_VW, D_MODEL), C_VW ** -0.5),
        'lam_q1': nrm(ks[14], (n_odd, HEAD_DIM), 0.1),
        'lam_k1': nrm(ks[15], (n_odd, HEAD_DIM), 0.1),
        'lam_q2': nrm(ks[16], (n_odd, HEAD_DIM), 0.1),
        'lam_k2': nrm(ks[17], (n_odd, HEAD_DIM), 0.1),
        'subln_g': 1.0 + nrm(ks[18], (n_odd, C_V_DIM), 0.05),
        'mlp_w1': nrm(ks[19], (DEPTH, D_MODEL, D_FF), D_MODEL ** -0.5),
        'mlp_w2': nrm(ks[20], (DEPTH, D_FF, D_MODEL), D_FF ** -0.5),
        'final_g': 1.0 + nrm(ks[21], (D_MODEL,), 0.05),
    }


def reference(x, c, ctx, c_ctx, ada_w, ada_b, norm1_g, norm2_g, even_w_in, even_w_out, a_sink, b_rpb,
              odd_w_in, odd_w_out, lam_q1, lam_k1, lam_q2, lam_k2, subln_g, mlp_w1, mlp_w2, final_g):
    n = x.shape[1]
    cos, sin = _rope_tables(n)
    hx, hc = x, ctx
    for i in range(DEPTH):
        with_ctx = i < DEPTH - 1
        j = i // 2
        mx = (jax.nn.silu(c) @ ada_w[i] + ada_b[i])[:, None, :]
        mc = jax.nn.silu(c_ctx) @ ada_w[i] + ada_b[i]
        sx1, cx1, gx1, sx2, cx2, gx2 = jnp.split(mx, 6, axis=-1)
        sc1, cc1, gc1, sc2, cc2, gc2 = jnp.split(mc, 6, axis=-1)
        ax = _modulate(hx, norm1_g[i], sx1, cx1)
        ac = _modulate(hc, norm1_g[i], sc1, cc1)
        if i % 2 == 0:
            yx, yc = _even_mixer(ax, ac, even_w_in[j], even_w_out[j], a_sink[j], b_rpb[j], cos, sin, with_ctx)
        else:
            lam_init = 0.8 - 0.6 * math.exp(-0.3 * i)
            yx, yc = _odd_mixer(ax, ac, odd_w_in[j], odd_w_out[j], lam_q1[j], lam_k1[j], lam_q2[j], lam_k2[j],
                                subln_g[j], lam_init, cos, sin, with_ctx)
        hx = hx + gx1 * yx
        hx = hx + gx2 * _mlp(_modulate(hx, norm2_g[i], sx2, cx2), mlp_w1[i], mlp_w2[i])
        if with_ctx:
            hc = hc + gc1 * yc
            hc = hc + gc2 * _mlp(_modulate(hc, norm2_g[i], sc2, cc2), mlp_w1[i], mlp_w2[i])
    return _rms_norm(hx, final_g)
```

```cpp
#include <hip/hip_runtime.h>
#include <hip/hip_cooperative_groups.h>
#include <cstdio>
#include <cstdint>
namespace cg = cooperative_groups;

#define LAS __attribute__((address_space(3)))
typedef unsigned short bf16_t;
typedef short bf16x8 __attribute__((ext_vector_type(8)));
typedef float f32x4 __attribute__((ext_vector_type(4)));
typedef float f32x16 __attribute__((ext_vector_type(16)));
typedef unsigned u32x4 __attribute__((ext_vector_type(4)));
typedef unsigned u32x2 __attribute__((ext_vector_type(2)));
typedef float f32x2_t __attribute__((ext_vector_type(2)));
typedef __bf16 bf16x2_t __attribute__((ext_vector_type(2)));
__device__ __forceinline__ unsigned pk_bf16(float lo, float hi) { f32x2_t v = {lo, hi}; bf16x2_t b = __builtin_convertvector(v, bf16x2_t); return __builtin_bit_cast(unsigned, b); }

constexpr int DM = 1024, NBATCH = 8, SEQ = 4096, CTXL = 256, DFF = 4096;
constexpr int MLAT = NBATCH * SEQ;
constexpr int MCTX = NBATCH * CTXL;
constexpr int MTOT = MLAT + MCTX;
constexpr float EPS_F = 1e-6f;
constexpr float LOG2E_F = 1.4426950408889634f;
constexpr float QSCALE = 0.125f * LOG2E_F;
constexpr float LAM_INIT = 0.35550906759096926f;
constexpr int NQK0 = 1280, NV0 = 256, NQK1 = 2048, NV1 = 1024;

namespace pg8 {
#define PG8_LAS __attribute__((address_space(3)))
constexpr int BM = 256, BK = 64, HALF = 128, HTB = HALF * BK * 2  , STAGE_BYTES = 8 * HTB, NXCD = 8, WGM = 8;

__host__ __device__ __forceinline__ int lds_byte(int r, int c) { const int st = (r >> 4) * 2 + (c >> 5), rr = r & 15, cc = c & 31, ob = rr * 64 + cc * 2; return st * 1024 + (ob ^ (((ob >> 9) & 1) << 5)); }
__host__ __device__ __forceinline__ void stage_rc(int b, int& R, int& C) { const int st = b / 1024, sb = b % 1024, swz = sb ^ (((sb >> 9) & 1) << 5); R = (st >> 1) * 16 + swz / 64; C = (st & 1) * 32 + (swz % 64) / 2; }
__host__ __device__ __forceinline__ int perm32(int rho) { const int n = rho >> 4, i = rho & 15; return 8 * (i >> 2) + 4 * n + (i & 3); }

struct Unit { int pm, pn; };
struct Gemm { const bf16_t* A; const bf16_t* Bt; int M, N, K; };

struct StaticOrder {
    int nM, nN, nwg, G, c;
    __host__ __device__ void init(int M, int N, int G_, int c_) { nM = M / BM; nN = N / BM; nwg = nM * nN; G = G_; c = c_; }
    __host__ __device__ bool next(int i, Unit& u) const {
        const long L = (long)i * G + c; if (L >= nwg) return false;
        int wgid = (int)L; { const int q = nwg / NXCD, r = nwg % NXCD, xcd = wgid % NXCD, off = wgid / NXCD; wgid = (xcd < r ? xcd * (q + 1) : r * (q + 1) + (xcd - r) * q) + off; }
        const int nig = WGM * nN, gid = wgid / nig, fm = gid * WGM, gsz = (nM - fm) < WGM ? (nM - fm) : WGM;
        u.pm = fm + ((wgid % nig) % gsz); u.pn = (wgid % nig) / gsz; return true;
    }
    __device__ __forceinline__ void a_ready(const Unit&) const {}
    __device__ __forceinline__ void done(const Unit&) const {}
};

__device__ __forceinline__ int batch_of_tile(int p) { return p < 128 ? (p >> 4) : 8; }
__device__ __forceinline__ float row_rstd(const float* ss, int row) {
    const f32x4* sp = (const f32x4*)(ss + (size_t)row * 16);
    const f32x4 a = sp[0], b = sp[1], c = sp[2], d = sp[3];
    const f32x4 t = (a + b) + (c + d);
    const float tot = (t[0] + t[1]) + (t[2] + t[3]);
    return rsqrtf(tot * (1.0f / 1024.0f) + EPS_F);
}

struct EpiQK {
    static constexpr bool PERM = false, AFTER_DRAIN = false;
    bf16_t* O; int ldc; const float* ss; const float* bias; unsigned ropemask, scalemask; const float* ropetab;
    __device__ __forceinline__ void operator()(const f32x4 (&acc)[2][2][4][2], const Unit& u, int wr, int wc, int fr, int fq) const {
        const int bidx = batch_of_tile(u.pm);
        const int colb = u.pn * BM + wc * 32 + 4 * fq;
        f32x4 bv[2][2];
#pragma unroll
        for (int bj = 0; bj < 2; ++bj)
#pragma unroll
            for (int n = 0; n < 2; ++n) bv[bj][n] = *(const f32x4*)(bias + (size_t)bidx * ldc + colb + bj * HALF + n * 16);
#pragma unroll
        for (int ai = 0; ai < 2; ++ai)
#pragma unroll
            for (int m = 0; m < 4; ++m) {
                const int row = u.pm * BM + ai * HALF + wr * 64 + m * 16 + fr;
                const float rs = row_rstd(ss, row);
                const bool islat = row < MLAT;
                const int tpos = row & (SEQ - 1);
                const int pos = (wc & 1) ? (tpos & 63) : (tpos >> 6);
                const f32x4* rt = (const f32x4*)(ropetab + (size_t)(pos * 16 + 4 * fq) * 2);
                const f32x4 cs0 = rt[0], cs1 = rt[1];
                const float cc[4] = {cs0[0], cs0[2], cs1[0], cs1[2]}, sn[4] = {cs0[1], cs0[3], cs1[1], cs1[3]};
                bf16_t* rowp = O + (size_t)row * ldc + colb;
#pragma unroll
                for (int bj = 0; bj < 2; ++bj) {
                    const int c128 = u.pn * 2 + bj;
                    f32x4 v0 = acc[ai][bj][m][0] * rs + bv[bj][0], v1 = acc[ai][bj][m][1] * rs + bv[bj][1];
                    if (((ropemask >> c128) & 1u) && islat) {
#pragma unroll
                        for (int e = 0; e < 4; ++e) { const float x0 = v0[e], x1 = v1[e]; v0[e] = x0 * cc[e] - x1 * sn[e]; v1[e] = x1 * cc[e] + x0 * sn[e]; }
                    }
                    if ((scalemask >> c128) & 1u) { v0 = v0 * QSCALE; v1 = v1 * QSCALE; }
                    u32x2 w0, w1; w0.x = pk_bf16(v0[0], v0[1]); w0.y = pk_bf16(v0[2], v0[3]); w1.x = pk_bf16(v1[0], v1[1]); w1.y = pk_bf16(v1[2], v1[3]);
                    *(u32x2*)(rowp + bj * HALF) = w0; *(u32x2*)(rowp + bj * HALF + 16) = w1;
                }
            }
    }
};

struct EpiVT {
    static constexpr bool PERM = true, AFTER_DRAIN = false;
    bf16_t* O; int ldc; const float* ss; const float* bias; int NV;
    __device__ __forceinline__ void operator()(const f32x4 (&acc)[2][2][4][2], const Unit& u, int wr, int wc, int fr, int fq) const {
        const int bidx = batch_of_tile(u.pn);
        const int tok0 = u.pn * BM + wc * 32 + 8 * fq;
        float rr[2][8];
#pragma unroll
        for (int bj = 0; bj < 2; ++bj)
#pragma unroll
            for (int j = 0; j < 8; ++j) rr[bj][j] = row_rstd(ss, tok0 + bj * HALF + j);
#pragma unroll
        for (int ai = 0; ai < 2; ++ai)
#pragma unroll
            for (int m = 0; m < 4; ++m) {
                const int nrow = u.pm * BM + ai * HALF + wr * 64 + m * 16 + fr;
                const float b = bias[(size_t)bidx * NV + nrow];
                bf16_t* rowp = O + (size_t)nrow * ldc + tok0;
#pragma unroll
                for (int bj = 0; bj < 2; ++bj) {
                    const f32x4 a0 = acc[ai][bj][m][0], a1 = acc[ai][bj][m][1];
                    u32x4 w;
                    w.x = pk_bf16(a0[0] * rr[bj][0] + b, a0[1] * rr[bj][1] + b); w.y = pk_bf16(a0[2] * rr[bj][2] + b, a0[3] * rr[bj][3] + b);
                    w.z = pk_bf16(a1[0] * rr[bj][4] + b, a1[1] * rr[bj][5] + b); w.w = pk_bf16(a1[2] * rr[bj][6] + b, a1[3] * rr[bj][7] + b);
                    *(u32x4*)(rowp + bj * HALF) = w;
                }
            }
    }
};

struct EpiUp {
    static constexpr bool PERM = true, AFTER_DRAIN = false;
    bf16_t* O; const float* ss; const float* bias;
    __device__ __forceinline__ void operator()(const f32x4 (&acc)[2][2][4][2], const Unit& u, int wr, int wc, int fr, int fq) const {
        const int bidx = batch_of_tile(u.pm);
        const int colb = u.pn * BM + wc * 32 + 8 * fq;
        f32x4 bv[2][2];
#pragma unroll
        for (int bj = 0; bj < 2; ++bj)
#pragma unroll
            for (int n = 0; n < 2; ++n) bv[bj][n] = *(const f32x4*)(bias + (size_t)bidx * DFF + colb + bj * HALF + 4 * n);
#pragma unroll
        for (int ai = 0; ai < 2; ++ai)
#pragma unroll
            for (int m = 0; m < 4; ++m) {
                const int row = u.pm * BM + ai * HALF + wr * 64 + m * 16 + fr;
                const float rs = row_rstd(ss, row);
                bf16_t* rowp = O + (size_t)row * DFF + colb;
#pragma unroll
                for (int bj = 0; bj < 2; ++bj) {
                    f32x4 v0 = acc[ai][bj][m][0] * rs + bv[bj][0], v1 = acc[ai][bj][m][1] * rs + bv[bj][1];
#pragma unroll
                    for (int e = 0; e < 4; ++e) { const float a = fmaxf(v0[e], 0.f), b = fmaxf(v1[e], 0.f); v0[e] = a * a; v1[e] = b * b; }
                    u32x4 w; w.x = pk_bf16(v0[0], v0[1]); w.y = pk_bf16(v0[2], v0[3]); w.z = pk_bf16(v1[0], v1[1]); w.w = pk_bf16(v1[2], v1[3]);
                    *(u32x4*)(rowp + bj * HALF) = w;
                }
            }
    }
};

struct EpiRes {
    static constexpr bool PERM = false, AFTER_DRAIN = false;
    const float* hin_lat; const float* hin_ctx; float* hout; bf16_t* xg; float* ss;
    const float* gate; const float* scl; const float* ng;
    __device__ __forceinline__ void operator()(const f32x4 (&acc)[2][2][4][2], const Unit& u, int wr, int wc, int fr, int fq) const {
        const int bidx = batch_of_tile(u.pm);
        const int colb = u.pn * BM + wc * 32 + 4 * fq;
        f32x4 gv[2][2], gp[2][2];
#pragma unroll
        for (int bj = 0; bj < 2; ++bj)
#pragma unroll
            for (int n = 0; n < 2; ++n) {
                const int c = colb + bj * HALF + n * 16;
                gv[bj][n] = *(const f32x4*)(gate + (size_t)bidx * 6144 + c);
                if (xg) { const f32x4 s = *(const f32x4*)(scl + (size_t)bidx * 6144 + c); const f32x4 g = *(const f32x4*)(ng + c); gp[bj][n] = g * (s + 1.0f); }
                else gp[bj][n] = (f32x4){0.f, 0.f, 0.f, 0.f};
            }
#pragma unroll
        for (int ai = 0; ai < 2; ++ai)
#pragma unroll
            for (int m = 0; m < 4; ++m) {
                const int row = u.pm * BM + ai * HALF + wr * 64 + m * 16 + fr;
                const float* hp = (row < MLAT ? hin_lat + (size_t)row * DM : hin_ctx + (size_t)(row - MLAT) * DM) + colb;
                float* op = hout + (size_t)row * DM + colb;
                float ssum = 0.f;
#pragma unroll
                for (int bj = 0; bj < 2; ++bj)
#pragma unroll
                    for (int n = 0; n < 2; ++n) {
                        const f32x4 h = *(const f32x4*)(hp + bj * HALF + n * 16);
                        const f32x4 v = h + gv[bj][n] * acc[ai][bj][m][n];
                        *(f32x4*)(op + bj * HALF + n * 16) = v;
                        ssum += (v[0] * v[0] + v[1] * v[1]) + (v[2] * v[2] + v[3] * v[3]);
                        if (xg) { const f32x4 y = v * gp[bj][n]; u32x2 w; w.x = pk_bf16(y[0], y[1]); w.y = pk_bf16(y[2], y[3]); *(u32x2*)(xg + (size_t)row * DM + colb + bj * HALF + n * 16) = w; }
                    }
                ssum += __shfl_xor(ssum, 16); ssum += __shfl_xor(ssum, 32);
                if (fq == 0) ss[(size_t)row * 16 + u.pn * 4 + wc] = ssum;
            }
    }
};

template <class Epi, class Sched, bool ALIGN_EPI = false, bool SP2 = false>
__device__ __forceinline__ void gemm_phase(PG8_LAS unsigned char* lds, const Gemm g, const Sched& S, const Epi& E) {
    const int tid = threadIdx.x, wid = __builtin_amdgcn_readfirstlane(tid >> 6), lane = tid & 63, wr = wid >> 2, wc = wid & 3, fr = lane & 15, fq = lane >> 4;
    const int K = g.K, nt = K / BK;
    unsigned voffA[2], voffB[2];
#pragma unroll
    for (int i = 0; i < 2; ++i) { int R, C; stage_rc(tid * 16 + i * 8192, R, C); const int Rb = Epi::PERM ? ((R & ~31) + perm32(R & 31)) : R;
        voffA[i] = (unsigned)(R * K + C) * 2u; voffB[i] = (unsigned)(Rb * K + C) * 2u; }
    const size_t kstep = (size_t)(BK * 2);
    const size_t hstep = (size_t)HALF * K * 2;
    const size_t tstep = 2 * hstep;
    const unsigned ldsw = (unsigned)wid * 1024u;
    const int aoff = lds_byte(wr * 64 + fr, fq * 8), boff = lds_byte(wc * 32 + fr, fq * 8);
#define PG8_SA(b, h) (((b) * 2 + (h)) * HTB)
#define PG8_SB(b, h) ((4 + (b) * 2 + (h)) * HTB)
#define PG8_STAGE(bufoff, gbase, voff) do { _Pragma("unroll") for (int _i = 0; _i < 2; ++_i) \
        __builtin_amdgcn_global_load_lds((const unsigned*)((const char*)(gbase) + (voff)[_i]), (PG8_LAS unsigned*)(lds + (bufoff) + ldsw + _i * 8192), 16, 0, 0); } while (0)
#define PG8_LDA(dst, b, h) do { _Pragma("unroll") for (int m = 0; m < 4; ++m) _Pragma("unroll") for (int k = 0; k < 2; ++k) dst[m][k] = *(const PG8_LAS bf16x8*)(lds + PG8_SA(b, h) + aoff + m * 2048 + k * 1024); } while (0)
#define PG8_LDB(dst, b, h) do { _Pragma("unroll") for (int n = 0; n < 2; ++n) _Pragma("unroll") for (int k = 0; k < 2; ++k) dst[n][k] = *(const PG8_LAS bf16x8*)(lds + PG8_SB(b, h) + boff + n * 2048 + k * 1024); } while (0)
#define PG8_MMA(ai, bj, At, Bt) do { __builtin_amdgcn_s_setprio(1); _Pragma("unroll") for (int m = 0; m < 4; ++m) _Pragma("unroll") for (int n = 0; n < 2; ++n) _Pragma("unroll") for (int k = 0; k < 2; ++k) \
        acc[ai][bj][m][n] = __builtin_amdgcn_mfma_f32_16x16x32_bf16(Bt[n][k], At[m][k], acc[ai][bj][m][n], 0, 0, 0); __builtin_amdgcn_s_setprio(0); } while (0)
#define PG8_WAIT_V(n) asm volatile("s_waitcnt vmcnt(" #n ")" ::: "memory")
#define PG8_WAIT_L(n) asm volatile("s_waitcnt lgkmcnt(" #n ")" ::: "memory")
#define PG8_BAR __builtin_amdgcn_s_barrier()
#define PG8_SCHED __builtin_amdgcn_sched_barrier(0)
    Unit cur, nxt; int ui = 0;
    if (!S.next(0, cur)) return;
    f32x4 acc[2][2][4][2];
#pragma unroll
    for (int a = 0; a < 2; ++a)
#pragma unroll
        for (int b = 0; b < 2; ++b)
#pragma unroll
            for (int m = 0; m < 4; ++m)
#pragma unroll
                for (int n = 0; n < 2; ++n) acc[a][b][m][n] = (f32x4){0.f, 0.f, 0.f, 0.f};
    bf16x8 At[4][2], B0[2][2], B1[2][2];
    const char* cA = (const char*)g.A + (size_t)cur.pm * tstep; const char* cB = (const char*)g.Bt + (size_t)cur.pn * tstep;
    S.a_ready(cur);
    if constexpr (SP2) {
        PG8_STAGE(PG8_SB(0, 0), cB, voffB); PG8_STAGE(PG8_SB(0, 1), cB + hstep, voffB); PG8_STAGE(PG8_SA(0, 0), cA, voffA); PG8_STAGE(PG8_SA(0, 1), cA + hstep, voffA);
        if (wr == 1) PG8_BAR;
        PG8_WAIT_V(2); PG8_BAR;
        PG8_STAGE(PG8_SB(1, 0), cB + kstep, voffB); PG8_STAGE(PG8_SA(1, 0), cA + kstep, voffA); PG8_STAGE(PG8_SB(1, 1), cB + hstep + kstep, voffB);
        PG8_WAIT_V(6); PG8_BAR;
    } else {
        PG8_STAGE(PG8_SB(0, 0), cB, voffB); PG8_STAGE(PG8_SA(0, 0), cA, voffA); PG8_STAGE(PG8_SB(0, 1), cB + hstep, voffB); PG8_STAGE(PG8_SA(0, 1), cA + hstep, voffA);
        if (wr == 1) PG8_BAR;
        PG8_WAIT_V(4); PG8_BAR;
        PG8_STAGE(PG8_SB(1, 0), cB + kstep, voffB); PG8_STAGE(PG8_SA(1, 0), cA + kstep, voffA); PG8_STAGE(PG8_SB(1, 1), cB + hstep + kstep, voffB);
        PG8_WAIT_V(6); PG8_BAR;
    }
    for (;;) {
        const bool has_next = S.next(ui + 1, nxt);
        const char* nA = has_next ? (const char*)g.A + (size_t)nxt.pm * tstep : cA; const char* nB = has_next ? (const char*)g.Bt + (size_t)nxt.pn * tstep : cB;
        for (int t = 0; t < nt; t += 2) {
            const bool last = (t == nt - 2);
            const char* a1 = cA + (size_t)(t + 1) * kstep;
            const char* a2 = last ? nA : cA + (size_t)(t + 2) * kstep; const char* b2 = last ? nB : cB + (size_t)(t + 2) * kstep;
            const char* a3 = a2 + kstep; const char* b3 = b2 + kstep;
            if (last && has_next) S.a_ready(nxt);
            if constexpr (SP2) {
            PG8_LDB(B0, 0, 0); PG8_LDB(B1, 0, 1); PG8_SCHED; PG8_LDA(At, 0, 0); PG8_STAGE(PG8_SA(1, 1), a1 + hstep, voffA);
            PG8_WAIT_V(8); PG8_WAIT_L(0); PG8_BAR; PG8_MMA(0, 0, At, B0); PG8_MMA(0, 1, At, B1); PG8_BAR; PG8_SCHED;
            PG8_LDA(At, 0, 1); PG8_STAGE(PG8_SB(0, 0), b2, voffB); PG8_STAGE(PG8_SB(0, 1), b2 + hstep, voffB); PG8_STAGE(PG8_SA(0, 0), a2, voffA);
            PG8_WAIT_V(8); PG8_WAIT_L(0); PG8_BAR; PG8_MMA(1, 0, At, B0); PG8_MMA(1, 1, At, B1); PG8_BAR; PG8_SCHED;
            PG8_LDB(B0, 1, 0); PG8_LDB(B1, 1, 1); PG8_SCHED; PG8_LDA(At, 1, 0); PG8_STAGE(PG8_SA(0, 1), a2 + hstep, voffA);
            PG8_WAIT_V(8); PG8_WAIT_L(0); PG8_BAR; PG8_MMA(0, 0, At, B0); PG8_MMA(0, 1, At, B1); PG8_BAR; PG8_SCHED;
            PG8_LDA(At, 1, 1); PG8_STAGE(PG8_SB(1, 0), b3, voffB); PG8_STAGE(PG8_SB(1, 1), b3 + hstep, voffB); PG8_STAGE(PG8_SA(1, 0), a3, voffA);
            PG8_WAIT_V(8); PG8_WAIT_L(0); PG8_BAR; PG8_MMA(1, 0, At, B0); PG8_MMA(1, 1, At, B1); PG8_BAR; PG8_SCHED;
            } else {
            PG8_LDB(B0, 0, 0); PG8_SCHED; PG8_LDA(At, 0, 0); PG8_STAGE(PG8_SA(1, 1), a1 + hstep, voffA);
            PG8_WAIT_L(8); PG8_BAR; PG8_WAIT_L(0); PG8_MMA(0, 0, At, B0); PG8_BAR; PG8_SCHED;
            PG8_LDB(B1, 0, 1); PG8_STAGE(PG8_SB(0, 0), b2, voffB);
            PG8_BAR; PG8_WAIT_L(0); PG8_MMA(0, 1, At, B1); PG8_BAR;
            PG8_LDA(At, 0, 1); PG8_STAGE(PG8_SA(0, 0), a2, voffA);
            PG8_BAR; PG8_WAIT_L(0); PG8_MMA(1, 0, At, B0); PG8_BAR; PG8_SCHED;
            PG8_STAGE(PG8_SB(0, 1), b2 + hstep, voffB);
            PG8_WAIT_V(6); PG8_BAR; PG8_MMA(1, 1, At, B1); PG8_BAR;
            PG8_LDB(B0, 1, 0); PG8_SCHED; PG8_LDA(At, 1, 0); PG8_STAGE(PG8_SA(0, 1), a2 + hstep, voffA);
            PG8_WAIT_L(8); PG8_BAR; PG8_WAIT_L(0); PG8_MMA(0, 0, At, B0); PG8_BAR; PG8_SCHED;
            PG8_LDB(B1, 1, 1); PG8_STAGE(PG8_SB(1, 0), b3, voffB);
            PG8_BAR; PG8_WAIT_L(0); PG8_MMA(0, 1, At, B1); PG8_BAR;
            PG8_LDA(At, 1, 1); PG8_STAGE(PG8_SA(1, 0), a3, voffA);
            PG8_BAR; PG8_WAIT_L(0); PG8_MMA(1, 0, At, B0); PG8_BAR; PG8_SCHED;
            PG8_STAGE(PG8_SB(1, 1), b3 + hstep, voffB);
            PG8_WAIT_V(6); PG8_BAR; PG8_MMA(1, 1, At, B1); PG8_BAR;
            }
        }
        if constexpr (ALIGN_EPI) { if (wr == 0) PG8_BAR; }
        if constexpr (!Epi::AFTER_DRAIN) { E(acc, cur, wr, wc, fr, fq); S.done(cur); }
        if (!has_next) break;
#pragma unroll
        for (int a = 0; a < 2; ++a)
#pragma unroll
            for (int b = 0; b < 2; ++b)
#pragma unroll
                for (int m = 0; m < 4; ++m)
#pragma unroll
                    for (int n = 0; n < 2; ++n) acc[a][b][m][n] = (f32x4){0.f, 0.f, 0.f, 0.f};
        cur = nxt; cA = nA; cB = nB; ++ui;
        if constexpr (ALIGN_EPI) { if (wr == 1) PG8_BAR; }
    }
    PG8_WAIT_V(0);
    if constexpr (!ALIGN_EPI) { if (wr == 0) PG8_BAR; }
    PG8_BAR;
    if constexpr (Epi::AFTER_DRAIN) { E.fused(acc, cur, wr, wc, fr, fq, lds, wid, lane); S.done(cur); }
#undef PG8_SA
#undef PG8_SB
#undef PG8_STAGE
#undef PG8_LDA
#undef PG8_LDB
#undef PG8_MMA
#undef PG8_WAIT_V
#undef PG8_WAIT_L
#undef PG8_BAR
#undef PG8_SCHED
}
}

namespace att {
#define MFMA32(a, b, c) __builtin_amdgcn_mfma_f32_32x32x16_bf16((a), (b), (c), 0, 0, 0)
__device__ __forceinline__ int koff(int r, int h) { return 16 * (r >> 3) + 8 * h + (r & 7); }
__device__ __forceinline__ int crow(int r, int h) { return (r & 3) + 8 * (r >> 2) + 4 * h; }
__device__ __forceinline__ float ex2(float x) { return __builtin_amdgcn_exp2f(x); }
__device__ __forceinline__ float wave_sum(float v) {
#pragma unroll
    for (int o = 1; o < 64; o <<= 1) v += __shfl_xor(v, o);
    return v;
}

__device__ __forceinline__ void qk_tile(f32x16 (&s)[2], const LAS unsigned char* Kt, const bf16x8 (&qf)[4], int pi, int h) {
    const int sw = (pi >> 1) & 7;
#pragma unroll
    for (int kb = 0; kb < 2; ++kb) {
        f32x16 a = {};
#pragma unroll
        for (int d0 = 0; d0 < 4; ++d0) {
            const bf16x8 kf = *(const LAS bf16x8*)(Kt + (32 * kb + pi) * 128 + (((2 * d0 + h) ^ sw) << 4));
            a = MFMA32(kf, qf[d0], a);
        }
        s[kb] = a;
    }
}
template <int DVB>
__device__ __forceinline__ void softmax_pv(f32x16 (&s)[2], const LAS unsigned char* VTt, f32x16 (&oT)[DVB], float& m_run, float& l_run, int i31, int h) {
    float mx = s[0][0];
#pragma unroll
    for (int r = 1; r < 16; ++r) mx = fmaxf(mx, s[0][r]);
#pragma unroll
    for (int r = 0; r < 16; ++r) mx = fmaxf(mx, s[1][r]);
    mx = fmaxf(mx, __shfl_xor(mx, 32));
    if (__any(mx > m_run)) {
        const float mn = fmaxf(m_run, mx); const float alpha = ex2(m_run - mn); m_run = mn; l_run *= alpha;
#pragma unroll
        for (int db = 0; db < DVB; ++db)
#pragma unroll
            for (int r = 0; r < 16; ++r) oT[db][r] *= alpha;
    }
    float ps = 0.f;
#pragma unroll
    for (int kb = 0; kb < 2; ++kb)
#pragma unroll
        for (int r = 0; r < 16; ++r) { const float p = ex2(s[kb][r] - m_run); s[kb][r] = p; ps += p; }
    l_run += ps;
    const int sw = (i31 >> 1) & 7;
#pragma unroll
    for (int kb = 0; kb < 2; ++kb)
#pragma unroll
        for (int st = 0; st < 2; ++st) {
            u32x4 pw;
            pw.x = pk_bf16(s[kb][8 * st + 0], s[kb][8 * st + 1]); pw.y = pk_bf16(s[kb][8 * st + 2], s[kb][8 * st + 3]);
            pw.z = pk_bf16(s[kb][8 * st + 4], s[kb][8 * st + 5]); pw.w = pk_bf16(s[kb][8 * st + 6], s[kb][8 * st + 7]);
            const bf16x8 pb = __builtin_bit_cast(bf16x8, pw);
#pragma unroll
            for (int db = 0; db < DVB; ++db) {
                const bf16x8 vf = *(const LAS bf16x8*)(VTt + (32 * db + i31) * 128 + (((4 * kb + 2 * st + h) ^ sw) << 4));
                oT[db] = MFMA32(vf, pb, oT[db]);
            }
        }
}

constexpr int L0_UNITS = 2176;
constexpr int L0_BUF = 16384;
constexpr int L0_RPB_OFF = 98304;
struct L0Args { const bf16_t* QK; const bf16_t* VT; bf16_t* Y; const float* sink; const float* rpb; };

__device__ __forceinline__ void attn_l0_phase(LAS unsigned char* lds, const L0Args P, int bid, int G, int tid) {
    const int lane = tid & 63, wid = __builtin_amdgcn_readfirstlane(tid >> 6), i31 = lane & 31, h = lane >> 5;
    const int pi = (i31 & 0x13) | ((i31 & 4) << 1) | ((i31 & 8) >> 1);
    const int g = wid >> 1, jh = wid & 1;
    LAS float* rpbl = (LAS float*)(lds + L0_RPB_OFF);
    for (int i = tid; i < 8 * 15 * 31; i += 512) rpbl[i] = P.rpb[i] * LOG2E_F;
    __syncthreads();
    const int srow = tid >> 3, sch = tid & 7;
    const int sdst = srow * 128 + ((sch ^ ((srow >> 1) & 7)) << 4);
    for (int u = bid; u < L0_UNITS; u += G) {
        int mode, b, kvh, qx, isB;
        if (u < 1024) { mode = 0; b = u >> 7; kvh = (u >> 6) & 1; qx = u & 63; isB = 1; }
        else if (u < 2048) { const int v = u - 1024; mode = 1; b = v >> 7; kvh = (v >> 6) & 1; qx = v & 63; isB = 0; }
        else { const int v = u - 2048; mode = 2; b = v >> 4; kvh = (v >> 2) & 1; isB = (v >> 3) & 1; qx = v & 3; }
        int lat0 = 0, nlat = 0, qtok0;
        if (mode == 0) { lat0 = min(max(qx - 4, 0), 56); nlat = 8; qtok0 = b * SEQ + 64 * qx; }
        else if (mode == 1) { lat0 = max(qx - 2, 0); nlat = min(qx + 2, 63) - lat0 + 1; qtok0 = b * SEQ + 64 * qx; }
        else { qtok0 = MLAT + b * CTXL + 64 * qx; }
        const int nt = nlat + 4;
        const int hq = 4 * kvh + g;
        const int qcol = isB * 512 + hq * 64, kcol = (isB ? 1152 : 1024) + 64 * kvh, vrow = isB * 128 + 64 * kvh;
        const int qtok = qtok0 + 32 * jh + i31;
        bf16x8 qf[4];
#pragma unroll
        for (int d0 = 0; d0 < 4; ++d0) qf[d0] = *(const bf16x8*)(P.QK + (size_t)qtok * NQK0 + qcol + 16 * d0 + 8 * h);
        float m_run, l_run;
        if (!isB) { m_run = P.sink[hq] * LOG2E_F; l_run = (h == 0) ? 1.f : 0.f; } else { m_run = -1e30f; l_run = 0.f; }
        f32x16 oT[2]; oT[0] = f32x16{}; oT[1] = f32x16{};
        u32x4 stK, stV;
        { const int tok0 = (0 < nlat) ? b * SEQ + 64 * lat0 : MLAT + b * CTXL;
          stK = *(const u32x4*)(P.QK + (size_t)(tok0 + srow) * NQK0 + kcol + sch * 8);
          stV = *(const u32x4*)(P.VT + (size_t)(vrow + srow) * MTOT + tok0 + sch * 8);
          *(LAS u32x4*)(lds + sdst) = stK; *(LAS u32x4*)(lds + 8192 + sdst) = stV; }
        __syncthreads();
        for (int t = 0; t < nt; ++t) {
            const LAS unsigned char* buf = lds + (t & 1) * L0_BUF;
            if (t + 1 < nt) {
                const int t1 = t + 1;
                const int tok0 = (t1 < nlat) ? b * SEQ + 64 * (lat0 + t1) : MLAT + b * CTXL + 64 * (t1 - nlat);
                stK = *(const u32x4*)(P.QK + (size_t)(tok0 + srow) * NQK0 + kcol + sch * 8);
                stV = *(const u32x4*)(P.VT + (size_t)(vrow + srow) * MTOT + tok0 + sch * 8);
            }
            f32x16 s[2];
            qk_tile(s, buf, qf, pi, h);
            if (t < nlat) {
                if (mode == 0) {
                    const int krow = lat0 + t, c = 32 * jh + i31, cstart = min(max(c - 8, 0), 48);
                    const LAS float* tab = rpbl + (hq * 15 + (krow - qx + 7)) * 31 + (8 * h - c + 15);
                    const int vb = 8 * h - cstart;
#pragma unroll
                    for (int kb = 0; kb < 2; ++kb)
#pragma unroll
                        for (int r = 0; r < 16; ++r) {
                            const int kc = 32 * kb + 16 * (r >> 3) + (r & 7);
                            const float bias = tab[kc];
                            s[kb][r] = ((unsigned)(kc + vb) < 16u) ? s[kb][r] + bias : -INFINITY;
                        }
                } else {
                    const int tl = lat0 + t;
                    if (tl == qx - 2 || tl == qx + 2) {
                        const int dq = 64 * qx + 32 * jh + i31 - 64 * tl - 8 * h;
#pragma unroll
                        for (int kb = 0; kb < 2; ++kb)
#pragma unroll
                            for (int r = 0; r < 16; ++r) {
                                const int kc = 32 * kb + 16 * (r >> 3) + (r & 7);
                                const int d = dq - kc;
                                if (d > 128 || d < -128) s[kb][r] = -INFINITY;
                            }
                    }
                }
            }
            softmax_pv<2>(s, buf + 8192, oT, m_run, l_run, i31, h);
            if (t + 1 < nt) { LAS unsigned char* nb = lds + ((t + 1) & 1) * L0_BUF; *(LAS u32x4*)(nb + sdst) = stK; *(LAS u32x4*)(nb + 8192 + sdst) = stV; }
            __syncthreads();
        }
        const float l = l_run + __shfl_xor(l_run, 32);
        const float inv = 1.0f / l;
        bf16_t* yp = P.Y + (size_t)qtok * DM + qcol;
#pragma unroll
        for (int db = 0; db < 2; ++db)
#pragma unroll
            for (int rg = 0; rg < 4; ++rg) {
                u32x2 w; w.x = pk_bf16(oT[db][4 * rg] * inv, oT[db][4 * rg + 1] * inv); w.y = pk_bf16(oT[db][4 * rg + 2] * inv, oT[db][4 * rg + 3] * inv);
                *(u32x2*)(yp + 32 * db + 8 * rg + 4 * h) = w;
            }
    }
}

constexpr int DF_BUF = 32768;
constexpr int DF_X_OFF = 65536;
struct DiffArgs { const bf16_t* QK; const bf16_t* VT; bf16_t* Y; const float* lq1; const float* lk1; const float* lq2; const float* lk2; const float* subg; };

__device__ __forceinline__ void attn_diff_phase(LAS unsigned char* lds, const DiffArgs P, int bid, int G, int tid) {
    const int lane = tid & 63, wid = __builtin_amdgcn_readfirstlane(tid >> 6), i31 = lane & 31, h = lane >> 5;
    const int pi = (i31 & 0x13) | ((i31 & 4) << 1) | ((i31 & 8) >> 1);
    const int msub = wid & 1, jg = wid >> 1;
    const float lam = expf(wave_sum(P.lq1[lane] * P.lk1[lane])) - expf(wave_sum(P.lq2[lane] * P.lk2[lane])) + LAM_INIT;
    int sdK[2], sdV[2], skr[2], skc[2], sve[2], svc[2];
#pragma unroll
    for (int i = 0; i < 2; ++i) {
        const int ci = tid + 512 * i;
        const int kr = ci >> 4, c16 = ci & 15; skr[i] = kr; skc[i] = c16;
        sdK[i] = (c16 >> 3) * 8192 + kr * 128 + (((c16 & 7) ^ ((kr >> 1) & 7)) << 4);
        const int e = ci >> 3, ch = ci & 7; sve[i] = e; svc[i] = ch;
        sdV[i] = 16384 + e * 128 + ((ch ^ ((e >> 1) & 7)) << 4);
    }
    const int nunits = NBATCH * 8 * 32;
    for (int it = 0; ; ++it) {
        int pairIdx, qb;
        if (G == 256) { if (it >= 8) break; pairIdx = (bid & 7) * 8 + it; qb = bid >> 3; }
        else { const int u = bid + it * G; if (u >= nunits) break; pairIdx = u >> 5; qb = u & 31; }
        const int b = pairIdx >> 3, hd = pairIdx & 7;
        const int qtok = b * SEQ + 128 * qb + 32 * jg + i31;
        bf16x8 qf[4];
#pragma unroll
        for (int d0 = 0; d0 < 4; ++d0) qf[d0] = *(const bf16x8*)(P.QK + (size_t)qtok * NQK1 + hd * 128 + msub * 64 + 16 * d0 + 8 * h);
        float m_run = -1e30f, l_run = 0.f;
        f32x16 oT[4]; oT[0] = f32x16{}; oT[1] = f32x16{}; oT[2] = f32x16{}; oT[3] = f32x16{};
        const bf16_t* kbase = P.QK + 1024 + hd * 128;
        const bf16_t* vbase = P.VT + (size_t)(hd * 128) * MTOT;
        u32x4 stK[2], stV[2];
        { const int tok0 = b * SEQ;
#pragma unroll
          for (int i = 0; i < 2; ++i) { stK[i] = *(const u32x4*)(kbase + (size_t)(tok0 + skr[i]) * NQK1 + skc[i] * 8); stV[i] = *(const u32x4*)(vbase + (size_t)sve[i] * MTOT + tok0 + svc[i] * 8); }
#pragma unroll
          for (int i = 0; i < 2; ++i) { *(LAS u32x4*)(lds + sdK[i]) = stK[i]; *(LAS u32x4*)(lds + sdV[i]) = stV[i]; } }
        __syncthreads();
        constexpr int NT = 68;
        for (int t = 0; t < NT; ++t) {
            const LAS unsigned char* buf = lds + (t & 1) * DF_BUF;
            if (t + 1 < NT) {
                const int t1 = t + 1;
                const int tok0 = (t1 < 64) ? b * SEQ + 64 * t1 : MLAT + b * CTXL + 64 * (t1 - 64);
#pragma unroll
                for (int i = 0; i < 2; ++i) { stK[i] = *(const u32x4*)(kbase + (size_t)(tok0 + skr[i]) * NQK1 + skc[i] * 8); stV[i] = *(const u32x4*)(vbase + (size_t)sve[i] * MTOT + tok0 + svc[i] * 8); }
            }
            f32x16 s[2];
            qk_tile(s, buf + msub * 8192, qf, pi, h);
            softmax_pv<4>(s, buf + 16384, oT, m_run, l_run, i31, h);
            if (t + 1 < NT) { LAS unsigned char* nb = lds + ((t + 1) & 1) * DF_BUF;
#pragma unroll
                for (int i = 0; i < 2; ++i) { *(LAS u32x4*)(nb + sdK[i]) = stK[i]; *(LAS u32x4*)(nb + sdV[i]) = stV[i]; } }
            __syncthreads();
        }
        const float l = l_run + __shfl_xor(l_run, 32);
        const float inv = 1.0f / l;
        LAS float* X = (LAS float*)(lds + DF_X_OFF) + jg * 4096;
        if (msub == 1) {
            const float f = lam * inv;
#pragma unroll
            for (int db = 0; db < 4; ++db)
#pragma unroll
                for (int r = 0; r < 16; ++r) X[(32 * db + crow(r, h)) * 32 + i31] = oT[db][r] * f;
        }
        __syncthreads();
        if (msub == 0) {
            float ssq = 0.f;
#pragma unroll
            for (int db = 0; db < 4; ++db)
#pragma unroll
                for (int r = 0; r < 16; ++r) { const float d = oT[db][r] * inv - X[(32 * db + crow(r, h)) * 32 + i31]; oT[db][r] = d; ssq += d * d; }
            ssq += __shfl_xor(ssq, 32);
            const float rn = rsqrtf(ssq * (1.0f / 128.0f) + EPS_F) * (1.0f - LAM_INIT);
            bf16_t* yp = P.Y + (size_t)qtok * DM + hd * 128;
#pragma unroll
            for (int db = 0; db < 4; ++db)
#pragma unroll
                for (int rg = 0; rg < 4; ++rg) {
                    const int e0 = 32 * db + 8 * rg + 4 * h;
                    const f32x4 gq = *(const f32x4*)(P.subg + e0);
                    u32x2 w; w.x = pk_bf16(oT[db][4 * rg] * rn * gq[0], oT[db][4 * rg + 1] * rn * gq[1]); w.y = pk_bf16(oT[db][4 * rg + 2] * rn * gq[2], oT[db][4 * rg + 3] * rn * gq[3]);
                    *(u32x2*)(yp + e0) = w;
                }
        }
        __syncthreads();
    }
}
#undef MFMA32
}

constexpr size_t MiB = 1u << 20;
constexpr size_t WS_MOD = 0;
constexpr size_t WS_ROPE = 512 * 1024;
constexpr size_t WS_BIAS = 1 * MiB;
constexpr size_t WS_SS = 4 * MiB;
constexpr size_t WS_WQK0 = 8 * MiB, WS_WV0 = 11 * MiB, WS_WO0 = 12 * MiB, WS_W10 = 14 * MiB, WS_W20 = 22 * MiB;
constexpr size_t WS_WQK1 = 30 * MiB, WS_WV1 = 34 * MiB, WS_WO1 = 36 * MiB, WS_W11 = 38 * MiB, WS_W21 = 46 * MiB;
constexpr size_t WS_HR = 56 * MiB;
constexpr size_t WS_QK = 192 * MiB;
constexpr size_t WS_VT = 328 * MiB;
constexpr size_t WS_Y = 396 * MiB;
constexpr size_t WS_H = 192 * MiB;
constexpr size_t WS_END = 464 * MiB;
constexpr int BO_QK0 = 0, BO_V0 = BO_QK0 + 9 * NQK0, BO_UP0 = BO_V0 + 9 * NV0, BO_QK1 = BO_UP0 + 9 * DFF, BO_V1 = BO_QK1 + 9 * NQK1, BO_UP1 = BO_V1 + 9 * NV1;
constexpr int LDS_BYTES = 147456;
constexpr int NPHASE = 13;

__device__ __forceinline__ float silu_f(float v) { return v / (1.0f + expf(-v)); }
__device__ __forceinline__ void even_map(int c, int& isv, int& r) {
    if (c < 512) { isv = 0; r = c; } else if (c < 640) { isv = 0; r = 1024 + (c - 512); } else if (c < 768) { isv = 1; r = c - 640; }
    else if (c < 1280) { isv = 0; r = 512 + (c - 768); } else if (c < 1408) { isv = 0; r = 1152 + (c - 1280); } else { isv = 1; r = 128 + (c - 1408); }
}
__device__ __forceinline__ void gemv9_item(const float* __restrict__ W, int ldw, int csrc0, const LAS float* vec, LAS float* red, float* out, int ostride, int cdst0, const float* addb, int tid) {
    const int col = tid & 63, kg = tid >> 6;
    float a0 = 0.f, a1 = 0.f, a2 = 0.f, a3 = 0.f, a4 = 0.f, a5 = 0.f, a6 = 0.f, a7 = 0.f, a8 = 0.f;
    const float* wp = W + (size_t)(kg * 128) * ldw + csrc0 + col;
    const LAS float* vp = vec + kg * 128;
#pragma unroll 8
    for (int k = 0; k < 128; ++k) {
        const float w = wp[(size_t)k * ldw];
        a0 += vp[k] * w; a1 += vp[1024 + k] * w; a2 += vp[2048 + k] * w; a3 += vp[3072 + k] * w; a4 += vp[4096 + k] * w;
        a5 += vp[5120 + k] * w; a6 += vp[6144 + k] * w; a7 += vp[7168 + k] * w; a8 += vp[8192 + k] * w;
    }
    LAS float* rp = red + kg * 576 + col;
    rp[0] = a0; rp[64] = a1; rp[128] = a2; rp[192] = a3; rp[256] = a4; rp[320] = a5; rp[384] = a6; rp[448] = a7; rp[512] = a8;
    __syncthreads();
    for (int idx = tid; idx < 576; idx += 512) {
        const int b = idx >> 6, c = idx & 63; float s = 0.f;
#pragma unroll
        for (int g2 = 0; g2 < 8; ++g2) s += red[g2 * 576 + idx];
        if (addb) s += addb[csrc0 + c];
        out[(size_t)b * ostride + cdst0 + c] = s;
    }
    __syncthreads();
}
__device__ __forceinline__ void transpose_item(const float* __restrict__ W, int K, int N, int k0, int n0, bf16_t* dst, LAS float* scr, int lane) {
#pragma unroll 8
    for (int i = 0; i < 32; ++i) { const int kk = 2 * i + (lane >> 5); scr[kk * 33 + (lane & 31)] = W[(size_t)(k0 + kk) * N + n0 + (lane & 31)]; }
    asm volatile("s_waitcnt lgkmcnt(0)" ::: "memory");
    const int c = lane & 7;
#pragma unroll
    for (int j = 0; j < 4; ++j) { const int n = (lane >> 3) + 8 * j; const LAS float* s = scr + (8 * c) * 33 + n;
        u32x4 o; o.x = pk_bf16(s[0 * 33], s[1 * 33]); o.y = pk_bf16(s[2 * 33], s[3 * 33]); o.z = pk_bf16(s[4 * 33], s[5 * 33]); o.w = pk_bf16(s[6 * 33], s[7 * 33]);
        *(u32x4*)(dst + (size_t)n * K + k0 + 8 * c) = o; }
    asm volatile("s_waitcnt lgkmcnt(0)" ::: "memory");
}
__device__ __forceinline__ void sincos_small(double a, float& c, float& s) {
    const double TWO_PI = 6.283185307179586476925287;
    const double k = __builtin_rint(a / TWO_PI);
    const double x = a - k * TWO_PI, x2 = x * x;
    double ts = 1.0, tc = 1.0;
    for (int j = 15; j >= 1; --j) { ts = 1.0 - x2 / (double)((2 * j) * (2 * j + 1)) * ts; tc = 1.0 - x2 / (double)((2 * j - 1) * (2 * j)) * tc; }
    s = (float)(x * ts); c = (float)tc;
}

struct Args { const float* in[22]; float* out; unsigned char* ws; int ph_lo, ph_hi; };

__global__ void __launch_bounds__(512, 2) dit_fwd(Args args) {
    extern __shared__ __attribute__((aligned(16))) unsigned char lds_raw[];
    LAS unsigned char* lds = (LAS unsigned char*)lds_raw;
    const int tid = threadIdx.x, lane = tid & 63, wave = __builtin_amdgcn_readfirstlane(tid >> 6);
    const int bid = blockIdx.x, G = gridDim.x;
    const int gw = bid * 8 + wave, NGW = G * 8;
    unsigned char* ws = args.ws;
    const float* x = args.in[0]; const float* cvec = args.in[1]; const float* ctx = args.in[2]; const float* c_ctx = args.in[3];
    const float* ada_w = args.in[4]; const float* ada_b = args.in[5]; const float* norm1_g = args.in[6]; const float* norm2_g = args.in[7];
    const float* even_w_in = args.in[8]; const float* even_w_out = args.in[9]; const float* a_sink = args.in[10]; const float* b_rpb = args.in[11];
    const float* odd_w_in = args.in[12]; const float* odd_w_out = args.in[13];
    const float* mlp_w1 = args.in[19]; const float* mlp_w2 = args.in[20]; const float* final_g = args.in[21];
    float* mod = (float*)(ws + WS_MOD); float* ropetab = (float*)(ws + WS_ROPE); float* biasb = (float*)(ws + WS_BIAS); float* ssb = (float*)(ws + WS_SS);
    bf16_t* Wqk0 = (bf16_t*)(ws + WS_WQK0); bf16_t* Wv0 = (bf16_t*)(ws + WS_WV0); bf16_t* Wo0 = (bf16_t*)(ws + WS_WO0); bf16_t* W10 = (bf16_t*)(ws + WS_W10); bf16_t* W20 = (bf16_t*)(ws + WS_W20);
    bf16_t* Wqk1 = (bf16_t*)(ws + WS_WQK1); bf16_t* Wv1 = (bf16_t*)(ws + WS_WV1); bf16_t* Wo1 = (bf16_t*)(ws + WS_WO1); bf16_t* W11 = (bf16_t*)(ws + WS_W11); bf16_t* W21 = (bf16_t*)(ws + WS_W21);
    float* HR = (float*)(ws + WS_HR); bf16_t* QK = (bf16_t*)(ws + WS_QK); bf16_t* VT = (bf16_t*)(ws + WS_VT); bf16_t* Y = (bf16_t*)(ws + WS_Y); bf16_t* Hb = (bf16_t*)(ws + WS_H);
    bf16_t* XG = (bf16_t*)args.out;
    const int lo = args.ph_lo, hi = args.ph_hi;
#define IN(k) (lo <= (k) && (k) < hi)
#define SEAM(k) do { if (IN(k) && IN((k) + 1)) { cg::this_grid().sync(); } } while (0)

    if (IN(0)) {
        if (bid < 192) {
            LAS float* vec = (LAS float*)lds; LAS float* red = (LAS float*)(lds + 40960);
            for (int i = tid; i < 9 * 1024; i += 512) { const float v = (i < 8192) ? cvec[i] : c_ctx[i - 8192]; vec[i] = silu_f(v); }
            __syncthreads();
            const int l = bid / 96, cb = bid % 96;
            gemv9_item(ada_w + (size_t)l * DM * 6144, 6144, cb * 64, vec, red, mod + (size_t)l * 9 * 6144, 6144, cb * 64, ada_b + (size_t)l * 6144, tid);
        }
        if (bid == G - 1) {
            for (int idx = tid; idx < 1024; idx += 512) {
                const int pos = idx >> 4, i = idx & 15; double f = 1.0;
                for (int q = 0; q < i; ++q) f *= 0.56234132519034908;
                float c, s; sincos_small((double)pos * f, c, s);
                ropetab[2 * idx] = c; ropetab[2 * idx + 1] = s;
            }
        }
        __syncthreads();
        LAS float* scr = (LAS float*)(lds + wave * 8448);
        for (int it = gw; it < 11520; it += NGW) {
            int r = it;
            if (r < 768) { const int kb = r / 48, nb = r % 48; int isv, dr; even_map(32 * nb, isv, dr);
                transpose_item(even_w_in, DM, 1536, 64 * kb, 32 * nb, (isv ? Wv0 : Wqk0) + (size_t)dr * DM, scr, lane); continue; } r -= 768;
            if (r < 512) { const int kb = r / 32, nb = r % 32; transpose_item(even_w_out, DM, DM, 64 * kb, 32 * nb, Wo0 + (size_t)(32 * nb) * DM, scr, lane); continue; } r -= 512;
            if (r < 1536) { const int kb = r / 96, nb = r % 96; const int n0 = 32 * nb;
                transpose_item(odd_w_in, DM, 3072, 64 * kb, n0, n0 < 2048 ? Wqk1 + (size_t)n0 * DM : Wv1 + (size_t)(n0 - 2048) * DM, scr, lane); continue; } r -= 1536;
            if (r < 512) { const int kb = r / 32, nb = r % 32; transpose_item(odd_w_out, DM, DM, 64 * kb, 32 * nb, Wo1 + (size_t)(32 * nb) * DM, scr, lane); continue; } r -= 512;
            if (r < 4096) { const int l = r / 2048, q = r % 2048, kb = q / 128, nb = q % 128;
                transpose_item(mlp_w1 + (size_t)l * DM * DFF, DM, DFF, 64 * kb, 32 * nb, (l ? W11 : W10) + (size_t)(32 * nb) * DM, scr, lane); continue; } r -= 4096;
            { const int l = r / 2048, q = r % 2048, kb = q / 32, nb = q % 32;
                transpose_item(mlp_w2 + (size_t)l * DFF * DM, DFF, DM, 64 * kb, 32 * nb, (l ? W21 : W20) + (size_t)(32 * nb) * DFF, scr, lane); }
        }
    }
    SEAM(0);
    if (IN(1)) {
        if (bid < 200) {
            LAS float* vec = (LAS float*)lds; LAS float* red = (LAS float*)(lds + 40960);
            int l, soff; if (bid < 24) { l = 0; soff = 0; } else if (bid < 88) { l = 0; soff = 3072; } else if (bid < 136) { l = 1; soff = 0; } else { l = 1; soff = 3072; }
            for (int i = tid; i < 9 * 1024; i += 512) vec[i] = mod[(size_t)(l * 9 + (i >> 10)) * 6144 + soff + (i & 1023)];
            __syncthreads();
            if (bid < 24) { const int c0 = 64 * bid; int isv, dr; even_map(c0, isv, dr);
                gemv9_item(even_w_in, 1536, c0, vec, red, biasb + (isv ? BO_V0 : BO_QK0), isv ? NV0 : NQK0, dr, nullptr, tid); }
            else if (bid < 88) { const int c0 = 64 * (bid - 24); gemv9_item(mlp_w1, DFF, c0, vec, red, biasb + BO_UP0, DFF, c0, nullptr, tid); }
            else if (bid < 136) { const int c0 = 64 * (bid - 88);
                if (c0 < 2048) gemv9_item(odd_w_in, 3072, c0, vec, red, biasb + BO_QK1, NQK1, c0, nullptr, tid);
                else gemv9_item(odd_w_in, 3072, c0, vec, red, biasb + BO_V1, NV1, c0 - 2048, nullptr, tid); }
            else { const int c0 = 64 * (bid - 136); gemv9_item(mlp_w1 + (size_t)DM * DFF, DFF, c0, vec, red, biasb + BO_UP1, DFF, c0, nullptr, tid); }
        }
        for (int row = gw; row < MTOT; row += NGW) {
            const float* src = row < MLAT ? x + (size_t)row * DM : ctx + (size_t)(row - MLAT) * DM;
            const int b = row < MLAT ? (row >> 12) : 8;
            const float* scl = mod + (size_t)b * 6144 + 1024;
            float ssum = 0.f;
#pragma unroll
            for (int j = 0; j < 4; ++j) {
                const int k = 4 * lane + 256 * j;
                const f32x4 v = *(const f32x4*)(src + k), g = *(const f32x4*)(norm1_g + k), s = *(const f32x4*)(scl + k);
                ssum += (v[0] * v[0] + v[1] * v[1]) + (v[2] * v[2] + v[3] * v[3]);
                const f32x4 y = v * (g * (s + 1.0f));
                u32x2 w; w.x = pk_bf16(y[0], y[1]); w.y = pk_bf16(y[2], y[3]);
                *(u32x2*)(XG + (size_t)row * DM + k) = w;
            }
            ssum = att::wave_sum(ssum);
            if (lane < 16) ssb[(size_t)row * 16 + lane] = (lane == 0) ? ssum : 0.f;
        }
    }
    SEAM(1);
    if (IN(2)) {
        { pg8::Gemm g{XG, Wqk0, MTOT, NQK0, DM}; pg8::StaticOrder S; S.init(MTOT, NQK0, G, bid);
          pg8::EpiQK E{QK, NQK0, ssb, biasb + BO_QK0, 0x10Fu, 0x0FFu, ropetab};
          pg8::gemm_phase<pg8::EpiQK, pg8::StaticOrder, true, true>(lds, g, S, E); }
        { pg8::Gemm g{Wv0, XG, NV0, MTOT, DM}; pg8::StaticOrder S; S.init(NV0, MTOT, G, bid);
          pg8::EpiVT E{VT, MTOT, ssb, biasb + BO_V0, NV0};
          pg8::gemm_phase<pg8::EpiVT, pg8::StaticOrder, true, true>(lds, g, S, E); }
    }
    SEAM(2);
    if (IN(3)) { att::L0Args P{QK, VT, Y, a_sink, b_rpb}; att::attn_l0_phase(lds, P, bid, G, tid); }
    SEAM(3);
    if (IN(4)) {
        pg8::Gemm g{Y, Wo0, MTOT, DM, DM}; pg8::StaticOrder S; S.init(MTOT, DM, G, bid);
        pg8::EpiRes E{x, ctx, HR, XG, ssb, mod + 2048, mod + 4096, norm2_g};
        pg8::gemm_phase<pg8::EpiRes, pg8::StaticOrder, true, true>(lds, g, S, E);
    }
    SEAM(4);
    if (IN(5)) {
        pg8::Gemm g{XG, W10, MTOT, DFF, DM}; pg8::StaticOrder S; S.init(MTOT, DFF, G, bid);
        pg8::EpiUp E{Hb, ssb, biasb + BO_UP0};
        pg8::gemm_phase<pg8::EpiUp, pg8::StaticOrder, true, true>(lds, g, S, E);
    }
    SEAM(5);
    if (IN(6)) {
        pg8::Gemm g{Hb, W20, MTOT, DM, DFF}; pg8::StaticOrder S; S.init(MTOT, DM, G, bid);
        pg8::EpiRes E{HR, HR + (size_t)MLAT * DM, HR, XG, ssb, mod + 5120, mod + 9 * 6144 + 1024, norm1_g + DM};
        pg8::gemm_phase<pg8::EpiRes, pg8::StaticOrder, true, true>(lds, g, S, E);
    }
    SEAM(6);
    if (IN(7)) {
        { pg8::Gemm g{XG, Wqk1, MTOT, NQK1, DM}; pg8::StaticOrder S; S.init(MTOT, NQK1, G, bid);
          pg8::EpiQK E{QK, NQK1, ssb, biasb + BO_QK1, 0xFFFFu, 0x00FFu, ropetab};
          pg8::gemm_phase<pg8::EpiQK, pg8::StaticOrder, true, true>(lds, g, S, E); }
        { pg8::Gemm g{Wv1, XG, NV1, MTOT, DM}; pg8::StaticOrder S; S.init(NV1, MTOT, G, bid);
          pg8::EpiVT E{VT, MTOT, ssb, biasb + BO_V1, NV1};
          pg8::gemm_phase<pg8::EpiVT, pg8::StaticOrder, true, true>(lds, g, S, E); }
    }
    SEAM(7);
    if (IN(8)) { att::DiffArgs P{QK, VT, Y, args.in[14], args.in[15], args.in[16], args.in[17], args.in[18]}; att::attn_diff_phase(lds, P, bid, G, tid); }
    SEAM(8);
    if (IN(9)) {
        pg8::Gemm g{Y, Wo1, MLAT, DM, DM}; pg8::StaticOrder S; S.init(MLAT, DM, G, bid);
        pg8::EpiRes E{HR, HR, HR, XG, ssb, mod + 9 * 6144 + 2048, mod + 9 * 6144 + 4096, norm2_g + DM};
        pg8::gemm_phase<pg8::EpiRes, pg8::StaticOrder, true, true>(lds, g, S, E);
    }
    SEAM(9);
    if (IN(10)) {
        pg8::Gemm g{XG, W11, MLAT, DFF, DM}; pg8::StaticOrder S; S.init(MLAT, DFF, G, bid);
        pg8::EpiUp E{Hb, ssb, biasb + BO_UP1};
        pg8::gemm_phase<pg8::EpiUp, pg8::StaticOrder, true, true>(lds, g, S, E);
    }
    SEAM(10);
    if (IN(11)) {
        pg8::Gemm g{Hb, W21, MLAT, DM, DFF}; pg8::StaticOrder S; S.init(MLAT, DM, G, bid);
        pg8::EpiRes E{HR, HR, args.out, nullptr, ssb, mod + 9 * 6144 + 5120, nullptr, nullptr};
        pg8::gemm_phase<pg8::EpiRes, pg8::StaticOrder, true, true>(lds, g, S, E);
    }
    SEAM(11);
    if (IN(12)) {
        for (int row = gw; row < MLAT; row += NGW) {
            const float rs = pg8::row_rstd(ssb, row);
            float* op = args.out + (size_t)row * DM;
#pragma unroll
            for (int j = 0; j < 4; ++j) { const int k = 4 * lane + 256 * j; const f32x4 v = *(const f32x4*)(op + k), g = *(const f32x4*)(final_g + k); *(f32x4*)(op + k) = v * rs * g; }
        }
    }
#undef IN
#undef SEAM
}

#ifndef N_LAUNCH_MODE
#define N_LAUNCH_MODE 1
#endif
extern "C" void kernel_launch(void* const* d_in, const int* in_sizes, int n_in, void* d_out, int out_size, void* d_ws, size_t ws_size, hipStream_t stream) {
    static int grid = 0;
    if (grid == 0) {
        if (n_in != 22 || out_size != MLAT * DM || ws_size < WS_END) { fprintf(stderr, "kernel_launch: unexpected shapes (n_in %d out %d ws %zu)\n", n_in, out_size, ws_size); grid = -1; return; }
        int dev = 0, cus = 0, per_cu = 0;
        if (hipGetDevice(&dev) != hipSuccess || hipDeviceGetAttribute(&cus, hipDeviceAttributeMultiprocessorCount, dev) != hipSuccess) { grid = -1; return; }
        if (hipFuncSetAttribute((const void*)dit_fwd, hipFuncAttributeMaxDynamicSharedMemorySize, LDS_BYTES) != hipSuccess) { fprintf(stderr, "kernel_launch: hipFuncSetAttribute failed\n"); grid = -1; return; }
        if (hipOccupancyMaxActiveBlocksPerMultiprocessor(&per_cu, (const void*)dit_fwd, 512, LDS_BYTES) != hipSuccess || per_cu < 1) { fprintf(stderr, "kernel_launch: occupancy query says %d\n", per_cu); per_cu = 1; }
        (void)hipGetLastError();
        grid = cus;
        if (grid % 8 != 0 || grid < 8) { fprintf(stderr, "kernel_launch: unexpected CU count %d\n", cus); }
    }
    if (grid < 0) return;
    Args a{};
    for (int i = 0; i < 22; ++i) a.in[i] = (const float*)d_in[i];
    a.out = (float*)d_out; a.ws = (unsigned char*)d_ws;
#if N_LAUNCH_MODE == 0
    a.ph_lo = 0; a.ph_hi = NPHASE;
    void* kargs[] = {&a};
    hipError_t e = hipLaunchCooperativeKernel((const void*)dit_fwd, dim3(grid), dim3(512), kargs, LDS_BYTES, stream);
    if (e != hipSuccess) fprintf(stderr, "kernel_launch: cooperative launch failed: %s (grid %d)\n", hipGetErrorString(e), grid);
#else
    for (int p = 0; p < NPHASE; ++p) { a.ph_lo = p; a.ph_hi = p + 1; hipLaunchKernelGGL(dit_fwd, dim3(grid), dim3(512), LDS_BYTES, stream, a); }
#endif
}
```

```cpp
#include <hip/hip_runtime.h>
#include <hip/hip_cooperative_groups.h>
#include <cstdio>
#include <cstdint>
namespace cg = cooperative_groups;

#define LAS __attribute__((address_space(3)))
typedef unsigned short bf16_t;
typedef short bf16x8 __attribute__((ext_vector_type(8)));
typedef float f32x4 __attribute__((ext_vector_type(4)));
typedef float f32x16 __attribute__((ext_vector_type(16)));
typedef unsigned u32x4 __attribute__((ext_vector_type(4)));
typedef unsigned u32x2 __attribute__((ext_vector_type(2)));
typedef float f32x2_t __attribute__((ext_vector_type(2)));
typedef __bf16 bf16x2_t __attribute__((ext_vector_type(2)));
__device__ __forceinline__ unsigned pk_bf16(float lo, float hi) { f32x2_t v = {lo, hi}; bf16x2_t b = __builtin_convertvector(v, bf16x2_t); return __builtin_bit_cast(unsigned, b); }

constexpr int DM = 1024, NBATCH = 8, SEQ = 4096, CTXL = 256, DFF = 4096;
constexpr int MLAT = NBATCH * SEQ;
constexpr int MCTX = NBATCH * CTXL;
constexpr int MTOT = MLAT + MCTX;
constexpr float EPS_F = 1e-6f;
constexpr float LOG2E_F = 1.4426950408889634f;
constexpr float QSCALE = 0.125f * LOG2E_F;
constexpr float LAM_INIT = 0.35550906759096926f;
constexpr int NQK0 = 1280, NV0 = 256, NQK1 = 2048, NV1 = 1024;

namespace pg8 {
#define PG8_LAS __attribute__((address_space(3)))
constexpr int BM = 256, BK = 64, HALF = 128, HTB = HALF * BK * 2  , STAGE_BYTES = 8 * HTB, NXCD = 8, WGM = 8;

__host__ __device__ __forceinline__ int lds_byte(int r, int c) { const int st = (r >> 4) * 2 + (c >> 5), rr = r & 15, cc = c & 31, ob = rr * 64 + cc * 2; return st * 1024 + (ob ^ (((ob >> 9) & 1) << 5)); }
__host__ __device__ __forceinline__ void stage_rc(int b, int& R, int& C) { const int st = b / 1024, sb = b % 1024, swz = sb ^ (((sb >> 9) & 1) << 5); R = (st >> 1) * 16 + swz / 64; C = (st & 1) * 32 + (swz % 64) / 2; }
__host__ __device__ __forceinline__ int perm32(int rho) { const int n = rho >> 4, i = rho & 15; return 8 * (i >> 2) + 4 * n + (i & 3); }

struct Unit { int pm, pn; };
struct Gemm { const bf16_t* A; const bf16_t* Bt; int M, N, K; };

struct StaticOrder {
    int nM, nN, nwg, G, c;
    __host__ __device__ void init(int M, int N, int G_, int c_) { nM = M / BM; nN = N / BM; nwg = nM * nN; G = G_; c = c_; }
    __host__ __device__ bool next(int i, Unit& u) const {
        const long L = (long)i * G + c; if (L >= nwg) return false;
        int wgid = (int)L; { const int q = nwg / NXCD, r = nwg % NXCD, xcd = wgid % NXCD, off = wgid / NXCD; wgid = (xcd < r ? xcd * (q + 1) : r * (q + 1) + (xcd - r) * q) + off; }
        const int nig = WGM * nN, gid = wgid / nig, fm = gid * WGM, gsz = (nM - fm) < WGM ? (nM - fm) : WGM;
        u.pm = fm + ((wgid % nig) % gsz); u.pn = (wgid % nig) / gsz; return true;
    }
    __device__ __forceinline__ void a_ready(const Unit&) const {}
    __device__ __forceinline__ void done(const Unit&) const {}
};

__device__ __forceinline__ int batch_of_tile(int p) { return p < 128 ? (p >> 4) : 8; }
__device__ __forceinline__ float row_rstd(const float* ss, int row) {
    const f32x4* sp = (const f32x4*)(ss + (size_t)row * 16);
    const f32x4 a = sp[0], b = sp[1], c = sp[2], d = sp[3];
    const f32x4 t = (a + b) + (c + d);
    const float tot = (t[0] + t[1]) + (t[2] + t[3]);
    return rsqrtf(tot * (1.0f / 1024.0f) + EPS_F);
}

struct EpiQK {
    static constexpr bool PERM = false, AFTER_DRAIN = false;
    bf16_t* O; int ldc; const float* ss; const float* bias; unsigned ropemask, scalemask; const float* ropetab;
    __device__ __forceinline__ void operator()(const f32x4 (&acc)[2][2][4][2], const Unit& u, int wr, int wc, int fr, int fq) const {
        const int bidx = batch_of_tile(u.pm);
        const int colb = u.pn * BM + wc * 32 + 4 * fq;
        f32x4 bv[2][2];
#pragma unroll
        for (int bj = 0; bj < 2; ++bj)
#pragma unroll
            for (int n = 0; n < 2; ++n) bv[bj][n] = *(const f32x4*)(bias + (size_t)bidx * ldc + colb + bj * HALF + n * 16);
#pragma unroll
        for (int ai = 0; ai < 2; ++ai)
#pragma unroll
            for (int m = 0; m < 4; ++m) {
                const int row = u.pm * BM + ai * HALF + wr * 64 + m * 16 + fr;
                const float rs = row_rstd(ss, row);
                const bool islat = row < MLAT;
                const int tpos = row & (SEQ - 1);
                const int pos = (wc & 1) ? (tpos & 63) : (tpos >> 6);
                const f32x4* rt = (const f32x4*)(ropetab + (size_t)(pos * 16 + 4 * fq) * 2);
                const f32x4 cs0 = rt[0], cs1 = rt[1];
                const float cc[4] = {cs0[0], cs0[2], cs1[0], cs1[2]}, sn[4] = {cs0[1], cs0[3], cs1[1], cs1[3]};
                bf16_t* rowp = O + (size_t)row * ldc + colb;
#pragma unroll
                for (int bj = 0; bj < 2; ++bj) {
                    const int c128 = u.pn * 2 + bj;
                    f32x4 v0 = acc[ai][bj][m][0] * rs + bv[bj][0], v1 = acc[ai][bj][m][1] * rs + bv[bj][1];
                    if (((ropemask >> c128) & 1u) && islat) {
#pragma unroll
                        for (int e = 0; e < 4; ++e) { const float x0 = v0[e], x1 = v1[e]; v0[e] = x0 * cc[e] - x1 * sn[e]; v1[e] = x1 * cc[e] + x0 * sn[e]; }
                    }
                    if ((scalemask >> c128) & 1u) { v0 = v0 * QSCALE; v1 = v1 * QSCALE; }
                    u32x2 w0, w1; w0.x = pk_bf16(v0[0], v0[1]); w0.y = pk_bf16(v0[2], v0[3]); w1.x = pk_bf16(v1[0], v1[1]); w1.y = pk_bf16(v1[2], v1[3]);
                    *(u32x2*)(rowp + bj * HALF) = w0; *(u32x2*)(rowp + bj * HALF + 16) = w1;
                }
            }
    }
};

struct EpiVT {
    static constexpr bool PERM = true, AFTER_DRAIN = false;
    bf16_t* O; int ldc; const float* ss; const float* bias; int NV;
    __device__ __forceinline__ void operator()(const f32x4 (&acc)[2][2][4][2], const Unit& u, int wr, int wc, int fr, int fq) const {
        const int bidx = batch_of_tile(u.pn);
        const int tok0 = u.pn * BM + wc * 32 + 8 * fq;
        float rr[2][8];
#pragma unroll
        for (int bj = 0; bj < 2; ++bj)
#pragma unroll
            for (int j = 0; j < 8; ++j) rr[bj][j] = row_rstd(ss, tok0 + bj * HALF + j);
#pragma unroll
        for (int ai = 0; ai < 2; ++ai)
#pragma unroll
            for (int m = 0; m < 4; ++m) {
                const int nrow = u.pm * BM + ai * HALF + wr * 64 + m * 16 + fr;
                const float b = bias[(size_t)bidx * NV + nrow];
                bf16_t* rowp = O + (size_t)nrow * ldc + tok0;
#pragma unroll
                for (int bj = 0; bj < 2; ++bj) {
                    const f32x4 a0 = acc[ai][bj][m][0], a1 = acc[ai][bj][m][1];
                    u32x4 w;
                    w.x = pk_bf16(a0[0] * rr[bj][0] + b, a0[1] * rr[bj][1] + b); w.y = pk_bf16(a0[2] * rr[bj][2] + b, a0[3] * rr[bj][3] + b);
                    w.z = pk_bf16(a1[0] * rr[bj][4] + b, a1[1] * rr[bj][5] + b); w.w = pk_bf16(a1[2] * rr[bj][6] + b, a1[3] * rr[bj][7] + b);
                    *(u32x4*)(rowp + bj * HALF) = w;
                }
            }
    }
};

struct EpiUp {
    static constexpr bool PERM = true, AFTER_DRAIN = false;
    bf16_t* O; const float* ss; const float* bias;
    __device__ __forceinline__ void operator()(const f32x4 (&acc)[2][2][4][2], const Unit& u, int wr, int wc, int fr, int fq) const {
        const int bidx = batch_of_tile(u.pm);
        const int colb = u.pn * BM + wc * 32 + 8 * fq;
        f32x4 bv[2][2];
#pragma unroll
        for (int bj = 0; bj < 2; ++bj)
#pragma unroll
            for (int n = 0; n < 2; ++n) bv[bj][n] = *(const f32x4*)(bias + (size_t)bidx * DFF + colb + bj * HALF + 4 * n);
#pragma unroll
        for (int ai = 0; ai < 2; ++ai)
#pragma unroll
            for (int m = 0; m < 4; ++m) {
                const int row = u.pm * BM + ai * HALF + wr * 64 + m * 16 + fr;
                const float rs = row_rstd(ss, row);
                bf16_t* rowp = O + (size_t)row * DFF + colb;
#pragma unroll
                for (int bj = 0; bj < 2; ++bj) {
                    f32x4 v0 = acc[ai][bj][m][0] * rs + bv[bj][0], v1 = acc[ai][bj][m][1] * rs + bv[bj][1];
#pragma unroll
                    for (int e = 0; e < 4; ++e) { const float a = fmaxf(v0[e], 0.f), b = fmaxf(v1[e], 0.f); v0[e] = a * a; v1[e] = b * b; }
                    u32x4 w; w.x = pk_bf16(v0[0], v0[1]); w.y = pk_bf16(v0[2], v0[3]); w.z = pk_bf16(v1[0], v1[1]); w.w = pk_bf16(v1[2], v1[3]);
                    *(u32x4*)(rowp + bj * HALF) = w;
                }
            }
    }
};

struct EpiRes {
    static constexpr bool PERM = false, AFTER_DRAIN = false;
    const float* hin_lat; const float* hin_ctx; float* hout; bf16_t* xg; float* ss;
    const float* gate; const float* scl; const float* ng;
    __device__ __forceinline__ void operator()(const f32x4 (&acc)[2][2][4][2], const Unit& u, int wr, int wc, int fr, int fq) const {
        const int bidx = batch_of_tile(u.pm);
        const int colb = u.pn * BM + wc * 32 + 4 * fq;
        f32x4 gv[2][2], gp[2][2];
#pragma unroll
        for (int bj = 0; bj < 2; ++bj)
#pragma unroll
            for (int n = 0; n < 2; ++n) {
                const int c = colb + bj * HALF + n * 16;
                gv[bj][n] = *(const f32x4*)(gate + (size_t)bidx * 6144 + c);
                if (xg) { const f32x4 s = *(const f32x4*)(scl + (size_t)bidx * 6144 + c); const f32x4 g = *(const f32x4*)(ng + c); gp[bj][n] = g * (s + 1.0f); }
                else gp[bj][n] = (f32x4){0.f, 0.f, 0.f, 0.f};
            }
#pragma unroll
        for (int ai = 0; ai < 2; ++ai)
#pragma unroll
            for (int m = 0; m < 4; ++m) {
                const int row = u.pm * BM + ai * HALF + wr * 64 + m * 16 + fr;
                const float* hp = (row < MLAT ? hin_lat + (size_t)row * DM : hin_ctx + (size_t)(row - MLAT) * DM) + colb;
                float* op = hout + (size_t)row * DM + colb;
                float ssum = 0.f;
#pragma unroll
                for (int bj = 0; bj < 2; ++bj)
#pragma unroll
                    for (int n = 0; n < 2; ++n) {
                        const f32x4 h = *(const f32x4*)(hp + bj * HALF + n * 16);
                        const f32x4 v = h + gv[bj][n] * acc[ai][bj][m][n];
                        *(f32x4*)(op + bj * HALF + n * 16) = v;
                        ssum += (v[0] * v[0] + v[1] * v[1]) + (v[2] * v[2] + v[3] * v[3]);
                        if (xg) { const f32x4 y = v * gp[bj][n]; u32x2 w; w.x = pk_bf16(y[0], y[1]); w.y = pk_bf16(y[2], y[3]); *(u32x2*)(xg + (size_t)row * DM + colb + bj * HALF + n * 16) = w; }
                    }
                ssum += __shfl_xor(ssum, 16); ssum += __shfl_xor(ssum, 32);
                if (fq == 0) ss[(size_t)row * 16 + u.pn * 4 + wc] = ssum;
            }
    }
};

template <class Epi, class Sched, bool ALIGN_EPI = false, bool SP2 = false>
__device__ __forceinline__ void gemm_phase(PG8_LAS unsigned char* lds, const Gemm g, const Sched& S, const Epi& E) {
    const int tid = threadIdx.x, wid = __builtin_amdgcn_readfirstlane(tid >> 6), lane = tid & 63, wr = wid >> 2, wc = wid & 3, fr = lane & 15, fq = lane >> 4;
    const int K = g.K, nt = K / BK;
    unsigned voffA[2], voffB[2];
#pragma unroll
    for (int i = 0; i < 2; ++i) { int R, C; stage_rc(tid * 16 + i * 8192, R, C); const int Rb = Epi::PERM ? ((R & ~31) + perm32(R & 31)) : R;
        voffA[i] = (unsigned)(R * K + C) * 2u; voffB[i] = (unsigned)(Rb * K + C) * 2u; }
    const size_t kstep = (size_t)(BK * 2);
    const size_t hstep = (size_t)HALF * K * 2;
    const size_t tstep = 2 * hstep;
    const unsigned ldsw = (unsigned)wid * 1024u;
    const int aoff = lds_byte(wr * 64 + fr, fq * 8), boff = lds_byte(wc * 32 + fr, fq * 8);
#define PG8_SA(b, h) (((b) * 2 + (h)) * HTB)
#define PG8_SB(b, h) ((4 + (b) * 2 + (h)) * HTB)
#define PG8_STAGE(bufoff, gbase, voff) do { _Pragma("unroll") for (int _i = 0; _i < 2; ++_i) \
        __builtin_amdgcn_global_load_lds((const unsigned*)((const char*)(gbase) + (voff)[_i]), (PG8_LAS unsigned*)(lds + (bufoff) + ldsw + _i * 8192), 16, 0, 0); } while (0)
#define PG8_LDA(dst, b, h) do { _Pragma("unroll") for (int m = 0; m < 4; ++m) _Pragma("unroll") for (int k = 0; k < 2; ++k) dst[m][k] = *(const PG8_LAS bf16x8*)(lds + PG8_SA(b, h) + aoff + m * 2048 + k * 1024); } while (0)
#define PG8_LDB(dst, b, h) do { _Pragma("unroll") for (int n = 0; n < 2; ++n) _Pragma("unroll") for (int k = 0; k < 2; ++k) dst[n][k] = *(const PG8_LAS bf16x8*)(lds + PG8_SB(b, h) + boff + n * 2048 + k * 1024); } while (0)
#define PG8_MMA(ai, bj, At, Bt) do { __builtin_amdgcn_s_setprio(1); _Pragma("unroll") for (int m = 0; m < 4; ++m) _Pragma("unroll") for (int n = 0; n < 2; ++n) _Pragma("unroll") for (int k = 0; k < 2; ++k) \
        acc[ai][bj][m][n] = __builtin_amdgcn_mfma_f32_16x16x32_bf16(Bt[n][k], At[m][k], acc[ai][bj][m][n], 0, 0, 0); __builtin_amdgcn_s_setprio(0); } while (0)
#define PG8_WAIT_V(n) asm volatile("s_waitcnt vmcnt(" #n ")" ::: "memory")
#define PG8_WAIT_L(n) asm volatile("s_waitcnt lgkmcnt(" #n ")" ::: "memory")
#define PG8_BAR __builtin_amdgcn_s_barrier()
#define PG8_SCHED __builtin_amdgcn_sched_barrier(0)
    Unit cur, nxt; int ui = 0;
    if (!S.next(0, cur)) return;
    f32x4 acc[2][2][4][2];
#pragma unroll
    for (int a = 0; a < 2; ++a)
#pragma unroll
        for (int b = 0; b < 2; ++b)
#pragma unroll
            for (int m = 0; m < 4; ++m)
#pragma unroll
                for (int n = 0; n < 2; ++n) acc[a][b][m][n] = (f32x4){0.f, 0.f, 0.f, 0.f};
    bf16x8 At[4][2], B0[2][2], B1[2][2];
    const char* cA = (const char*)g.A + (size_t)cur.pm * tstep; const char* cB = (const char*)g.Bt + (size_t)cur.pn * tstep;
    S.a_ready(cur);
    if constexpr (SP2) {
        PG8_STAGE(PG8_SB(0, 0), cB, voffB); PG8_STAGE(PG8_SB(0, 1), cB + hstep, voffB); PG8_STAGE(PG8_SA(0, 0), cA, voffA); PG8_STAGE(PG8_SA(0, 1), cA + hstep, voffA);
        if (wr == 1) PG8_BAR;
        PG8_WAIT_V(2); PG8_BAR;
        PG8_STAGE(PG8_SB(1, 0), cB + kstep, voffB); PG8_STAGE(PG8_SA(1, 0), cA + kstep, voffA); PG8_STAGE(PG8_SB(1, 1), cB + hstep + kstep, voffB);
        PG8_WAIT_V(6); PG8_BAR;
    } else {
        PG8_STAGE(PG8_SB(0, 0), cB, voffB); PG8_STAGE(PG8_SA(0, 0), cA, voffA); PG8_STAGE(PG8_SB(0, 1), cB + hstep, voffB); PG8_STAGE(PG8_SA(0, 1), cA + hstep, voffA);
        if (wr == 1) PG8_BAR;
        PG8_WAIT_V(4); PG8_BAR;
        PG8_STAGE(PG8_SB(1, 0), cB + kstep, voffB); PG8_STAGE(PG8_SA(1, 0), cA + kstep, voffA); PG8_STAGE(PG8_SB(1, 1), cB + hstep + kstep, voffB);
        PG8_WAIT_V(6); PG8_BAR;
    }
    for (;;) {
        const bool has_next = S.next(ui + 1, nxt);
        const char* nA = has_next ? (const char*)g.A + (size_t)nxt.pm * tstep : cA; const char* nB = has_next ? (const char*)g.Bt + (size_t)nxt.pn * tstep : cB;
        for (int t = 0; t < nt; t += 2) {
            const bool last = (t == nt - 2);
            const char* a1 = cA + (size_t)(t + 1) * kstep;
            const char* a2 = last ? nA : cA + (size_t)(t + 2) * kstep; const char* b2 = last ? nB : cB + (size_t)(t + 2) * kstep;
            const char* a3 = a2 + kstep; const char* b3 = b2 + kstep;
            if (last && has_next) S.a_ready(nxt);
            if constexpr (SP2) {
            PG8_LDB(B0, 0, 0); PG8_LDB(B1, 0, 1); PG8_SCHED; PG8_LDA(At, 0, 0); PG8_STAGE(PG8_SA(1, 1), a1 + hstep, voffA);
            PG8_WAIT_V(8); PG8_WAIT_L(0); PG8_BAR; PG8_MMA(0, 0, At, B0); PG8_MMA(0, 1, At, B1); PG8_BAR; PG8_SCHED;
            PG8_LDA(At, 0, 1); PG8_STAGE(PG8_SB(0, 0), b2, voffB); PG8_STAGE(PG8_SB(0, 1), b2 + hstep, voffB); PG8_STAGE(PG8_SA(0, 0), a2, voffA);
            PG8_WAIT_V(8); PG8_WAIT_L(0); PG8_BAR; PG8_MMA(1, 0, At, B0); PG8_MMA(1, 1, At, B1); PG8_BAR; PG8_SCHED;
            PG8_LDB(B0, 1, 0); PG8_LDB(B1, 1, 1); PG8_SCHED; PG8_LDA(At, 1, 0); PG8_STAGE(PG8_SA(0, 1), a2 + hstep, voffA);
            PG8_WAIT_V(8); PG8_WAIT_L(0); PG8_BAR; PG8_MMA(0, 0, At, B0); PG8_MMA(0, 1, At, B1); PG8_BAR; PG8_SCHED;
            PG8_LDA(At, 1, 1); PG8_STAGE(PG8_SB(1, 0), b3, voffB); PG8_STAGE(PG8_SB(1, 1), b3 + hstep, voffB); PG8_STAGE(PG8_SA(1, 0), a3, voffA);
            PG8_WAIT_V(8); PG8_WAIT_L(0); PG8_BAR; PG8_MMA(1, 0, At, B0); PG8_MMA(1, 1, At, B1); PG8_BAR; PG8_SCHED;
            } else {
            PG8_LDB(B0, 0, 0); PG8_SCHED; PG8_LDA(At, 0, 0); PG8_STAGE(PG8_SA(1, 1), a1 + hstep, voffA);
            PG8_WAIT_L(8); PG8_BAR; PG8_WAIT_L(0); PG8_MMA(0, 0, At, B0); PG8_BAR; PG8_SCHED;
            PG8_LDB(B1, 0, 1); PG8_STAGE(PG8_SB(0, 0), b2, voffB);
            PG8_BAR; PG8_WAIT_L(0); PG8_MMA(0, 1, At, B1); PG8_BAR;
            PG8_LDA(At, 0, 1); PG8_STAGE(PG8_SA(0, 0), a2, voffA);
            PG8_BAR; PG8_WAIT_L(0); PG8_MMA(1, 0, At, B0); PG8_BAR; PG8_SCHED;
            PG8_STAGE(PG8_SB(0, 1), b2 + hstep, voffB);
            PG8_WAIT_V(6); PG8_BAR; PG8_MMA(1, 1, At, B1); PG8_BAR;
            PG8_LDB(B0, 1, 0); PG8_SCHED; PG8_LDA(At, 1, 0); PG8_STAGE(PG8_SA(0, 1), a2 + hstep, voffA);
            PG8_WAIT_L(8); PG8_BAR; PG8_WAIT_L(0); PG8_MMA(0, 0, At, B0); PG8_BAR; PG8_SCHED;
            PG8_LDB(B1, 1, 1); PG8_STAGE(PG8_SB(1, 0), b3, voffB);
            PG8_BAR; PG8_WAIT_L(0); PG8_MMA(0, 1, At, B1); PG8_BAR;
            PG8_LDA(At, 1, 1); PG8_STAGE(PG8_SA(1, 0), a3, voffA);
            PG8_BAR; PG8_WAIT_L(0); PG8_MMA(1, 0, At, B0); PG8_BAR; PG8_SCHED;
            PG8_STAGE(PG8_SB(1, 1), b3 + hstep, voffB);
            PG8_WAIT_V(6); PG8_BAR; PG8_MMA(1, 1, At, B1); PG8_BAR;
            }
        }
        if constexpr (ALIGN_EPI) { if (wr == 0) PG8_BAR; }
        if constexpr (!Epi::AFTER_DRAIN) { E(acc, cur, wr, wc, fr, fq); S.done(cur); }
        if (!has_next) break;
#pragma unroll
        for (int a = 0; a < 2; ++a)
#pragma unroll
            for (int b = 0; b < 2; ++b)
#pragma unroll
                for (int m = 0; m < 4; ++m)
#pragma unroll
                    for (int n = 0; n < 2; ++n) acc[a][b][m][n] = (f32x4){0.f, 0.f, 0.f, 0.f};
        cur = nxt; cA = nA; cB = nB; ++ui;
        if constexpr (ALIGN_EPI) { if (wr == 1) PG8_BAR; }
    }
    PG8_WAIT_V(0);
    if constexpr (!ALIGN_EPI) { if (wr == 0) PG8_BAR; }
    PG8_BAR;
    if constexpr (Epi::AFTER_DRAIN) { E.fused(acc, cur, wr, wc, fr, fq, lds, wid, lane); S.done(cur); }
#undef PG8_SA
#undef PG8_SB
#undef PG8_STAGE
#undef PG8_LDA
#undef PG8_LDB
#undef PG8_MMA
#undef PG8_WAIT_V
#undef PG8_WAIT_L
#undef PG8_BAR
#undef PG8_SCHED
}
}

namespace att {
#define MFMA32(a, b, c) __builtin_amdgcn_mfma_f32_32x32x16_bf16((a), (b), (c), 0, 0, 0)
__device__ __forceinline__ int koff(int r, int h) { return 16 * (r >> 3) + 8 * h + (r & 7); }
__device__ __forceinline__ int crow(int r, int h) { return (r & 3) + 8 * (r >> 2) + 4 * h; }
__device__ __forceinline__ float ex2(float x) { return __builtin_amdgcn_exp2f(x); }
__device__ __forceinline__ float wave_sum(float v) {
#pragma unroll
    for (int o = 1; o < 64; o <<= 1) v += __shfl_xor(v, o);
    return v;
}

__device__ __forceinline__ void qk_tile(f32x16 (&s)[2], const LAS unsigned char* Kt, const bf16x8 (&qf)[4], int pi, int h) {
    const int sw = (pi >> 1) & 7;
#pragma unroll
    for (int kb = 0; kb < 2; ++kb) {
        f32x16 a = {};
#pragma unroll
        for (int d0 = 0; d0 < 4; ++d0) {
            const bf16x8 kf = *(const LAS bf16x8*)(Kt + (32 * kb + pi) * 128 + (((2 * d0 + h) ^ sw) << 4));
            a = MFMA32(kf, qf[d0], a);
        }
        s[kb] = a;
    }
}
template <int DVB>
__device__ __forceinline__ void softmax_pv(f32x16 (&s)[2], const LAS unsigned char* VTt, f32x16 (&oT)[DVB], float& m_run, float& l_run, int i31, int h) {
    float mx = s[0][0];
#pragma unroll
    for (int r = 1; r < 16; ++r) mx = fmaxf(mx, s[0][r]);
#pragma unroll
    for (int r = 0; r < 16; ++r) mx = fmaxf(mx, s[1][r]);
    mx = fmaxf(mx, __shfl_xor(mx, 32));
    if (__any(mx > m_run)) {
        const float mn = fmaxf(m_run, mx); const float alpha = ex2(m_run - mn); m_run = mn; l_run *= alpha;
#pragma unroll
        for (int db = 0; db < DVB; ++db)
#pragma unroll
            for (int r = 0; r < 16; ++r) oT[db][r] *= alpha;
    }
    float ps = 0.f;
#pragma unroll
    for (int kb = 0; kb < 2; ++kb)
#pragma unroll
        for (int r = 0; r < 16; ++r) { const float p = ex2(s[kb][r] - m_run); s[kb][r] = p; ps += p; }
    l_run += ps;
    const int sw = (i31 >> 1) & 7;
#pragma unroll
    for (int kb = 0; kb < 2; ++kb)
#pragma unroll
        for (int st = 0; st < 2; ++st) {
            u32x4 pw;
            pw.x = pk_bf16(s[kb][8 * st + 0], s[kb][8 * st + 1]); pw.y = pk_bf16(s[kb][8 * st + 2], s[kb][8 * st + 3]);
            pw.z = pk_bf16(s[kb][8 * st + 4], s[kb][8 * st + 5]); pw.w = pk_bf16(s[kb][8 * st + 6], s[kb][8 * st + 7]);
            const bf16x8 pb = __builtin_bit_cast(bf16x8, pw);
#pragma unroll
            for (int db = 0; db < DVB; ++db) {
                const bf16x8 vf = *(const LAS bf16x8*)(VTt + (32 * db + i31) * 128 + (((4 * kb + 2 * st + h) ^ sw) << 4));
                oT[db] = MFMA32(vf, pb, oT[db]);
            }
        }
}

constexpr int L0_UNITS = 2176;
constexpr int L0_BUF = 16384;
constexpr int L0_RPB_OFF = 98304;
struct L0Args { const bf16_t* QK; const bf16_t* VT; bf16_t* Y; const float* sink; const float* rpb; };

__device__ __forceinline__ void attn_l0_phase(LAS unsigned char* lds, const L0Args P, int bid, int G, int tid) {
    const int lane = tid & 63, wid = __builtin_amdgcn_readfirstlane(tid >> 6), i31 = lane & 31, h = lane >> 5;
    const int pi = (i31 & 0x13) | ((i31 & 4) << 1) | ((i31 & 8) >> 1);
    const int g = wid >> 1, jh = wid & 1;
    LAS float* rpbl = (LAS float*)(lds + L0_RPB_OFF);
    for (int i = tid; i < 8 * 15 * 31; i += 512) rpbl[i] = P.rpb[i] * LOG2E_F;
    __syncthreads();
    const int srow = tid >> 3, sch = tid & 7;
    const int sdst = srow * 128 + ((sch ^ ((srow >> 1) & 7)) << 4);
    for (int u = bid; u < L0_UNITS; u += G) {
        int mode, b, kvh, qx, isB;
        if (u < 1024) { mode = 0; b = u >> 7; kvh = (u >> 6) & 1; qx = u & 63; isB = 1; }
        else if (u < 2048) { const int v = u - 1024; mode = 1; b = v >> 7; kvh = (v >> 6) & 1; qx = v & 63; isB = 0; }
        else { const int v = u - 2048; mode = 2; b = v >> 4; kvh = (v >> 2) & 1; isB = (v >> 3) & 1; qx = v & 3; }
        int lat0 = 0, nlat = 0, qtok0;
        if (mode == 0) { lat0 = min(max(qx - 4, 0), 56); nlat = 8; qtok0 = b * SEQ + 64 * qx; }
        else if (mode == 1) { lat0 = max(qx - 2, 0); nlat = min(qx + 2, 63) - lat0 + 1; qtok0 = b * SEQ + 64 * qx; }
        else { qtok0 = MLAT + b * CTXL + 64 * qx; }
        const int nt = nlat + 4;
        const int hq = 4 * kvh + g;
        const int qcol = isB * 512 + hq * 64, kcol = (isB ? 1152 : 1024) + 64 * kvh, vrow = isB * 128 + 64 * kvh;
        const int qtok = qtok0 + 32 * jh + i31;
        bf16x8 qf[4];
#pragma unroll
        for (int d0 = 0; d0 < 4; ++d0) qf[d0] = *(const bf16x8*)(P.QK + (size_t)qtok * NQK0 + qcol + 16 * d0 + 8 * h);
        float m_run, l_run;
        if (!isB) { m_run = P.sink[hq] * LOG2E_F; l_run = (h == 0) ? 1.f : 0.f; } else { m_run = -1e30f; l_run = 0.f; }
        f32x16 oT[2]; oT[0] = f32x16{}; oT[1] = f32x16{};
        u32x4 stK, stV;
        { const int tok0 = (0 < nlat) ? b * SEQ + 64 * lat0 : MLAT + b * CTXL;
          stK = *(const u32x4*)(P.QK + (size_t)(tok0 + srow) * NQK0 + kcol + sch * 8);
          stV = *(const u32x4*)(P.VT + (size_t)(vrow + srow) * MTOT + tok0 + sch * 8);
          *(LAS u32x4*)(lds + sdst) = stK; *(LAS u32x4*)(lds + 8192 + sdst) = stV; }
        __syncthreads();
        for (int t = 0; t < nt; ++t) {
            const LAS unsigned char* buf = lds + (t & 1) * L0_BUF;
            if (t + 1 < nt) {
                const int t1 = t + 1;
                const int tok0 = (t1 < nlat) ? b * SEQ + 64 * (lat0 + t1) : MLAT + b * CTXL + 64 * (t1 - nlat);
                stK = *(const u32x4*)(P.QK + (size_t)(tok0 + srow) * NQK0 + kcol + sch * 8);
                stV = *(const u32x4*)(P.VT + (size_t)(vrow + srow) * MTOT + tok0 + sch * 8);
            }
            f32x16 s[2];
            qk_tile(s, buf, qf, pi, h);
            if (t < nlat) {
                if (mode == 0) {
                    const int krow = lat0 + t, c = 32 * jh + i31, cstart = min(max(c - 8, 0), 48);
                    const LAS float* tab = rpbl + (hq * 15 + (krow - qx + 7)) * 31 + (8 * h - c + 15);
                    const int vb = 8 * h - cstart;
#pragma unroll
                    for (int kb = 0; kb < 2; ++kb)
#pragma unroll
                        for (int r = 0; r < 16; ++r) {
                            const int kc = 32 * kb + 16 * (r >> 3) + (r & 7);
                            const float bias = tab[kc];
                            s[kb][r] = ((unsigned)(kc + vb) < 16u) ? s[kb][r] + bias : -INFINITY;
                        }
                } else {
                    const int tl = lat0 + t;
                    if (tl == qx - 2 || tl == qx + 2) {
                        const int dq = 64 * qx + 32 * jh + i31 - 64 * tl - 8 * h;
#pragma unroll
                        for (int kb = 0; kb < 2; ++kb)
#pragma unroll
                            for (int r = 0; r < 16; ++r) {
                                const int kc = 32 * kb + 16 * (r >> 3) + (r & 7);
                                const int d = dq - kc;
                                if (d > 128 || d < -128) s[kb][r] = -INFINITY;
                            }
                    }
                }
            }
            softmax_pv<2>(s, buf + 8192, oT, m_run, l_run, i31, h);
            if (t + 1 < nt) { LAS unsigned char* nb = lds + ((t + 1) & 1) * L0_BUF; *(LAS u32x4*)(nb + sdst) = stK; *(LAS u32x4*)(nb + 8192 + sdst) = stV; }
            __syncthreads();
        }
        const float l = l_run + __shfl_xor(l_run, 32);
        const float inv = 1.0f / l;
        bf16_t* yp = P.Y + (size_t)qtok * DM + qcol;
#pragma unroll
        for (int db = 0; db < 2; ++db)
#pragma unroll
            for (int rg = 0; rg < 4; ++rg) {
                u32x2 w; w.x = pk_bf16(oT[db][4 * rg] * inv, oT[db][4 * rg + 1] * inv); w.y = pk_bf16(oT[db][4 * rg + 2] * inv, oT[db][4 * rg + 3] * inv);
                *(u32x2*)(yp + 32 * db + 8 * rg + 4 * h) = w;
            }
    }
}

constexpr int DF_BUF = 32768;
constexpr int DF_X_OFF = 65536;
struct DiffArgs { const bf16_t* QK; const bf16_t* VT; bf16_t* Y; const float* lq1; const float* lk1; const float* lq2; const float* lk2; const float* subg; };

__device__ __forceinline__ void attn_diff_phase(LAS unsigned char* lds, const DiffArgs P, int bid, int G, int tid) {
    const int lane = tid & 63, wid = __builtin_amdgcn_readfirstlane(tid >> 6), i31 = lane & 31, h = lane >> 5;
    const int pi = (i31 & 0x13) | ((i31 & 4) << 1) | ((i31 & 8) >> 1);
    const int msub = wid & 1, jg = wid >> 1;
    const float lam = expf(wave_sum(P.lq1[lane] * P.lk1[lane])) - expf(wave_sum(P.lq2[lane] * P.lk2[lane])) + LAM_INIT;
    int sdK[2], sdV[2], skr[2], skc[2], sve[2], svc[2];
#pragma unroll
    for (int i = 0; i < 2; ++i) {
        const int ci = tid + 512 * i;
        const int kr = ci >> 4, c16 = ci & 15; skr[i] = kr; skc[i] = c16;
        sdK[i] = (c16 >> 3) * 8192 + kr * 128 + (((c16 & 7) ^ ((kr >> 1) & 7)) << 4);
        const int e = ci >> 3, ch = ci & 7; sve[i] = e; svc[i] = ch;
        sdV[i] = 16384 + e * 128 + ((ch ^ ((e >> 1) & 7)) << 4);
    }
    const int nunits = NBATCH * 8 * 32;
    for (int it = 0; ; ++it) {
        int pairIdx, qb;
        if (G == 256) { if (it >= 8) break; pairIdx = (bid & 7) * 8 + it; qb = bid >> 3; }
        else { const int u = bid + it * G; if (u >= nunits) break; pairIdx = u >> 5; qb = u & 31; }
        const int b = pairIdx >> 3, hd = pairIdx & 7;
        const int qtok = b * SEQ + 128 * qb + 32 * jg + i31;
        bf16x8 qf[4];
#pragma unroll
        for (int d0 = 0; d0 < 4; ++d0) qf[d0] = *(const bf16x8*)(P.QK + (size_t)qtok * NQK1 + hd * 128 + msub * 64 + 16 * d0 + 8 * h);
        float m_run = -1e30f, l_run = 0.f;
        f32x16 oT[4]; oT[0] = f32x16{}; oT[1] = f32x16{}; oT[2] = f32x16{}; oT[3] = f32x16{};
        const bf16_t* kbase = P.QK + 1024 + hd * 128;
        const bf16_t* vbase = P.VT + (size_t)(hd * 128) * MTOT;
        u32x4 stK[2], stV[2];
        { const int tok0 = b * SEQ;
#pragma unroll
          for (int i = 0; i < 2; ++i) { stK[i] = *(const u32x4*)(kbase + (size_t)(tok0 + skr[i]) * NQK1 + skc[i] * 8); stV[i] = *(const u32x4*)(vbase + (size_t)sve[i] * MTOT + tok0 + svc[i] * 8); }
#pragma unroll
          for (int i = 0; i < 2; ++i) { *(LAS u32x4*)(lds + sdK[i]) = stK[i]; *(LAS u32x4*)(lds + sdV[i]) = stV[i]; } }
        __syncthreads();
        constexpr int NT = 68;
        for (int t = 0; t < NT; ++t) {
            const LAS unsigned char* buf = lds + (t & 1) * DF_BUF;
            if (t + 1 < NT) {
                const int t1 = t + 1;
                const int tok0 = (t1 < 64) ? b * SEQ + 64 * t1 : MLAT + b * CTXL + 64 * (t1 - 64);
#pragma unroll
                for (int i = 0; i < 2; ++i) { stK[i] = *(const u32x4*)(kbase + (size_t)(tok0 + skr[i]) * NQK1 + skc[i] * 8); stV[i] = *(const u32x4*)(vbase + (size_t)sve[i] * MTOT + tok0 + svc[i] * 8); }
            }
            f32x16 s[2];
            qk_tile(s, buf + msub * 8192, qf, pi, h);
            softmax_pv<4>(s, buf + 16384, oT, m_run, l_run, i31, h);
            if (t + 1 < NT) { LAS unsigned char* nb = lds + ((t + 1) & 1) * DF_BUF;
#pragma unroll
                for (int i = 0; i < 2; ++i) { *(LAS u32x4*)(nb + sdK[i]) = stK[i]; *(LAS u32x4*)(nb + sdV[i]) = stV[i]; } }
            __syncthreads();
        }
        const float l = l_run + __shfl_xor(l_run, 32);
        const float inv = 1.0f / l;
        LAS float* X = (LAS float*)(lds + DF_X_OFF) + jg * 4096;
        if (msub == 1) {
            const float f = lam * inv;
#pragma unroll
            for (int db = 0; db < 4; ++db)
#pragma unroll
                for (int r = 0; r < 16; ++r) X[(32 * db + crow(r, h)) * 32 + i31] = oT[db][r] * f;
        }
        __syncthreads();
        if (msub == 0) {
            float ssq = 0.f;
#pragma unroll
            for (int db = 0; db < 4; ++db)
#pragma unroll
                for (int r = 0; r < 16; ++r) { const float d = oT[db][r] * inv - X[(32 * db + crow(r, h)) * 32 + i31]; oT[db][r] = d; ssq += d * d; }
            ssq += __shfl_xor(ssq, 32);
            const float rn = rsqrtf(ssq * (1.0f / 128.0f) + EPS_F) * (1.0f - LAM_INIT);
            bf16_t* yp = P.Y + (size_t)qtok * DM + hd * 128;
#pragma unroll
            for (int db = 0; db < 4; ++db)
#pragma unroll
                for (int rg = 0; rg < 4; ++rg) {
                    const int e0 = 32 * db + 8 * rg + 4 * h;
                    const f32x4 gq = *(const f32x4*)(P.subg + e0);
                    u32x2 w; w.x = pk_bf16(oT[db][4 * rg] * rn * gq[0], oT[db][4 * rg + 1] * rn * gq[1]); w.y = pk_bf16(oT[db][4 * rg + 2] * rn * gq[2], oT[db][4 * rg + 3] * rn * gq[3]);
                    *(u32x2*)(yp + e0) = w;
                }
        }
        __syncthreads();
    }
}
#undef MFMA32
}

constexpr size_t MiB = 1u << 20;
constexpr size_t WS_MOD = 0;
constexpr size_t WS_ROPE = 512 * 1024;
constexpr size_t WS_BIAS = 1 * MiB;
constexpr size_t WS_SS = 4 * MiB;
constexpr size_t WS_WQK0 = 8 * MiB, WS_WV0 = 11 * MiB, WS_WO0 = 12 * MiB, WS_W10 = 14 * MiB, WS_W20 = 22 * MiB;
constexpr size_t WS_WQK1 = 30 * MiB, WS_WV1 = 34 * MiB, WS_WO1 = 36 * MiB, WS_W11 = 38 * MiB, WS_W21 = 46 * MiB;
constexpr size_t WS_HR = 56 * MiB;
constexpr size_t WS_QK = 192 * MiB;
constexpr size_t WS_VT = 328 * MiB;
constexpr size_t WS_Y = 396 * MiB;
constexpr size_t WS_H = 192 * MiB;
constexpr size_t WS_END = 464 * MiB;
constexpr int BO_QK0 = 0, BO_V0 = BO_QK0 + 9 * NQK0, BO_UP0 = BO_V0 + 9 * NV0, BO_QK1 = BO_UP0 + 9 * DFF, BO_V1 = BO_QK1 + 9 * NQK1, BO_UP1 = BO_V1 + 9 * NV1;
constexpr int LDS_BYTES = 147456;
constexpr int NPHASE = 13;

__device__ __forceinline__ float silu_f(float v) { return v / (1.0f + expf(-v)); }
__device__ __forceinline__ void even_map(int c, int& isv, int& r) {
    if (c < 512) { isv = 0; r = c; } else if (c < 640) { isv = 0; r = 1024 + (c - 512); } else if (c < 768) { isv = 1; r = c - 640; }
    else if (c < 1280) { isv = 0; r = 512 + (c - 768); } else if (c < 1408) { isv = 0; r = 1152 + (c - 1280); } else { isv = 1; r = 128 + (c - 1408); }
}
__device__ __forceinline__ void gemv9_item(const float* __restrict__ W, int ldw, int csrc0, const LAS float* vec, LAS float* red, float* out, int ostride, int cdst0, const float* addb, int tid) {
    const int col = tid & 63, kg = tid >> 6;
    float a0 = 0.f, a1 = 0.f, a2 = 0.f, a3 = 0.f, a4 = 0.f, a5 = 0.f, a6 = 0.f, a7 = 0.f, a8 = 0.f;
    const float* wp = W + (size_t)(kg * 128) * ldw + csrc0 + col;
    const LAS float* vp = vec + kg * 128;
#pragma unroll 8
    for (int k = 0; k < 128; ++k) {
        const float w = wp[(size_t)k * ldw];
        a0 += vp[k] * w; a1 += vp[1024 + k] * w; a2 += vp[2048 + k] * w; a3 += vp[3072 + k] * w; a4 += vp[4096 + k] * w;
        a5 += vp[5120 + k] * w; a6 += vp[6144 + k] * w; a7 += vp[7168 + k] * w; a8 += vp[8192 + k] * w;
    }
    LAS float* rp = red + kg * 576 + col;
    rp[0] = a0; rp[64] = a1; rp[128] = a2; rp[192] = a3; rp[256] = a4; rp[320] = a5; rp[384] = a6; rp[448] = a7; rp[512] = a8;
    __syncthreads();
    for (int idx = tid; idx < 576; idx += 512) {
        const int b = idx >> 6, c = idx & 63; float s = 0.f;
#pragma unroll
        for (int g2 = 0; g2 < 8; ++g2) s += red[g2 * 576 + idx];
        if (addb) s += addb[csrc0 + c];
        out[(size_t)b * ostride + cdst0 + c] = s;
    }
    __syncthreads();
}
__device__ __forceinline__ void transpose_item(const float* __restrict__ W, int K, int N, int k0, int n0, bf16_t* dst, LAS float* scr, int lane) {
#pragma unroll 8
    for (int i = 0; i < 32; ++i) { const int kk = 2 * i + (lane >> 5); scr[kk * 33 + (lane & 31)] = W[(size_t)(k0 + kk) * N + n0 + (lane & 31)]; }
    asm volatile("s_waitcnt lgkmcnt(0)" ::: "memory");
    const int c = lane & 7;
#pragma unroll
    for (int j = 0; j < 4; ++j) { const int n = (lane >> 3) + 8 * j; const LAS float* s = scr + (8 * c) * 33 + n;
        u32x4 o; o.x = pk_bf16(s[0 * 33], s[1 * 33]); o.y = pk_bf16(s[2 * 33], s[3 * 33]); o.z = pk_bf16(s[4 * 33], s[5 * 33]); o.w = pk_bf16(s[6 * 33], s[7 * 33]);
        *(u32x4*)(dst + (size_t)n * K + k0 + 8 * c) = o; }
    asm volatile("s_waitcnt lgkmcnt(0)" ::: "memory");
}
__device__ __forceinline__ void sincos_small(double a, float& c, float& s) {
    const double TWO_PI = 6.283185307179586476925287;
    const double k = __builtin_rint(a / TWO_PI);
    const double x = a - k * TWO_PI, x2 = x * x;
    double ts = 1.0, tc = 1.0;
    for (int j = 15; j >= 1; --j) { ts = 1.0 - x2 / (double)((2 * j) * (2 * j + 1)) * ts; tc = 1.0 - x2 / (double)((2 * j - 1) * (2 * j)) * tc; }
    s = (float)(x * ts); c = (float)tc;
}

struct Args { const float* in[22]; float* out; unsigned char* ws; int ph_lo, ph_hi; };

__global__ void __launch_bounds__(512, 2) dit_fwd(Args args) {
    extern __shared__ __attribute__((aligned(16))) unsigned char lds_raw[];
    LAS unsigned char* lds = (LAS unsigned char*)lds_raw;
    const int tid = threadIdx.x, lane = tid & 63, wave = __builtin_amdgcn_readfirstlane(tid >> 6);
    const int bid = blockIdx.x, G = gridDim.x;
    const int gw = bid * 8 + wave, NGW = G * 8;
    unsigned char* ws = args.ws;
    const float* x = args.in[0]; const float* cvec = args.in[1]; const float* ctx = args.in[2]; const float* c_ctx = args.in[3];
    const float* ada_w = args.in[4]; const float* ada_b = args.in[5]; const float* norm1_g = args.in[6]; const float* norm2_g = args.in[7];
    const float* even_w_in = args.in[8]; const float* even_w_out = args.in[9]; const float* a_sink = args.in[10]; const float* b_rpb = args.in[11];
    const float* odd_w_in = args.in[12]; const float* odd_w_out = args.in[13];
    const float* mlp_w1 = args.in[19]; const float* mlp_w2 = args.in[20]; const float* final_g = args.in[21];
    float* mod = (float*)(ws + WS_MOD); float* ropetab = (float*)(ws + WS_ROPE); float* biasb = (float*)(ws + WS_BIAS); float* ssb = (float*)(ws + WS_SS);
    bf16_t* Wqk0 = (bf16_t*)(ws + WS_WQK0); bf16_t* Wv0 = (bf16_t*)(ws + WS_WV0); bf16_t* Wo0 = (bf16_t*)(ws + WS_WO0); bf16_t* W10 = (bf16_t*)(ws + WS_W10); bf16_t* W20 = (bf16_t*)(ws + WS_W20);
    bf16_t* Wqk1 = (bf16_t*)(ws + WS_WQK1); bf16_t* Wv1 = (bf16_t*)(ws + WS_WV1); bf16_t* Wo1 = (bf16_t*)(ws + WS_WO1); bf16_t* W11 = (bf16_t*)(ws + WS_W11); bf16_t* W21 = (bf16_t*)(ws + WS_W21);
    float* HR = (float*)(ws + WS_HR); bf16_t* QK = (bf16_t*)(ws + WS_QK); bf16_t* VT = (bf16_t*)(ws + WS_VT); bf16_t* Y = (bf16_t*)(ws + WS_Y); bf16_t* Hb = (bf16_t*)(ws + WS_H);
    bf16_t* XG = (bf16_t*)args.out;
    const int lo = args.ph_lo, hi = args.ph_hi;
#define IN(k) (lo <= (k) && (k) < hi)
#define SEAM(k) do { if (IN(k) && IN((k) + 1)) { cg::this_grid().sync(); } } while (0)

    if (IN(0)) {
        if (bid < 192) {
            LAS float* vec = (LAS float*)lds; LAS float* red = (LAS float*)(lds + 40960);
            for (int i = tid; i < 9 * 1024; i += 512) { const float v = (i < 8192) ? cvec[i] : c_ctx[i - 8192]; vec[i] = silu_f(v); }
            __syncthreads();
            const int l = bid / 96, cb = bid % 96;
            gemv9_item(ada_w + (size_t)l * DM * 6144, 6144, cb * 64, vec, red, mod + (size_t)l * 9 * 6144, 6144, cb * 64, ada_b + (size_t)l * 6144, tid);
        }
        if (bid == G - 1) {
            for (int idx = tid; idx < 1024; idx += 512) {
                const int pos = idx >> 4, i = idx & 15; double f = 1.0;
                for (int q = 0; q < i; ++q) f *= 0.56234132519034908;
                float c, s; sincos_small((double)pos * f, c, s);
                ropetab[2 * idx] = c; ropetab[2 * idx + 1] = s;
            }
        }
        __syncthreads();
        LAS float* scr = (LAS float*)(lds + wave * 8448);
        for (int it = gw; it < 11520; it += NGW) {
            int r = it;
            if (r < 768) { const int kb = r / 48, nb = r % 48; int isv, dr; even_map(32 * nb, isv, dr);
                transpose_item(even_w_in, DM, 1536, 64 * kb, 32 * nb, (isv ? Wv0 : Wqk0) + (size_t)dr * DM, scr, lane); continue; } r -= 768;
            if (r < 512) { const int kb = r / 32, nb = r % 32; transpose_item(even_w_out, DM, DM, 64 * kb, 32 * nb, Wo0 + (size_t)(32 * nb) * DM, scr, lane); continue; } r -= 512;
            if (r < 1536) { const int kb = r / 96, nb = r % 96; const int n0 = 32 * nb;
                transpose_item(odd_w_in, DM, 3072, 64 * kb, n0, n0 < 2048 ? Wqk1 + (size_t)n0 * DM : Wv1 + (size_t)(n0 - 2048) * DM, scr, lane); continue; } r -= 1536;
            if (r < 512) { const int kb = r / 32, nb = r % 32; transpose_item(odd_w_out, DM, DM, 64 * kb, 32 * nb, Wo1 + (size_t)(32 * nb) * DM, scr, lane); continue; } r -= 512;
            if (r < 4096) { const int l = r / 2048, q = r % 2048, kb = q / 128, nb = q % 128;
                transpose_item(mlp_w1 + (size_t)l * DM * DFF, DM, DFF, 64 * kb, 32 * nb, (l ? W11 : W10) + (size_t)(32 * nb) * DM, scr, lane); continue; } r -= 4096;
            { const int l = r / 2048, q = r % 2048, kb = q / 32, nb = q % 32;
                transpose_item(mlp_w2 + (size_t)l * DFF * DM, DFF, DM, 64 * kb, 32 * nb, (l ? W21 : W20) + (size_t)(32 * nb) * DFF, scr, lane); }
        }
    }
    SEAM(0);
    if (IN(1)) {
        if (bid < 200) {
            LAS float* vec = (LAS float*)lds; LAS float* red = (LAS float*)(lds + 40960);
            int l, soff; if (bid < 24) { l = 0; soff = 0; } else if (bid < 88) { l = 0; soff = 3072; } else if (bid < 136) { l = 1; soff = 0; } else { l = 1; soff = 3072; }
            for (int i = tid; i < 9 * 1024; i += 512) vec[i] = mod[(size_t)(l * 9 + (i >> 10)) * 6144 + soff + (i & 1023)];
            __syncthreads();
            if (bid < 24) { const int c0 = 64 * bid; int isv, dr; even_map(c0, isv, dr);
                gemv9_item(even_w_in, 1536, c0, vec, red, biasb + (isv ? BO_V0 : BO_QK0), isv ? NV0 : NQK0, dr, nullptr, tid); }
            else if (bid < 88) { const int c0 = 64 * (bid - 24); gemv9_item(mlp_w1, DFF, c0, vec, red, biasb + BO_UP0, DFF, c0, nullptr, tid); }
            else if (bid < 136) { const int c0 = 64 * (bid - 88);
                if (c0 < 2048) gemv9_item(odd_w_in, 3072, c0, vec, red, biasb + BO_QK1, NQK1, c0, nullptr, tid);
                else gemv9_item(odd_w_in, 3072, c0, vec, red, biasb + BO_V1, NV1, c0 - 2048, nullptr, tid); }
            else { const int c0 = 64 * (bid - 136); gemv9_item(mlp_w1 + (size_t)DM * DFF, DFF, c0, vec, red, biasb + BO_UP1, DFF, c0, nullptr, tid); }
        }
        for (int row = gw; row < MTOT; row += NGW) {
            const float* src = row < MLAT ? x + (size_t)row * DM : ctx + (size_t)(row - MLAT) * DM;
            const int b = row < MLAT ? (row >> 12) : 8;
            const float* scl = mod + (size_t)b * 6144 + 1024;
            float ssum = 0.f;
#pragma unroll
            for (int j = 0; j < 4; ++j) {
                const int k = 4 * lane + 256 * j;
                const f32x4 v = *(const f32x4*)(src + k), g = *(const f32x4*)(norm1_g + k), s = *(const f32x4*)(scl + k);
                ssum += (v[0] * v[0] + v[1] * v[1]) + (v[2] * v[2] + v[3] * v[3]);
                const f32x4 y = v * (g * (s + 1.0f));
                u32x2 w; w.x = pk_bf16(y[0], y[1]); w.y = pk_bf16(y[2], y[3]);
                *(u32x2*)(XG + (size_t)row * DM + k) = w;
            }
            ssum = att::wave_sum(ssum);
            if (lane < 16) ssb[(size_t)row * 16 + lane] = (lane == 0) ? ssum : 0.f;
        }
    }
    SEAM(1);
    if (IN(2)) {
        { pg8::Gemm g{XG, Wqk0, MTOT, NQK0, DM}; pg8::StaticOrder S; S.init(MTOT, NQK0, G, bid);
          pg8::EpiQK E{QK, NQK0, ssb, biasb + BO_QK0, 0x10Fu, 0x0FFu, ropetab};
          pg8::gemm_phase<pg8::EpiQK, pg8::StaticOrder, true, true>(lds, g, S, E); }
        { pg8::Gemm g{Wv0, XG, NV0, MTOT, DM}; pg8::StaticOrder S; S.init(NV0, MTOT, G, bid);
          pg8::EpiVT E{VT, MTOT, ssb, biasb + BO_V0, NV0};
          pg8::gemm_phase<pg8::EpiVT, pg8::StaticOrder, true, true>(lds, g, S, E); }
    }
    SEAM(2);
    if (IN(3)) { att::L0Args P{QK, VT, Y, a_sink, b_rpb}; att::attn_l0_phase(lds, P, bid, G, tid); }
    SEAM(3);
    if (IN(4)) {
        pg8::Gemm g{Y, Wo0, MTOT, DM, DM}; pg8::StaticOrder S; S.init(MTOT, DM, G, bid);
        pg8::EpiRes E{x, ctx, HR, XG, ssb, mod + 2048, mod + 4096, norm2_g};
        pg8::gemm_phase<pg8::EpiRes, pg8::StaticOrder, true, true>(lds, g, S, E);
    }
    SEAM(4);
    if (IN(5)) {
        pg8::Gemm g{XG, W10, MTOT, DFF, DM}; pg8::StaticOrder S; S.init(MTOT, DFF, G, bid);
        pg8::EpiUp E{Hb, ssb, biasb + BO_UP0};
        pg8::gemm_phase<pg8::EpiUp, pg8::StaticOrder, true, true>(lds, g, S, E);
    }
    SEAM(5);
    if (IN(6)) {
        pg8::Gemm g{Hb, W20, MTOT, DM, DFF}; pg8::StaticOrder S; S.init(MTOT, DM, G, bid);
        pg8::EpiRes E{HR, HR + (size_t)MLAT * DM, HR, XG, ssb, mod + 5120, mod + 9 * 6144 + 1024, norm1_g + DM};
        pg8::gemm_phase<pg8::EpiRes, pg8::StaticOrder, true, true>(lds, g, S, E);
    }
    SEAM(6);
    if (IN(7)) {
        { pg8::Gemm g{XG, Wqk1, MTOT, NQK1, DM}; pg8::StaticOrder S; S.init(MTOT, NQK1, G, bid);
          pg8::EpiQK E{QK, NQK1, ssb, biasb + BO_QK1, 0xFFFFu, 0x00FFu, ropetab};
          pg8::gemm_phase<pg8::EpiQK, pg8::StaticOrder, true, true>(lds, g, S, E); }
        { pg8::Gemm g{Wv1, XG, NV1, MTOT, DM}; pg8::StaticOrder S; S.init(NV1, MTOT, G, bid);
          pg8::EpiVT E{VT, MTOT, ssb, biasb + BO_V1, NV1};
          pg8::gemm_phase<pg8::EpiVT, pg8::StaticOrder, true, true>(lds, g, S, E); }
    }
    SEAM(7);
    if (IN(8)) { att::DiffArgs P{QK, VT, Y, args.in[14], args.in[15], args.in[16], args.in[17], args.in[18]}; att::attn_diff_phase(lds, P, bid, G, tid); }
    SEAM(8);
    if (IN(9)) {
        pg8::Gemm g{Y, Wo1, MLAT, DM, DM}; pg8::StaticOrder S; S.init(MLAT, DM, G, bid);
        pg8::EpiRes E{HR, HR, HR, XG, ssb, mod + 9 * 6144 + 2048, mod + 9 * 6144 + 4096, norm2_g + DM};
        pg8::gemm_phase<pg8::EpiRes, pg8::StaticOrder, true, true>(lds, g, S, E);
    }
    SEAM(9);
    if (IN(10)) {
        pg8::Gemm g{XG, W11, MLAT, DFF, DM}; pg8::StaticOrder S; S.init(MLAT, DFF, G, bid);
        pg8::EpiUp E{Hb, ssb, biasb + BO_UP1};
        pg8::gemm_phase<pg8::EpiUp, pg8::StaticOrder, true, true>(lds, g, S, E);
    }
    SEAM(10);
    if (IN(11)) {
        pg8::Gemm g{Hb, W21, MLAT, DM, DFF}; pg8::StaticOrder S; S.init(MLAT, DM, G, bid);
        pg8::EpiRes E{HR, HR, args.out, nullptr, ssb, mod + 9 * 6144 + 5120, nullptr, nullptr};
        pg8::gemm_phase<pg8::EpiRes, pg8::StaticOrder, true, true>(lds, g, S, E);
    }
    SEAM(11);
    if (IN(12)) {
        for (int row = gw; row < MLAT; row += NGW) {
            const float rs = pg8::row_rstd(ssb, row);
            float* op = args.out + (size_t)row * DM;
#pragma unroll
            for (int j = 0; j < 4; ++j) { const int k = 4 * lane + 256 * j; const f32x4 v = *(const f32x4*)(op + k), g = *(const f32x4*)(final_g + k); *(f32x4*)(op + k) = v * rs * g; }
        }
    }
#undef IN
#undef SEAM
}

#ifndef N_LAUNCH_MODE
#define N_LAUNCH_MODE 0
#endif
extern "C" void kernel_launch(void* const* d_in, const int* in_sizes, int n_in, void* d_out, int out_size, void* d_ws, size_t ws_size, hipStream_t stream) {
    static int grid = 0;
    if (grid == 0) {
        if (n_in != 22 || out_size != MLAT * DM || ws_size < WS_END) { fprintf(stderr, "kernel_launch: unexpected shapes (n_in %d out %d ws %zu)\n", n_in, out_size, ws_size); grid = -1; return; }
        int dev = 0, cus = 0, per_cu = 0;
        if (hipGetDevice(&dev) != hipSuccess || hipDeviceGetAttribute(&cus, hipDeviceAttributeMultiprocessorCount, dev) != hipSuccess) { grid = -1; return; }
        if (hipFuncSetAttribute((const void*)dit_fwd, hipFuncAttributeMaxDynamicSharedMemorySize, LDS_BYTES) != hipSuccess) { fprintf(stderr, "kernel_launch: hipFuncSetAttribute failed\n"); grid = -1; return; }
        if (hipOccupancyMaxActiveBlocksPerMultiprocessor(&per_cu, (const void*)dit_fwd, 512, LDS_BYTES) != hipSuccess || per_cu < 1) { fprintf(stderr, "kernel_launch: occupancy query says %d\n", per_cu); per_cu = 1; }
        (void)hipGetLastError();
        grid = cus;
        if (grid % 8 != 0 || grid < 8) { fprintf(stderr, "kernel_launch: unexpected CU count %d\n", cus); }
    }
    if (grid < 0) return;
    Args a{};
    for (int i = 0; i < 22; ++i) a.in[i] = (const float*)d_in[i];
    a.out = (float*)d_out; a.ws = (unsigned char*)d_ws;
#if N_LAUNCH_MODE == 0
    a.ph_lo = 0; a.ph_hi = NPHASE;
    void* kargs[] = {&a};
    hipError_t e = hipLaunchCooperativeKernel((const void*)dit_fwd, dim3(grid), dim3(512), kargs, LDS_BYTES, stream);
    if (e != hipSuccess) fprintf(stderr, "kernel_launch: cooperative launch failed: %s (grid %d)\n", hipGetErrorString(e), grid);
#else
    for (int p = 0; p < NPHASE; ++p) { a.ph_lo = p; a.ph_hi = p + 1; hipLaunchKernelGGL(dit_fwd, dim3(grid), dim3(512), LDS_BYTES, stream, a); }
#endif
}
```

```cpp
#include <hip/hip_runtime.h>
#include <hip/hip_cooperative_groups.h>
#include <cstdio>
#include <cstdint>
namespace cg = cooperative_groups;

#define LAS __attribute__((address_space(3)))
typedef unsigned short bf16_t;
typedef short bf16x8 __attribute__((ext_vector_type(8)));
typedef float f32x4 __attribute__((ext_vector_type(4)));
typedef float f32x16 __attribute__((ext_vector_type(16)));
typedef unsigned u32x4 __attribute__((ext_vector_type(4)));
typedef unsigned u32x2 __attribute__((ext_vector_type(2)));
typedef float f32x2_t __attribute__((ext_vector_type(2)));
typedef __bf16 bf16x2_t __attribute__((ext_vector_type(2)));
__device__ __forceinline__ unsigned pk_bf16(float lo, float hi) { f32x2_t v = {lo, hi}; bf16x2_t b = __builtin_convertvector(v, bf16x2_t); return __builtin_bit_cast(unsigned, b); }

constexpr int DM = 1024, NBATCH = 8, SEQ = 4096, CTXL = 256, DFF = 4096;
constexpr int MLAT = NBATCH * SEQ;
constexpr int MCTX = NBATCH * CTXL;
constexpr int MTOT = MLAT + MCTX;
constexpr float EPS_F = 1e-6f;
constexpr float LOG2E_F = 1.4426950408889634f;
constexpr float QSCALE = 0.125f * LOG2E_F;
constexpr float LAM_INIT = 0.35550906759096926f;
constexpr int NQK0 = 1280, NV0 = 256, NQK1 = 2048, NV1 = 1024;

namespace pg8 {
#define PG8_LAS __attribute__((address_space(3)))
constexpr int BM = 256, BK = 64, HALF = 128, HTB = HALF * BK * 2  , STAGE_BYTES = 8 * HTB, NXCD = 8, WGM = 8;

__host__ __device__ __forceinline__ int lds_byte(int r, int c) { const int st = (r >> 4) * 2 + (c >> 5), rr = r & 15, cc = c & 31, ob = rr * 64 + cc * 2; return st * 1024 + (ob ^ (((ob >> 9) & 1) << 5)); }
__host__ __device__ __forceinline__ void stage_rc(int b, int& R, int& C) { const int st = b / 1024, sb = b % 1024, swz = sb ^ (((sb >> 9) & 1) << 5); R = (st >> 1) * 16 + swz / 64; C = (st & 1) * 32 + (swz % 64) / 2; }
__host__ __device__ __forceinline__ int perm32(int rho) { const int n = rho >> 4, i = rho & 15; return 8 * (i >> 2) + 4 * n + (i & 3); }

struct Unit { int pm, pn, koff, nt, ord; };
struct Gemm { const bf16_t* A; const bf16_t* Bt; int M, N, K; };

struct StaticOrder {
    int nM, nN, nwg, G, c, ntf;
    __host__ __device__ void init(int M, int N, int G_, int c_, int K_) { nM = M / BM; nN = N / BM; nwg = nM * nN; G = G_; c = c_; ntf = K_ / BK; }
    __host__ __device__ bool next(int i, Unit& u) const {
        const long L = (long)i * G + c; if (L >= nwg) return false;
        int wgid = (int)L; { const int q = nwg / NXCD, r = nwg % NXCD, xcd = wgid % NXCD, off = wgid / NXCD; wgid = (xcd < r ? xcd * (q + 1) : r * (q + 1) + (xcd - r) * q) + off; }
        const int nig = WGM * nN, gid = wgid / nig, fm = gid * WGM, gsz = (nM - fm) < WGM ? (nM - fm) : WGM;
        u.pm = fm + ((wgid % nig) % gsz); u.pn = (wgid % nig) / gsz; u.koff = 0; u.nt = ntf; u.ord = i; return true;
    }
    __device__ __forceinline__ void a_ready(const Unit&) const {}
    __device__ __forceinline__ void done(const Unit&) const {}
};

__device__ __forceinline__ int batch_of_tile(int p) { return p < 128 ? (p >> 4) : 8; }
__device__ __forceinline__ float row_rstd(const float* ss, int row) {
    const f32x4* sp = (const f32x4*)(ss + (size_t)row * 16);
    const f32x4 a = sp[0], b = sp[1], c = sp[2], d = sp[3];
    const f32x4 t = (a + b) + (c + d);
    const float tot = (t[0] + t[1]) + (t[2] + t[3]);
    return rsqrtf(tot * (1.0f / 1024.0f) + EPS_F);
}

__device__ __forceinline__ void rows_rstd8(float (&rsv)[2][4], const float* ss, int row0, int fq) {
    f32x4 a[2][4];
#pragma unroll
    for (int ai = 0; ai < 2; ++ai)
#pragma unroll
        for (int m = 0; m < 4; ++m) a[ai][m] = *(const f32x4*)(ss + (size_t)(row0 + ai * HALF + m * 16) * 16 + 4 * fq);
#pragma unroll
    for (int ai = 0; ai < 2; ++ai)
#pragma unroll
        for (int m = 0; m < 4; ++m) {
            float t = (a[ai][m][0] + a[ai][m][1]) + (a[ai][m][2] + a[ai][m][3]);
            t += __shfl_xor(t, 16); t += __shfl_xor(t, 32);
            rsv[ai][m] = rsqrtf(t * (1.0f / 1024.0f) + EPS_F);
        }
}
constexpr int RSTAB_OFF = 131072 + 256, RSTAB_MAX_UNITS = 15;
template <class Sched, bool BY_PN>
__device__ __forceinline__ void fill_rstd_table(PG8_LAS unsigned char* lds, const Sched& S, const float* ss) {
    PG8_LAS float* tab = (PG8_LAS float*)(lds + RSTAB_OFF);
    const int t = threadIdx.x;
#pragma unroll 4
    for (int i0 = 0; i0 < RSTAB_MAX_UNITS + 1; i0 += 2) {
        Unit u; const int i = i0 + (t >> 8);
        if (i < RSTAB_MAX_UNITS && S.next(i, u)) tab[i * 256 + (t & 255)] = row_rstd(ss, (BY_PN ? u.pn : u.pm) * BM + (t & 255));
    }
    __syncthreads();
}
struct EpiQK {
    static constexpr bool PERM = false, AFTER_DRAIN = false;
    bf16_t* O; int ldc; const float* ss; const float* bias; unsigned ropemask, scalemask; const float* ropetab; PG8_LAS unsigned char* lds_base;
    __device__ __forceinline__ void operator()(const f32x4 (&acc)[2][2][4][2], const Unit& u, int wr, int wc, int fr, int fq) const {
        const int bidx = batch_of_tile(u.pm);
        const int colb = u.pn * BM + wc * 32 + 4 * fq;
        f32x4 bv[2][2];
#pragma unroll
        for (int bj = 0; bj < 2; ++bj)
#pragma unroll
            for (int n = 0; n < 2; ++n) bv[bj][n] = *(const f32x4*)(bias + (size_t)bidx * ldc + colb + bj * HALF + n * 16);
        const PG8_LAS float* rtab = (const PG8_LAS float*)(lds_base + RSTAB_OFF) + u.ord * 256 + wr * 64 + fr;
#pragma unroll
        for (int ai = 0; ai < 2; ++ai) {
#pragma unroll
            for (int m = 0; m < 4; ++m) {
                const int row = u.pm * BM + ai * HALF + wr * 64 + m * 16 + fr;
                const float rs = rtab[ai * HALF + m * 16];
                const bool islat = row < MLAT;
                const int tpos = row & (SEQ - 1);
                const int pos = (wc & 1) ? (tpos & 63) : (tpos >> 6);
                const f32x4* rt = (const f32x4*)(ropetab + (size_t)(pos * 16 + 4 * fq) * 2);
                const f32x4 c0 = rt[0], c1 = rt[1];
                const float cc[4] = {c0[0], c0[2], c1[0], c1[2]}, sn[4] = {c0[1], c0[3], c1[1], c1[3]};
                bf16_t* rowp = O + (size_t)row * ldc + colb;
#pragma unroll
                for (int bj = 0; bj < 2; ++bj) {
                    const int c128 = u.pn * 2 + bj;
                    f32x4 v0 = acc[ai][bj][m][0] * rs + bv[bj][0], v1 = acc[ai][bj][m][1] * rs + bv[bj][1];
                    if (((ropemask >> c128) & 1u) && islat) {
#pragma unroll
                        for (int e = 0; e < 4; ++e) { const float x0 = v0[e], x1 = v1[e]; v0[e] = x0 * cc[e] - x1 * sn[e]; v1[e] = x1 * cc[e] + x0 * sn[e]; }
                    }
                    if ((scalemask >> c128) & 1u) { v0 = v0 * QSCALE; v1 = v1 * QSCALE; }
                    u32x2 w0, w1; w0.x = pk_bf16(v0[0], v0[1]); w0.y = pk_bf16(v0[2], v0[3]); w1.x = pk_bf16(v1[0], v1[1]); w1.y = pk_bf16(v1[2], v1[3]);
                    *(u32x2*)(rowp + bj * HALF) = w0; *(u32x2*)(rowp + bj * HALF + 16) = w1;
                }
            }
        }
    }
};

struct EpiVT {
    static constexpr bool PERM = true, AFTER_DRAIN = false;
    bf16_t* O; int ldc; const float* ss; const float* bias; int NV; PG8_LAS unsigned char* lds_base;
    __device__ __forceinline__ void operator()(const f32x4 (&acc)[2][2][4][2], const Unit& u, int wr, int wc, int fr, int fq) const {
        const int bidx = batch_of_tile(u.pn);
        const int tok0 = u.pn * BM + wc * 32 + 8 * fq;
        float rr[2][8];
        { const PG8_LAS float* rtab = (const PG8_LAS float*)(lds_base + RSTAB_OFF) + u.ord * 256 + wc * 32 + 8 * fq;
#pragma unroll
          for (int bj = 0; bj < 2; ++bj) { const f32x4 a = *(const PG8_LAS f32x4*)(rtab + bj * HALF), b2 = *(const PG8_LAS f32x4*)(rtab + bj * HALF + 4);
              rr[bj][0] = a[0]; rr[bj][1] = a[1]; rr[bj][2] = a[2]; rr[bj][3] = a[3]; rr[bj][4] = b2[0]; rr[bj][5] = b2[1]; rr[bj][6] = b2[2]; rr[bj][7] = b2[3]; } }
        float bb[2][4];
#pragma unroll
        for (int ai = 0; ai < 2; ++ai)
#pragma unroll
            for (int m = 0; m < 4; ++m) bb[ai][m] = bias[(size_t)bidx * NV + u.pm * BM + ai * HALF + wr * 64 + m * 16 + fr];
#pragma unroll
        for (int ai = 0; ai < 2; ++ai)
#pragma unroll
            for (int m = 0; m < 4; ++m) {
                const int nrow = u.pm * BM + ai * HALF + wr * 64 + m * 16 + fr;
                const float b = bb[ai][m];
                bf16_t* rowp = O + (size_t)nrow * ldc + tok0;
#pragma unroll
                for (int bj = 0; bj < 2; ++bj) {
                    const f32x4 a0 = acc[ai][bj][m][0], a1 = acc[ai][bj][m][1];
                    u32x4 w;
                    w.x = pk_bf16(a0[0] * rr[bj][0] + b, a0[1] * rr[bj][1] + b); w.y = pk_bf16(a0[2] * rr[bj][2] + b, a0[3] * rr[bj][3] + b);
                    w.z = pk_bf16(a1[0] * rr[bj][4] + b, a1[1] * rr[bj][5] + b); w.w = pk_bf16(a1[2] * rr[bj][6] + b, a1[3] * rr[bj][7] + b);
                    *(u32x4*)(rowp + bj * HALF) = w;
                }
            }
    }
};

struct EpiUp {
    static constexpr bool PERM = true, AFTER_DRAIN = false;
    bf16_t* O; const float* ss; const float* bias; PG8_LAS unsigned char* lds_base;
    __device__ __forceinline__ void operator()(const f32x4 (&acc)[2][2][4][2], const Unit& u, int wr, int wc, int fr, int fq) const {
        const int bidx = batch_of_tile(u.pm);
        const int colb = u.pn * BM + wc * 32 + 8 * fq;
        f32x4 bv[2][2];
#pragma unroll
        for (int bj = 0; bj < 2; ++bj)
#pragma unroll
            for (int n = 0; n < 2; ++n) bv[bj][n] = *(const f32x4*)(bias + (size_t)bidx * DFF + colb + bj * HALF + 4 * n);
        const PG8_LAS float* rtab = (const PG8_LAS float*)(lds_base + RSTAB_OFF) + u.ord * 256 + wr * 64 + fr;
#pragma unroll
        for (int ai = 0; ai < 2; ++ai)
#pragma unroll
            for (int m = 0; m < 4; ++m) {
                const int row = u.pm * BM + ai * HALF + wr * 64 + m * 16 + fr;
                const float rs = rtab[ai * HALF + m * 16];
                bf16_t* rowp = O + (size_t)row * DFF + colb;
#pragma unroll
                for (int bj = 0; bj < 2; ++bj) {
                    f32x4 v0 = acc[ai][bj][m][0] * rs + bv[bj][0], v1 = acc[ai][bj][m][1] * rs + bv[bj][1];
#pragma unroll
                    for (int e = 0; e < 4; ++e) { const float a = fmaxf(v0[e], 0.f), b = fmaxf(v1[e], 0.f); v0[e] = a * a; v1[e] = b * b; }
                    u32x4 w; w.x = pk_bf16(v0[0], v0[1]); w.y = pk_bf16(v0[2], v0[3]); w.z = pk_bf16(v1[0], v1[1]); w.w = pk_bf16(v1[2], v1[3]);
                    *(u32x4*)(rowp + bj * HALF) = w;
                }
            }
    }
};

__device__ __forceinline__ f32x4 ld_bf4(const bf16_t* p) { const u32x2 w = *(const u32x2*)p; f32x4 v; v[0] = __uint_as_float(w.x << 16); v[1] = __uint_as_float(w.x & 0xffff0000u); v[2] = __uint_as_float(w.y << 16); v[3] = __uint_as_float(w.y & 0xffff0000u); return v; }
template <bool HIN_BF, bool HOUT_BF>
struct EpiResT {
    static constexpr bool PERM = false, AFTER_DRAIN = false;
    const void* hin_lat; const void* hin_ctx; void* hout; bf16_t* xg; float* ss;
    const float* gate; const float* scl; const float* ng;
    __device__ __forceinline__ void operator()(const f32x4 (&acc)[2][2][4][2], const Unit& u, int wr, int wc, int fr, int fq) const {
        const int bidx = batch_of_tile(u.pm);
        const int colb = u.pn * BM + wc * 32 + 4 * fq;
        f32x4 gv[2][2], gp[2][2];
#pragma unroll
        for (int bj = 0; bj < 2; ++bj)
#pragma unroll
            for (int n = 0; n < 2; ++n) {
                const int c = colb + bj * HALF + n * 16;
                gv[bj][n] = *(const f32x4*)(gate + (size_t)bidx * 6144 + c);
                if (xg) { const f32x4 s = *(const f32x4*)(scl + (size_t)bidx * 6144 + c); const f32x4 g = *(const f32x4*)(ng + c); gp[bj][n] = g * (s + 1.0f); }
                else gp[bj][n] = (f32x4){0.f, 0.f, 0.f, 0.f};
            }
        constexpr int RB = HIN_BF ? 4 : 2;
#pragma unroll
        for (int ab = 0; ab < 8 / RB; ++ab) {
            f32x4 hv[RB][2][2]; u32x2 hr[RB][2][2];
#pragma unroll
            for (int q = 0; q < RB; ++q) {
                const int am = ab * RB + q, ai = am >> 2, m = am & 3;
                const int row = u.pm * BM + ai * HALF + wr * 64 + m * 16 + fr;
                const size_t hoff = (row < MLAT ? (size_t)row : (size_t)(row - MLAT)) * DM + colb;
                const void* hb = row < MLAT ? hin_lat : hin_ctx;
#pragma unroll
                for (int bj = 0; bj < 2; ++bj)
#pragma unroll
                    for (int n = 0; n < 2; ++n) { const int co = bj * HALF + n * 16;
                        if (HIN_BF) hr[q][bj][n] = *(const u32x2*)((const bf16_t*)hb + hoff + co); else hv[q][bj][n] = *(const f32x4*)((const float*)hb + hoff + co); }
            }
#pragma unroll
            for (int q = 0; q < RB; ++q) {
                const int am = ab * RB + q, ai = am >> 2, m = am & 3;
                const int row = u.pm * BM + ai * HALF + wr * 64 + m * 16 + fr;
                float ssum = 0.f;
#pragma unroll
                for (int bj = 0; bj < 2; ++bj)
#pragma unroll
                    for (int n = 0; n < 2; ++n) {
                        const int co = bj * HALF + n * 16;
                        f32x4 hq;
                        if (HIN_BF) { const u32x2 w = hr[q][bj][n]; hq[0] = __uint_as_float(w.x << 16); hq[1] = __uint_as_float(w.x & 0xffff0000u); hq[2] = __uint_as_float(w.y << 16); hq[3] = __uint_as_float(w.y & 0xffff0000u); }
                        else hq = hv[q][bj][n];
                        const f32x4 v = hq + gv[bj][n] * acc[ai][bj][m][n];
                        if (HOUT_BF) { u32x2 w; w.x = pk_bf16(v[0], v[1]); w.y = pk_bf16(v[2], v[3]); *(u32x2*)((bf16_t*)hout + (size_t)row * DM + colb + co) = w; }
                        else *(f32x4*)((float*)hout + (size_t)row * DM + colb + co) = v;
                        ssum += (v[0] * v[0] + v[1] * v[1]) + (v[2] * v[2] + v[3] * v[3]);
                        if (xg) { const f32x4 y = v * gp[bj][n]; u32x2 w; w.x = pk_bf16(y[0], y[1]); w.y = pk_bf16(y[2], y[3]); *(u32x2*)(xg + (size_t)row * DM + colb + co) = w; }
                    }
                ssum += __shfl_xor(ssum, 16); ssum += __shfl_xor(ssum, 32);
                if (fq == 0) ss[(size_t)row * 16 + u.pn * 4 + wc] = ssum;
            }
        }
    }
};
typedef EpiResT<false, false> EpiRes;

struct EpiFinal {
    static constexpr bool PERM = false, AFTER_DRAIN = false;
    const float* hin; float* out; float* ss; const float* gate; const float* fg; unsigned* cnt;
    __device__ __forceinline__ void operator()(f32x4 (&acc)[2][2][4][2], const Unit& u, int wr, int wc, int fr, int fq) const {
        const int bidx = batch_of_tile(u.pm);
        const int colb = u.pn * BM + wc * 32 + 4 * fq;
        f32x4 gv[2][2];
#pragma unroll
        for (int bj = 0; bj < 2; ++bj)
#pragma unroll
            for (int n = 0; n < 2; ++n) gv[bj][n] = *(const f32x4*)(gate + (size_t)bidx * 6144 + colb + bj * HALF + n * 16);
#pragma unroll
        for (int ai = 0; ai < 2; ++ai)
#pragma unroll
            for (int m = 0; m < 4; ++m) {
                const int row = u.pm * BM + ai * HALF + wr * 64 + m * 16 + fr;
                const float* hp = hin + (size_t)row * DM + colb;
                float ssum = 0.f;
#pragma unroll
                for (int bj = 0; bj < 2; ++bj)
#pragma unroll
                    for (int n = 0; n < 2; ++n) {
                        const f32x4 v = *(const f32x4*)(hp + bj * HALF + n * 16) + gv[bj][n] * acc[ai][bj][m][n];
                        acc[ai][bj][m][n] = v;
                        ssum += (v[0] * v[0] + v[1] * v[1]) + (v[2] * v[2] + v[3] * v[3]);
                    }
                ssum += __shfl_xor(ssum, 16); ssum += __shfl_xor(ssum, 32);
                if (fq == 0) __hip_atomic_store(ss + (size_t)row * 16 + u.pn * 4 + wc, ssum, __ATOMIC_RELAXED, __HIP_MEMORY_SCOPE_AGENT);
            }
        asm volatile("s_waitcnt vmcnt(0)" ::: "memory");
        unsigned* cw = cnt + 64 * u.pm;
        if ((threadIdx.x & 63) == 0) __hip_atomic_fetch_add(cw, 1u, __ATOMIC_RELAXED, __HIP_MEMORY_SCOPE_AGENT);
        { const unsigned long long t0 = __builtin_amdgcn_s_memrealtime();
          while ((unsigned)__builtin_amdgcn_readfirstlane(__hip_atomic_load(cw, __ATOMIC_RELAXED, __HIP_MEMORY_SCOPE_AGENT)) < 32u) {
              if (__builtin_amdgcn_s_memrealtime() - t0 > 1000000ull) break;
              __builtin_amdgcn_s_sleep(2); } }
        __builtin_amdgcn_fence(__ATOMIC_ACQUIRE, "agent");
        asm volatile("s_waitcnt vmcnt(0)" ::: "memory");
        f32x4 fv[2][2];
#pragma unroll
        for (int bj = 0; bj < 2; ++bj)
#pragma unroll
            for (int n = 0; n < 2; ++n) fv[bj][n] = *(const f32x4*)(fg + colb + bj * HALF + n * 16);
#pragma unroll
        for (int ai = 0; ai < 2; ++ai)
#pragma unroll
            for (int m = 0; m < 4; ++m) {
                const int row = u.pm * BM + ai * HALF + wr * 64 + m * 16 + fr;
                const float rs = row_rstd(ss, row);
                float* op = out + (size_t)row * DM + colb;
#pragma unroll
                for (int bj = 0; bj < 2; ++bj)
#pragma unroll
                    for (int n = 0; n < 2; ++n) *(f32x4*)(op + bj * HALF + n * 16) = acc[ai][bj][m][n] * rs * fv[bj][n];
            }
    }
};

struct SplitCtxOrder {
    int c, nts;
    __host__ __device__ void init(int c_, int K_) { c = c_; nts = K_ / BK / 8; }
    __host__ __device__ bool next(int i, Unit& u) const {
        if (i != 0) return false;
        const int ti = c >> 3, ks = c & 7;
        u.pm = 128 + (ti >> 2); u.pn = ti & 3; u.nt = nts; u.koff = ks * nts * BK; u.ord = 0; return true;
    }
    __device__ __forceinline__ void a_ready(const Unit&) const {}
    __device__ __forceinline__ void done(const Unit&) const {}
};
struct EpiSlab {
    static constexpr bool PERM = false, AFTER_DRAIN = false;
    float* slab_lo; float* slab_hi;
    __device__ __forceinline__ void operator()(const f32x4 (&acc)[2][2][4][2], const Unit& u, int wr, int wc, int fr, int fq) const {
        const int ks = u.koff / (u.nt * BK);
        float* sl = (ks < 6 ? slab_lo + (size_t)ks * MCTX * DM : slab_hi + (size_t)(ks - 6) * MCTX * DM);
        const int colb = u.pn * BM + wc * 32 + 4 * fq;
#pragma unroll
        for (int ai = 0; ai < 2; ++ai)
#pragma unroll
            for (int m = 0; m < 4; ++m) {
                const int row = (u.pm - 128) * BM + ai * HALF + wr * 64 + m * 16 + fr;
                float* op = sl + (size_t)row * DM + colb;
#pragma unroll
                for (int bj = 0; bj < 2; ++bj)
#pragma unroll
                    for (int n = 0; n < 2; ++n) *(f32x4*)(op + bj * HALF + n * 16) = acc[ai][bj][m][n];
            }
    }
};

template <class Epi, class Sched, bool ALIGN_EPI = false, bool SP2 = false>
__device__ __forceinline__ void gemm_phase(PG8_LAS unsigned char* lds, const Gemm g, const Sched& S, const Epi& E) {
    const int tid = threadIdx.x, wid = __builtin_amdgcn_readfirstlane(tid >> 6), lane = tid & 63, wr = wid >> 2, wc = wid & 3, fr = lane & 15, fq = lane >> 4;
    const int K = g.K;
    unsigned voffA[2], voffB[2];
#pragma unroll
    for (int i = 0; i < 2; ++i) { int R, C; stage_rc(tid * 16 + i * 8192, R, C); const int Rb = Epi::PERM ? ((R & ~31) + perm32(R & 31)) : R;
        voffA[i] = (unsigned)(R * K + C) * 2u; voffB[i] = (unsigned)(Rb * K + C) * 2u; }
    const size_t kstep = (size_t)(BK * 2);
    const size_t hstep = (size_t)HALF * K * 2;
    const size_t tstep = 2 * hstep;
    const unsigned ldsw = (unsigned)wid * 1024u;
    const int aoff = lds_byte(wr * 64 + fr, fq * 8), boff = lds_byte(wc * 32 + fr, fq * 8);
#define PG8_SA(b, h) (((b) * 2 + (h)) * HTB)
#define PG8_SB(b, h) ((4 + (b) * 2 + (h)) * HTB)
#define PG8_STAGE(bufoff, gbase, voff) do { _Pragma("unroll") for (int _i = 0; _i < 2; ++_i) \
        __builtin_amdgcn_global_load_lds((const unsigned*)((const char*)(gbase) + (voff)[_i]), (PG8_LAS unsigned*)(lds + (bufoff) + ldsw + _i * 8192), 16, 0, 0); } while (0)
#define PG8_LDA(dst, b, h) do { _Pragma("unroll") for (int m = 0; m < 4; ++m) _Pragma("unroll") for (int k = 0; k < 2; ++k) dst[m][k] = *(const PG8_LAS bf16x8*)(lds + PG8_SA(b, h) + aoff + m * 2048 + k * 1024); } while (0)
#define PG8_LDB(dst, b, h) do { _Pragma("unroll") for (int n = 0; n < 2; ++n) _Pragma("unroll") for (int k = 0; k < 2; ++k) dst[n][k] = *(const PG8_LAS bf16x8*)(lds + PG8_SB(b, h) + boff + n * 2048 + k * 1024); } while (0)
#define PG8_MMA(ai, bj, At, Bt) do { __builtin_amdgcn_s_setprio(1); _Pragma("unroll") for (int m = 0; m < 4; ++m) _Pragma("unroll") for (int n = 0; n < 2; ++n) _Pragma("unroll") for (int k = 0; k < 2; ++k) \
        acc[ai][bj][m][n] = __builtin_amdgcn_mfma_f32_16x16x32_bf16(Bt[n][k], At[m][k], acc[ai][bj][m][n], 0, 0, 0); __builtin_amdgcn_s_setprio(0); } while (0)
#define PG8_WAIT_V(n) asm volatile("s_waitcnt vmcnt(" #n ")" ::: "memory")
#define PG8_WAIT_L(n) asm volatile("s_waitcnt lgkmcnt(" #n ")" ::: "memory")
#define PG8_BAR __builtin_amdgcn_s_barrier()
#define PG8_SCHED __builtin_amdgcn_sched_barrier(0)
    Unit cur, nxt; int ui = 0;
    if (!S.next(0, cur)) return;
    f32x4 acc[2][2][4][2];
#pragma unroll
    for (int a = 0; a < 2; ++a)
#pragma unroll
        for (int b = 0; b < 2; ++b)
#pragma unroll
            for (int m = 0; m < 4; ++m)
#pragma unroll
                for (int n = 0; n < 2; ++n) acc[a][b][m][n] = (f32x4){0.f, 0.f, 0.f, 0.f};
    bf16x8 At[4][2], B0[2][2], B1[2][2];
    const char* cA = (const char*)g.A + (size_t)cur.pm * tstep + (size_t)cur.koff * 2; const char* cB = (const char*)g.Bt + (size_t)cur.pn * tstep + (size_t)cur.koff * 2;
    S.a_ready(cur);
    if constexpr (SP2) {
        PG8_STAGE(PG8_SB(0, 0), cB, voffB); PG8_STAGE(PG8_SB(0, 1), cB + hstep, voffB); PG8_STAGE(PG8_SA(0, 0), cA, voffA); PG8_STAGE(PG8_SA(0, 1), cA + hstep, voffA);
        if (wr == 1) PG8_BAR;
        PG8_WAIT_V(2); PG8_BAR;
        PG8_STAGE(PG8_SB(1, 0), cB + kstep, voffB); PG8_STAGE(PG8_SA(1, 0), cA + kstep, voffA); PG8_STAGE(PG8_SB(1, 1), cB + hstep + kstep, voffB);
        PG8_WAIT_V(6); PG8_BAR;
    } else {
        PG8_STAGE(PG8_SB(0, 0), cB, voffB); PG8_STAGE(PG8_SA(0, 0), cA, voffA); PG8_STAGE(PG8_SB(0, 1), cB + hstep, voffB); PG8_STAGE(PG8_SA(0, 1), cA + hstep, voffA);
        if (wr == 1) PG8_BAR;
        PG8_WAIT_V(4); PG8_BAR;
        PG8_STAGE(PG8_SB(1, 0), cB + kstep, voffB); PG8_STAGE(PG8_SA(1, 0), cA + kstep, voffA); PG8_STAGE(PG8_SB(1, 1), cB + hstep + kstep, voffB);
        PG8_WAIT_V(6); PG8_BAR;
    }
    for (;;) {
        const bool has_next = S.next(ui + 1, nxt);
        const char* nA = has_next ? (const char*)g.A + (size_t)nxt.pm * tstep + (size_t)nxt.koff * 2 : cA; const char* nB = has_next ? (const char*)g.Bt + (size_t)nxt.pn * tstep + (size_t)nxt.koff * 2 : cB;
        const int nt = cur.nt;
        for (int t = 0; t < nt; t += 2) {
            const bool last = (t == nt - 2);
            const char* a1 = cA + (size_t)(t + 1) * kstep;
            const char* a2 = last ? nA : cA + (size_t)(t + 2) * kstep; const char* b2 = last ? nB : cB + (size_t)(t + 2) * kstep;
            const char* a3 = a2 + kstep; const char* b3 = b2 + kstep;
            if (last && has_next) S.a_ready(nxt);
            if constexpr (SP2) {
            PG8_LDB(B0, 0, 0); PG8_LDB(B1, 0, 1); PG8_SCHED; PG8_LDA(At, 0, 0); PG8_STAGE(PG8_SA(1, 1), a1 + hstep, voffA);
            PG8_WAIT_V(8); PG8_WAIT_L(0); PG8_BAR; PG8_MMA(0, 0, At, B0); PG8_MMA(0, 1, At, B1); PG8_BAR; PG8_SCHED;
            PG8_LDA(At, 0, 1); PG8_STAGE(PG8_SB(0, 0), b2, voffB); PG8_STAGE(PG8_SB(0, 1), b2 + hstep, voffB); PG8_STAGE(PG8_SA(0, 0), a2, voffA);
            PG8_WAIT_V(8); PG8_WAIT_L(0); PG8_BAR; PG8_MMA(1, 0, At, B0); PG8_MMA(1, 1, At, B1); PG8_BAR; PG8_SCHED;
            PG8_LDB(B0, 1, 0); PG8_LDB(B1, 1, 1); PG8_SCHED; PG8_LDA(At, 1, 0); PG8_STAGE(PG8_SA(0, 1), a2 + hstep, voffA);
            PG8_WAIT_V(8); PG8_WAIT_L(0); PG8_BAR; PG8_MMA(0, 0, At, B0); PG8_MMA(0, 1, At, B1); PG8_BAR; PG8_SCHED;
            PG8_LDA(At, 1, 1); PG8_STAGE(PG8_SB(1, 0), b3, voffB); PG8_STAGE(PG8_SB(1, 1), b3 + hstep, voffB); PG8_STAGE(PG8_SA(1, 0), a3, voffA);
            PG8_WAIT_V(8); PG8_WAIT_L(0); PG8_BAR; PG8_MMA(1, 0, At, B0); PG8_MMA(1, 1, At, B1); PG8_BAR; PG8_SCHED;
            } else {
            PG8_LDB(B0, 0, 0); PG8_SCHED; PG8_LDA(At, 0, 0); PG8_STAGE(PG8_SA(1, 1), a1 + hstep, voffA);
            PG8_WAIT_L(8); PG8_BAR; PG8_WAIT_L(0); PG8_MMA(0, 0, At, B0); PG8_BAR; PG8_SCHED;
            PG8_LDB(B1, 0, 1); PG8_STAGE(PG8_SB(0, 0), b2, voffB);
            PG8_BAR; PG8_WAIT_L(0); PG8_MMA(0, 1, At, B1); PG8_BAR;
            PG8_LDA(At, 0, 1); PG8_STAGE(PG8_SA(0, 0), a2, voffA);
            PG8_BAR; PG8_WAIT_L(0); PG8_MMA(1, 0, At, B0); PG8_BAR; PG8_SCHED;
            PG8_STAGE(PG8_SB(0, 1), b2 + hstep, voffB);
            PG8_WAIT_V(6); PG8_BAR; PG8_MMA(1, 1, At, B1); PG8_BAR;
            PG8_LDB(B0, 1, 0); PG8_SCHED; PG8_LDA(At, 1, 0); PG8_STAGE(PG8_SA(0, 1), a2 + hstep, voffA);
            PG8_WAIT_L(8); PG8_BAR; PG8_WAIT_L(0); PG8_MMA(0, 0, At, B0); PG8_BAR; PG8_SCHED;
            PG8_LDB(B1, 1, 1); PG8_STAGE(PG8_SB(1, 0), b3, voffB);
            PG8_BAR; PG8_WAIT_L(0); PG8_MMA(0, 1, At, B1); PG8_BAR;
            PG8_LDA(At, 1, 1); PG8_STAGE(PG8_SA(1, 0), a3, voffA);
            PG8_BAR; PG8_WAIT_L(0); PG8_MMA(1, 0, At, B0); PG8_BAR; PG8_SCHED;
            PG8_STAGE(PG8_SB(1, 1), b3 + hstep, voffB);
            PG8_WAIT_V(6); PG8_BAR; PG8_MMA(1, 1, At, B1); PG8_BAR;
            }
        }
        if constexpr (ALIGN_EPI) { if (wr == 0) PG8_BAR; }
        if constexpr (!Epi::AFTER_DRAIN) { E(acc, cur, wr, wc, fr, fq); S.done(cur); }
        if (!has_next) break;
#pragma unroll
        for (int a = 0; a < 2; ++a)
#pragma unroll
            for (int b = 0; b < 2; ++b)
#pragma unroll
                for (int m = 0; m < 4; ++m)
#pragma unroll
                    for (int n = 0; n < 2; ++n) acc[a][b][m][n] = (f32x4){0.f, 0.f, 0.f, 0.f};
        cur = nxt; cA = nA; cB = nB; ++ui;
        if constexpr (ALIGN_EPI) { if (wr == 1) PG8_BAR; }
    }
    PG8_WAIT_V(0);
    if constexpr (!ALIGN_EPI) { if (wr == 0) PG8_BAR; }
    PG8_BAR;
    if constexpr (Epi::AFTER_DRAIN) { E.fused(acc, cur, wr, wc, fr, fq, lds, wid, lane); S.done(cur); }
#undef PG8_SA
#undef PG8_SB
#undef PG8_STAGE
#undef PG8_LDA
#undef PG8_LDB
#undef PG8_MMA
#undef PG8_WAIT_V
#undef PG8_WAIT_L
#undef PG8_BAR
#undef PG8_SCHED
}
}

namespace att {
#define MFMA32(a, b, c) __builtin_amdgcn_mfma_f32_32x32x16_bf16((a), (b), (c), 0, 0, 0)
__device__ __forceinline__ int koff(int r, int h) { return 16 * (r >> 3) + 8 * h + (r & 7); }
__device__ __forceinline__ int crow(int r, int h) { return (r & 3) + 8 * (r >> 2) + 4 * h; }
__device__ __forceinline__ float ex2(float x) { return __builtin_amdgcn_exp2f(x); }
__device__ __forceinline__ float wave_sum(float v) {
#pragma unroll
    for (int o = 1; o < 64; o <<= 1) v += __shfl_xor(v, o);
    return v;
}

__device__ __forceinline__ void qk_tile(f32x16 (&s)[2], const LAS unsigned char* Kt, const bf16x8 (&qf)[4], int pi, int h) {
    const int sw = (pi >> 1) & 7;
#pragma unroll
    for (int kb = 0; kb < 2; ++kb) {
        f32x16 a = {};
#pragma unroll
        for (int d0 = 0; d0 < 4; ++d0) {
            const bf16x8 kf = *(const LAS bf16x8*)(Kt + (32 * kb + pi) * 128 + (((2 * d0 + h) ^ sw) << 4));
            a = MFMA32(kf, qf[d0], a);
        }
        s[kb] = a;
    }
}
template <int DVB>
__device__ __forceinline__ void softmax_pv(f32x16 (&s)[2], const LAS unsigned char* VTt, f32x16 (&oT)[DVB], float& m_run, float& l_run, int i31, int h) {
    float mx = s[0][0];
#pragma unroll
    for (int r = 1; r < 16; ++r) mx = fmaxf(mx, s[0][r]);
#pragma unroll
    for (int r = 0; r < 16; ++r) mx = fmaxf(mx, s[1][r]);
    mx = fmaxf(mx, __shfl_xor(mx, 32));
    if (__any(mx > m_run)) {
        const float mn = fmaxf(m_run, mx); const float alpha = ex2(m_run - mn); m_run = mn; l_run *= alpha;
#pragma unroll
        for (int db = 0; db < DVB; ++db)
#pragma unroll
            for (int r = 0; r < 16; ++r) oT[db][r] *= alpha;
    }
    float ps = 0.f;
#pragma unroll
    for (int kb = 0; kb < 2; ++kb)
#pragma unroll
        for (int r = 0; r < 16; ++r) { const float p = ex2(s[kb][r] - m_run); s[kb][r] = p; ps += p; }
    l_run += ps;
    const int sw = (i31 >> 1) & 7;
#pragma unroll
    for (int kb = 0; kb < 2; ++kb)
#pragma unroll
        for (int st = 0; st < 2; ++st) {
            u32x4 pw;
            pw.x = pk_bf16(s[kb][8 * st + 0], s[kb][8 * st + 1]); pw.y = pk_bf16(s[kb][8 * st + 2], s[kb][8 * st + 3]);
            pw.z = pk_bf16(s[kb][8 * st + 4], s[kb][8 * st + 5]); pw.w = pk_bf16(s[kb][8 * st + 6], s[kb][8 * st + 7]);
            const bf16x8 pb = __builtin_bit_cast(bf16x8, pw);
#pragma unroll
            for (int db = 0; db < DVB; ++db) {
                const bf16x8 vf = *(const LAS bf16x8*)(VTt + (32 * db + i31) * 128 + (((4 * kb + 2 * st + h) ^ sw) << 4));
                oT[db] = MFMA32(vf, pb, oT[db]);
            }
        }
}


#ifndef THR2V
#define THR2V 6.0f
#endif
constexpr float THR2 = THR2V;
__device__ __forceinline__ void qk_tile2(f32x16 (&s)[2], const LAS unsigned char* Kt, const bf16x8 (&qf)[4], const f32x16& negm, int pi, int h) {
    const int sw = (pi >> 1) & 7;
#pragma unroll
    for (int kb = 0; kb < 2; ++kb) {
        f32x16 a = negm;
#pragma unroll
        for (int d0 = 0; d0 < 4; ++d0) {
            const bf16x8 kf = *(const LAS bf16x8*)(Kt + (32 * kb + pi) * 128 + (((2 * d0 + h) ^ sw) << 4));
            a = MFMA32(kf, qf[d0], a);
        }
        s[kb] = a;
    }
}
template <int DVB>
__device__ __forceinline__ void softmax_pv2(f32x16 (&s)[2], const LAS unsigned char* VTt, f32x16 (&oT)[DVB], f32x16& negm, float& m_run, float& l_run, bool first, int i31, int h) {
    float mx = fmaxf(fmaxf(s[0][0], s[0][1]), s[0][2]);
#pragma unroll
    for (int r = 3; r < 15; r += 2) mx = fmaxf(fmaxf(mx, s[0][r]), s[0][r + 1]);
    mx = fmaxf(mx, s[0][15]);
#pragma unroll
    for (int r = 0; r < 16; r += 2) mx = fmaxf(fmaxf(mx, s[1][r]), s[1][r + 1]);
    if (first || __any(mx > THR2)) {
        mx = fmaxf(mx, __shfl_xor(mx, 32));
        float delta = first ? mx : fmaxf(mx, 0.f);
        if (delta == -INFINITY) delta = 0.f;
        const float alpha = first ? 1.0f : ex2(-delta);
        m_run += delta; l_run *= alpha;
#pragma unroll
        for (int db = 0; db < DVB; ++db)
#pragma unroll
            for (int r = 0; r < 16; ++r) oT[db][r] *= alpha;
#pragma unroll
        for (int kb = 0; kb < 2; ++kb)
#pragma unroll
            for (int r = 0; r < 16; ++r) s[kb][r] -= delta;
        const float nm = -m_run;
#pragma unroll
        for (int r = 0; r < 16; ++r) negm[r] = nm;
    }
    float ps = 0.f;
#pragma unroll
    for (int kb = 0; kb < 2; ++kb)
#pragma unroll
        for (int r = 0; r < 16; ++r) { const float p = ex2(s[kb][r]); s[kb][r] = p; ps += p; }
    l_run += ps;
    const int sw = (i31 >> 1) & 7;
#pragma unroll
    for (int kb = 0; kb < 2; ++kb)
#pragma unroll
        for (int st = 0; st < 2; ++st) {
            u32x4 pw;
            pw.x = pk_bf16(s[kb][8 * st + 0], s[kb][8 * st + 1]); pw.y = pk_bf16(s[kb][8 * st + 2], s[kb][8 * st + 3]);
            pw.z = pk_bf16(s[kb][8 * st + 4], s[kb][8 * st + 5]); pw.w = pk_bf16(s[kb][8 * st + 6], s[kb][8 * st + 7]);
            const bf16x8 pb = __builtin_bit_cast(bf16x8, pw);
#pragma unroll
            for (int db = 0; db < DVB; ++db) {
                const bf16x8 vf = *(const LAS bf16x8*)(VTt + (32 * db + i31) * 128 + (((4 * kb + 2 * st + h) ^ sw) << 4));
                oT[db] = MFMA32(vf, pb, oT[db]);
            }
        }
}


#define ATT_SB() do {} while (0)
#ifdef ATT_PRIO
#define ATT_P1() __builtin_amdgcn_s_setprio(1)
#define ATT_P0() __builtin_amdgcn_s_setprio(0)
#else
#define ATT_P1() do {} while (0)
#define ATT_P0() do {} while (0)
#endif
__device__ __forceinline__ bf16x8 exp_pack8(f32x16& sv, const int st, float& ps) {
    float p[8];
#pragma unroll
    for (int j = 0; j < 8; ++j) { p[j] = ex2(sv[8 * st + j]); }
    ps += ((p[0] + p[1]) + (p[2] + p[3])) + ((p[4] + p[5]) + (p[6] + p[7]));
    u32x4 pw; pw.x = pk_bf16(p[0], p[1]); pw.y = pk_bf16(p[2], p[3]); pw.z = pk_bf16(p[4], p[5]); pw.w = pk_bf16(p[6], p[7]);
    return __builtin_bit_cast(bf16x8, pw);
}
struct NoMask { __device__ __forceinline__ void operator()(f32x16&, f32x16&) const {} };
template <int DVB, class MF = NoMask>
__device__ __forceinline__ void tile_compute(const LAS unsigned char* Kt, const LAS unsigned char* VTt, const bf16x8 (&qf)[4], f32x16 (&oT)[DVB], f32x16& negm,
                                             float& m_run, float& l_run, bool first, int pi, int i31, int h, const MF mf = MF()) {
#ifdef IGLP_ID
    __builtin_amdgcn_iglp_opt(IGLP_ID);
#endif
    const int swk = (pi >> 1) & 7, swv = (i31 >> 1) & 7;
    bf16x8 kf[8];
#pragma unroll
    for (int kb = 0; kb < 2; ++kb)
#pragma unroll
        for (int d0 = 0; d0 < 4; ++d0) kf[kb * 4 + d0] = *(const LAS bf16x8*)(Kt + (32 * kb + pi) * 128 + (((2 * d0 + h) ^ swk) << 4));
    ATT_SB();
    f32x16 s0 = negm, s1 = negm;
    bf16x8 vf[4][DVB];
#pragma unroll
    for (int d0 = 0; d0 < 4; ++d0) { s0 = MFMA32(kf[d0], qf[d0], s0); s1 = MFMA32(kf[4 + d0], qf[d0], s1); }
#pragma unroll
    for (int j = 0; j < 2; ++j)
#pragma unroll
        for (int db = 0; db < DVB; ++db) vf[j][db] = *(const LAS bf16x8*)(VTt + (32 * db + i31) * 128 + (((2 * j + h) ^ swv) << 4));
    ATT_SB();
    mf(s0, s1);
    float mx = fmaxf(fmaxf(s0[0], s0[1]), s0[2]);
#pragma unroll
    for (int r = 3; r < 15; r += 2) mx = fmaxf(fmaxf(mx, s0[r]), s0[r + 1]);
    mx = fmaxf(mx, s0[15]);
#pragma unroll
    for (int r = 0; r < 16; r += 2) mx = fmaxf(fmaxf(mx, s1[r]), s1[r + 1]);
    if (first || __any(mx > THR2)) {
        mx = fmaxf(mx, __shfl_xor(mx, 32));
        float delta = first ? mx : fmaxf(mx, 0.f);
        if (delta == -INFINITY) delta = 0.f;
        const float alpha = first ? 1.0f : ex2(-delta);
        m_run += delta; l_run *= alpha;
#pragma unroll
        for (int db = 0; db < DVB; ++db)
#pragma unroll
            for (int r = 0; r < 16; ++r) oT[db][r] *= alpha;
#pragma unroll
        for (int r = 0; r < 16; ++r) { s0[r] -= delta; s1[r] -= delta; }
        const float nm = -m_run;
#pragma unroll
        for (int r = 0; r < 16; ++r) negm[r] = nm;
    }
    ATT_SB();
    float ps = 0.f;
    bf16x8 pb0 = exp_pack8(s0, 0, ps);
#pragma unroll
    for (int j = 2; j < 4; ++j)
#pragma unroll
        for (int db = 0; db < DVB; ++db) vf[j][db] = *(const LAS bf16x8*)(VTt + (32 * db + i31) * 128 + (((2 * j + h) ^ swv) << 4));
    ATT_SB();
#pragma unroll
    for (int db = 0; db < DVB; ++db) { ATT_P1(); oT[db] = MFMA32(vf[0][db], pb0, oT[db]); ATT_P0(); }
    bf16x8 pb1 = exp_pack8(s0, 1, ps);
    ATT_SB();
#pragma unroll
    for (int db = 0; db < DVB; ++db) { ATT_P1(); oT[db] = MFMA32(vf[1][db], pb1, oT[db]); ATT_P0(); }
    bf16x8 pb2 = exp_pack8(s1, 0, ps);
    ATT_SB();
#pragma unroll
    for (int db = 0; db < DVB; ++db) { ATT_P1(); oT[db] = MFMA32(vf[2][db], pb2, oT[db]); ATT_P0(); }
    bf16x8 pb3 = exp_pack8(s1, 1, ps);
    ATT_SB();
#pragma unroll
    for (int db = 0; db < DVB; ++db) { ATT_P1(); oT[db] = MFMA32(vf[3][db], pb3, oT[db]); ATT_P0(); }
    l_run += ps;
    ATT_SB();
}


template <int DVB>
__device__ __forceinline__ void tile_compute128(const LAS unsigned char* KtA, const LAS unsigned char* VTtA, const LAS unsigned char* KtB, const LAS unsigned char* VTtB, const bf16x8 (&qf)[4],
                                                f32x16 (&oT)[DVB], f32x16& negm, float& m_run, float& l_run, bool first, int pi, int i31, int h) {
    const int swk = (pi >> 1) & 7, swv = (i31 >> 1) & 7;
    f32x16 a0 = negm, a1 = negm, b0 = negm, b1 = negm;
    {
        bf16x8 kf[8];
#pragma unroll
        for (int kb = 0; kb < 2; ++kb)
#pragma unroll
            for (int d0 = 0; d0 < 4; ++d0) kf[kb * 4 + d0] = *(const LAS bf16x8*)(KtA + (32 * kb + pi) * 128 + (((2 * d0 + h) ^ swk) << 4));
#pragma unroll
        for (int d0 = 0; d0 < 4; ++d0) { a0 = MFMA32(kf[d0], qf[d0], a0); a1 = MFMA32(kf[4 + d0], qf[d0], a1); }
    }
    {
        bf16x8 kf[8];
#pragma unroll
        for (int kb = 0; kb < 2; ++kb)
#pragma unroll
            for (int d0 = 0; d0 < 4; ++d0) kf[kb * 4 + d0] = *(const LAS bf16x8*)(KtB + (32 * kb + pi) * 128 + (((2 * d0 + h) ^ swk) << 4));
#pragma unroll
        for (int d0 = 0; d0 < 4; ++d0) { b0 = MFMA32(kf[d0], qf[d0], b0); b1 = MFMA32(kf[4 + d0], qf[d0], b1); }
    }
    float mx = fmaxf(fmaxf(a0[0], a0[1]), a0[2]), my = fmaxf(fmaxf(b0[0], b0[1]), b0[2]);
#pragma unroll
    for (int r = 3; r < 15; r += 2) { mx = fmaxf(fmaxf(mx, a0[r]), a0[r + 1]); my = fmaxf(fmaxf(my, b0[r]), b0[r + 1]); }
    mx = fmaxf(mx, a0[15]); my = fmaxf(my, b0[15]);
#pragma unroll
    for (int r = 0; r < 16; r += 2) { mx = fmaxf(fmaxf(mx, a1[r]), a1[r + 1]); my = fmaxf(fmaxf(my, b1[r]), b1[r + 1]); }
    mx = fmaxf(mx, my);
    if (first || __any(mx > THR2)) {
        mx = fmaxf(mx, __shfl_xor(mx, 32));
        float delta = first ? mx : fmaxf(mx, 0.f);
        if (delta == -INFINITY) delta = 0.f;
        const float alpha = first ? 1.0f : ex2(-delta);
        m_run += delta; l_run *= alpha;
#pragma unroll
        for (int db = 0; db < DVB; ++db)
#pragma unroll
            for (int r = 0; r < 16; ++r) oT[db][r] *= alpha;
#pragma unroll
        for (int r = 0; r < 16; ++r) { a0[r] -= delta; a1[r] -= delta; b0[r] -= delta; b1[r] -= delta; }
        const float nm = -m_run;
#pragma unroll
        for (int r = 0; r < 16; ++r) negm[r] = nm;
    }
    float ps = 0.f;
    {
#pragma unroll
        for (int jp = 0; jp < 2; ++jp) {
            bf16x8 vf[2][DVB];
#pragma unroll
            for (int j = 0; j < 2; ++j)
#pragma unroll
                for (int db = 0; db < DVB; ++db) vf[j][db] = *(const LAS bf16x8*)(VTtA + (32 * db + i31) * 128 + (((2 * (2 * jp + j) + h) ^ swv) << 4));
            const bf16x8 p0 = exp_pack8(jp == 0 ? a0 : a1, 0, ps), p1 = exp_pack8(jp == 0 ? a0 : a1, 1, ps);
#pragma unroll
            for (int db = 0; db < DVB; ++db) oT[db] = MFMA32(vf[0][db], p0, oT[db]);
#pragma unroll
            for (int db = 0; db < DVB; ++db) oT[db] = MFMA32(vf[1][db], p1, oT[db]);
        }
    }
    {
#pragma unroll
        for (int jp = 0; jp < 2; ++jp) {
            bf16x8 vf[2][DVB];
#pragma unroll
            for (int j = 0; j < 2; ++j)
#pragma unroll
                for (int db = 0; db < DVB; ++db) vf[j][db] = *(const LAS bf16x8*)(VTtB + (32 * db + i31) * 128 + (((2 * (2 * jp + j) + h) ^ swv) << 4));
            const bf16x8 p0 = exp_pack8(jp == 0 ? b0 : b1, 0, ps), p1 = exp_pack8(jp == 0 ? b0 : b1, 1, ps);
#pragma unroll
            for (int db = 0; db < DVB; ++db) oT[db] = MFMA32(vf[0][db], p0, oT[db]);
#pragma unroll
            for (int db = 0; db < DVB; ++db) oT[db] = MFMA32(vf[1][db], p1, oT[db]);
        }
    }
    l_run += ps;
}

constexpr int L0_UNITS = 2176;
constexpr int L0_BUF = 16384;
constexpr int L0_RPB_OFF = 98304;
struct L0Args { const bf16_t* QK; const bf16_t* VT; bf16_t* Y; const float* sink; const float* rpb; };
#define L0_WAIT_BAR(N) asm volatile("s_waitcnt vmcnt(" #N ") lgkmcnt(0)\n\ts_barrier" ::: "memory")
struct L0Mask {
    int mode; const LAS float* tab; int vb; int dq;
    __device__ __forceinline__ void operator()(f32x16& s0, f32x16& s1) const {
        if (mode == 1) {
#pragma unroll
            for (int r = 0; r < 16; ++r) {
                const int kc0 = 16 * (r >> 3) + (r & 7), kc1 = 32 + kc0;
                const float b0 = tab[kc0], b1 = tab[kc1];
                s0[r] = ((unsigned)(kc0 + vb) < 16u) ? s0[r] + b0 : -INFINITY;
                s1[r] = ((unsigned)(kc1 + vb) < 16u) ? s1[r] + b1 : -INFINITY;
            }
        } else if (mode == 2) {
#pragma unroll
            for (int r = 0; r < 16; ++r) {
                const int kc0 = 16 * (r >> 3) + (r & 7), kc1 = 32 + kc0;
                const int d0 = dq - kc0, d1 = dq - kc1;
                if (d0 > 128 || d0 < -128) s0[r] = -INFINITY;
                if (d1 > 128 || d1 < -128) s1[r] = -INFINITY;
            }
        }
    }
};

struct L0Unit { int mode, b, qx, isB, lat0, nlat, nt, qtok0, hq, qcol, kcol, vrow; };
__device__ __forceinline__ L0Unit l0_decode(int u, int g) {
    L0Unit d; int kvh;
    if (u < 1024) { d.mode = 0; d.b = u >> 7; kvh = (u >> 6) & 1; d.qx = u & 63; d.isB = 1; }
    else if (u < 2048) { const int v = u - 1024; d.mode = 1; d.b = v >> 7; kvh = (v >> 6) & 1; d.qx = v & 63; d.isB = 0; }
    else { const int v = u - 2048; d.mode = 2; d.b = v >> 4; kvh = (v >> 2) & 1; d.isB = (v >> 3) & 1; d.qx = v & 3; }
    d.lat0 = 0; d.nlat = 0;
    if (d.mode == 0) { d.lat0 = min(max(d.qx - 4, 0), 56); d.nlat = 8; d.qtok0 = d.b * SEQ + 64 * d.qx; }
    else if (d.mode == 1) { d.lat0 = max(d.qx - 2, 0); d.nlat = min(d.qx + 2, 63) - d.lat0 + 1; d.qtok0 = d.b * SEQ + 64 * d.qx; }
    else { d.qtok0 = MLAT + d.b * CTXL + 64 * d.qx; }
    d.nt = d.nlat + 4;
    d.hq = 4 * kvh + g;
    d.qcol = d.isB * 512 + d.hq * 64; d.kcol = (d.isB ? 1152 : 1024) + 64 * kvh; d.vrow = d.isB * 128 + 64 * kvh;
    return d;
}
constexpr int L0_Q_OFF = 49152;
constexpr int L0_RPB2_OFF = 114688;
__device__ __forceinline__ void attn_l0_phase(LAS unsigned char* lds, const L0Args P, int bid, int G, int tid) {
    const int lane = tid & 63, wid = __builtin_amdgcn_readfirstlane(tid >> 6), i31 = lane & 31, h = lane >> 5;
    const int pi = (i31 & 0x13) | ((i31 & 4) << 1) | ((i31 & 8) >> 1);
    const int g = wid >> 1, jh = wid & 1;
    LAS float* rpbl = (LAS float*)(lds + L0_RPB2_OFF);
    for (int i = tid; i < 8 * 15 * 31; i += 512) rpbl[i] = P.rpb[i] * LOG2E_F;
    __syncthreads();
    int goff[2];
#pragma unroll
    for (int i = 0; i < 2; ++i) {
        const int p = 2 * wid + i, rl = lane >> 3, sl = lane & 7;
        if (wid < 4) { const int kr = 8 * p + rl, c = sl ^ ((kr >> 1) & 7); goff[i] = kr * NQK0 + c * 8; }
        else { const int e = 8 * (p - 8) + rl, c = sl ^ ((e >> 1) & 7); goff[i] = e * MTOT + c * 8; }
    }
    int qoff[4];
#pragma unroll
    for (int p = 0; p < 4; ++p) { const int row = 8 * p + (lane >> 3), c = (lane & 7) ^ ((row >> 1) & 7); qoff[p] = row * NQK0 + c * 8; }
#define L0_TOK0(D, t_) (((t_) < (D).nlat) ? (D).b * SEQ + 64 * ((D).lat0 + (t_)) : MLAT + (D).b * CTXL + 64 * ((t_) - (D).nlat))
#define L0_ISSUE(D, t_, bo_) do { const int tok0_ = L0_TOK0(D, t_); \
        const bf16_t* gb_ = (wid < 4) ? P.QK + (D).kcol + (size_t)tok0_ * NQK0 : P.VT + (size_t)(D).vrow * MTOT + tok0_; \
        _Pragma("unroll") for (int i_ = 0; i_ < 2; ++i_) __builtin_amdgcn_global_load_lds((const unsigned*)(gb_ + goff[i_]), (LAS unsigned*)(lds + (bo_) + (2 * wid + i_) * 1024), 16, 0, 0); } while (0)
#define L0_ISSUE_Q(D, bank_) do { const bf16_t* gq_ = P.QK + (size_t)((D).qtok0 + 32 * jh) * NQK0 + (D).qcol; \
        _Pragma("unroll") for (int p_ = 0; p_ < 4; ++p_) __builtin_amdgcn_global_load_lds((const unsigned*)(gq_ + qoff[p_]), (LAS unsigned*)(lds + L0_Q_OFF + (bank_) * 32768 + wid * 4096 + p_ * 1024), 16, 0, 0); } while (0)
    int u = bid;
    if (u >= L0_UNITS) return;
    L0Unit D = l0_decode(u, g);
    int r0 = 0, r1 = L0_BUF, r2 = 2 * L0_BUF, qbank = 0; bool later = false;
    L0_ISSUE(D, 0, r0); L0_ISSUE(D, 1, r1); L0_ISSUE_Q(D, 0);
    L0_WAIT_BAR(0);
    for (;;) {
        const int un = u + G; const bool has_next = un < L0_UNITS;
        L0Unit Dn = D; if (has_next) Dn = l0_decode(un, g);
        const int nt = D.nt;
        bf16x8 qf[4];
        { const LAS unsigned char* qb = lds + L0_Q_OFF + qbank * 32768 + wid * 4096; const int sw = (i31 >> 1) & 7;
#pragma unroll
          for (int d0 = 0; d0 < 4; ++d0) qf[d0] = *(const LAS bf16x8*)(qb + i31 * 128 + (((2 * d0 + h) ^ sw) << 4)); }
        float m_run, l_run;
        if (!D.isB) { m_run = P.sink[D.hq] * LOG2E_F; l_run = (h == 0) ? 1.f : 0.f; } else { m_run = 0.f; l_run = 0.f; }
        f32x16 negm;
#pragma unroll
        for (int r = 0; r < 16; ++r) negm[r] = -m_run;
        f32x16 oT[2]; oT[0] = f32x16{}; oT[1] = f32x16{};
        for (int t = 0; t < nt; ++t) {
            bool issued = false, issued_q = false;
            if (t + 2 < nt) { L0_ISSUE(D, t + 2, r2); issued = true; }
            else if (has_next) { L0_ISSUE(Dn, t + 2 - nt, r2); issued = true; if (t == nt - 1) { L0_ISSUE_Q(Dn, qbank ^ 1); issued_q = true; } }
            const LAS unsigned char* buf = lds + r0;
            L0Mask mk; mk.mode = 0; mk.tab = rpbl; mk.vb = 0; mk.dq = 0;
            if (t < D.nlat) {
                if (D.mode == 0) {
                    const int krow = D.lat0 + t, c = 32 * jh + i31, cstart = min(max(c - 8, 0), 48);
                    mk.mode = 1; mk.tab = rpbl + (D.hq * 15 + (krow - D.qx + 7)) * 31 + (8 * h - c + 15); mk.vb = 8 * h - cstart;
                } else {
                    const int tl = D.lat0 + t;
                    if (tl == D.qx - 2 || tl == D.qx + 2) { mk.mode = 2; mk.dq = 64 * D.qx + 32 * jh + i31 - 64 * tl - 8 * h; }
                }
            }
            tile_compute<2, L0Mask>(buf, buf + 8192, qf, oT, negm, m_run, l_run, D.isB && t == 0, pi, i31, h, mk);
            if (later && t == 0) L0_WAIT_BAR(63); else if (issued_q) L0_WAIT_BAR(6); else if (issued) L0_WAIT_BAR(2); else L0_WAIT_BAR(0);
            { const int tmp = r0; r0 = r1; r1 = r2; r2 = tmp; }
        }
        if (has_next) asm volatile("s_waitcnt vmcnt(0)" ::: "memory");
        const float l = l_run + __shfl_xor(l_run, 32);
        const float inv = 1.0f / l;
        bf16_t* yp = P.Y + (size_t)(D.qtok0 + 32 * jh + i31) * DM + D.qcol;
#pragma unroll
        for (int db = 0; db < 2; ++db)
#pragma unroll
            for (int rg = 0; rg < 4; ++rg) {
                u32x2 w; w.x = pk_bf16(oT[db][4 * rg] * inv, oT[db][4 * rg + 1] * inv); w.y = pk_bf16(oT[db][4 * rg + 2] * inv, oT[db][4 * rg + 3] * inv);
                *(u32x2*)(yp + 32 * db + 8 * rg + 4 * h) = w;
            }
        if (!has_next) break;
        u = un; D = Dn; qbank ^= 1; later = true;
    }
#undef L0_ISSUE
#undef L0_ISSUE_Q
#undef L0_TOK0
}
#undef L0_WAIT_BAR

constexpr int DF_SUB = 32768;
constexpr int DF_BUF = 65536;
constexpr int DF_X_OFF = 65536;
struct DiffArgs { const bf16_t* QK; const bf16_t* VT; bf16_t* Y; const float* lq1; const float* lk1; const float* lq2; const float* lk2; const float* subg; };
#define DF_WAIT_BAR(N) asm volatile("s_waitcnt vmcnt(" #N ") lgkmcnt(0)\n\ts_barrier" ::: "memory")

__device__ __forceinline__ void attn_diff_phase(LAS unsigned char* lds, const DiffArgs P, int bid, int G, int tid) {
    const int lane = tid & 63, wid = __builtin_amdgcn_readfirstlane(tid >> 6), i31 = lane & 31, h = lane >> 5;
    const int pi = (i31 & 0x13) | ((i31 & 4) << 1) | ((i31 & 8) >> 1);
    const int msub = wid & 1, jg = wid >> 1;
    const float lam = expf(wave_sum(P.lq1[lane] * P.lk1[lane])) - expf(wave_sum(P.lq2[lane] * P.lk2[lane])) + LAM_INIT;
    int goff[4];
#pragma unroll
    for (int i = 0; i < 4; ++i) {
        const int p = 4 * wid + i, rl = lane >> 3, sl = lane & 7;
        if (wid < 4) { const int kr = 8 * (p & 7) + rl, c = sl ^ ((kr >> 1) & 7); goff[i] = kr * NQK1 + (p >> 3) * 64 + c * 8; }
        else { const int e = 8 * (p - 16) + rl, c = sl ^ ((e >> 1) & 7); goff[i] = e * MTOT + c * 8; }
    }
    LAS float* subg_l = (LAS float*)(lds + 131072 + 256);
    if (tid < 128) subg_l[tid] = P.subg[tid];
    __syncthreads();
    const int nunits = NBATCH * 8 * 32;
#define DF_DECODE(it_, ok_, b_, hd_, qb_) do { int pair_; if (G == 256) { ok_ = (it_) < 8; pair_ = (bid & 7) * 8 + (it_); qb_ = bid >> 3; } \
        else { const int u_ = bid + (it_) * G; ok_ = u_ < nunits; pair_ = u_ >> 5; qb_ = u_ & 31; } b_ = pair_ >> 3; hd_ = pair_ & 7; } while (0)
#define DF_ISSUE(B_, KB_, VB_, st_, bo_) do { _Pragma("unroll") for (int sub_ = 0; sub_ < 2; ++sub_) { const int t_ = 2 * (st_) + sub_; \
            const int tok0_ = (t_ < 64) ? (B_) * SEQ + 64 * t_ : MLAT + (B_) * CTXL + 64 * (t_ - 64); \
            const bf16_t* gb_ = (wid < 4) ? (KB_) + (size_t)tok0_ * NQK1 : (VB_) + tok0_; \
            _Pragma("unroll") for (int i_ = 0; i_ < 4; ++i_) __builtin_amdgcn_global_load_lds((const unsigned*)(gb_ + goff[i_]), (LAS unsigned*)(lds + (bo_) + sub_ * DF_SUB + (4 * wid + i_) * 1024), 16, 0, 0); } } while (0)
    bool ok; int b, hd, qb;
    DF_DECODE(0, ok, b, hd, qb);
    if (!ok) return;
    const bf16_t* kbase = P.QK + 1024 + hd * 128;
    const bf16_t* vbase = P.VT + (size_t)(hd * 128) * MTOT;
    bf16x8 qf[4];
    { const int qtok0 = b * SEQ + 128 * qb + 32 * jg + i31;
#pragma unroll
      for (int d0 = 0; d0 < 4; ++d0) qf[d0] = *(const bf16x8*)(P.QK + (size_t)qtok0 * NQK1 + hd * 128 + msub * 64 + 16 * d0 + 8 * h); }
    DF_ISSUE(b, kbase, vbase, 0, 0);
    for (int it = 0; ; ++it) {
        const int qtok = b * SEQ + 128 * qb + 32 * jg + i31;
        float m_run = 0.f, l_run = 0.f;
        f32x16 oT[4]; oT[0] = f32x16{}; oT[1] = f32x16{}; oT[2] = f32x16{}; oT[3] = f32x16{};
        f32x16 negm = f32x16{};
        int b0 = 0, b1 = DF_BUF;
        asm volatile("" : "+v"(qf[0]), "+v"(qf[1]), "+v"(qf[2]), "+v"(qf[3]));
        DF_WAIT_BAR(0);
        constexpr int NST = 34;
        for (int st = 0; st < NST; ++st) {
            if (st + 1 < NST) DF_ISSUE(b, kbase, vbase, st + 1, b1);
            const LAS unsigned char* buf = lds + b0;
            tile_compute128<4>(buf + msub * 8192, buf + 16384, buf + DF_SUB + msub * 8192, buf + DF_SUB + 16384, qf, oT, negm, m_run, l_run, st == 0, pi, i31, h);
            DF_WAIT_BAR(0);
            { const int tmp = b0; b0 = b1; b1 = tmp; }
        }
        bool nok; int nb, nhd, nqb;
        DF_DECODE(it + 1, nok, nb, nhd, nqb);
        const int hd_cur = hd;
        if (nok) {
            kbase = P.QK + 1024 + nhd * 128; vbase = P.VT + (size_t)(nhd * 128) * MTOT;
            DF_ISSUE(nb, kbase, vbase, 0, 0);
            const int qtokn = nb * SEQ + 128 * nqb + 32 * jg + i31;
#pragma unroll
            for (int d0 = 0; d0 < 4; ++d0) qf[d0] = *(const bf16x8*)(P.QK + (size_t)qtokn * NQK1 + nhd * 128 + msub * 64 + 16 * d0 + 8 * h);
            b = nb; hd = nhd; qb = nqb;
        }
        const float l = l_run + __shfl_xor(l_run, 32);
        const float inv = 1.0f / l;
        LAS float* X = (LAS float*)(lds + DF_X_OFF) + jg * 4096;
        if (msub == 1) {
            const float f = lam * inv;
#pragma unroll
            for (int db = 0; db < 4; ++db)
#pragma unroll
                for (int r = 0; r < 16; ++r) X[(32 * db + crow(r, h)) * 32 + i31] = oT[db][r] * f;
        }
        __syncthreads();
        if (msub == 0) {
            float ssq = 0.f;
#pragma unroll
            for (int db = 0; db < 4; ++db)
#pragma unroll
                for (int r = 0; r < 16; ++r) { const float d = oT[db][r] * inv - X[(32 * db + crow(r, h)) * 32 + i31]; oT[db][r] = d; ssq += d * d; }
            ssq += __shfl_xor(ssq, 32);
            const float rn = rsqrtf(ssq * (1.0f / 128.0f) + EPS_F) * (1.0f - LAM_INIT);
            bf16_t* yp = P.Y + (size_t)qtok * DM + hd_cur * 128;
            f32x4 gqv[4][4];
#pragma unroll
            for (int db = 0; db < 4; ++db)
#pragma unroll
                for (int rg = 0; rg < 4; ++rg) gqv[db][rg] = *(const LAS f32x4*)(subg_l + 32 * db + 8 * rg + 4 * h);
#pragma unroll
            for (int db = 0; db < 4; ++db)
#pragma unroll
                for (int rg = 0; rg < 4; ++rg) {
                    const int e0 = 32 * db + 8 * rg + 4 * h;
                    const f32x4 gq = gqv[db][rg];
                    u32x2 w; w.x = pk_bf16(oT[db][4 * rg] * rn * gq[0], oT[db][4 * rg + 1] * rn * gq[1]); w.y = pk_bf16(oT[db][4 * rg + 2] * rn * gq[2], oT[db][4 * rg + 3] * rn * gq[3]);
                    *(u32x2*)(yp + e0) = w;
                }
        }
        __syncthreads();
        if (!nok) break;
    }
#undef DF_ISSUE
#undef DF_DECODE
}
#undef DF_WAIT_BAR
#undef MFMA32
}

constexpr size_t MiB = 1u << 20;
constexpr size_t WS_MOD = 0;
constexpr size_t WS_ROPE = 512 * 1024;
constexpr size_t WS_BIAS = 1 * MiB;
constexpr size_t WS_SS = 4 * MiB;
constexpr size_t WS_WQK0 = 8 * MiB, WS_WV0 = 11 * MiB, WS_WO0 = 12 * MiB, WS_W10 = 14 * MiB, WS_W20 = 22 * MiB;
constexpr size_t WS_WQK1 = 30 * MiB, WS_WV1 = 34 * MiB, WS_WO1 = 36 * MiB, WS_W11 = 38 * MiB, WS_W21 = 46 * MiB;
constexpr size_t WS_HR = 56 * MiB;
constexpr size_t WS_QK = 192 * MiB;
constexpr size_t WS_VT = 328 * MiB;
constexpr size_t WS_Y = 396 * MiB;
constexpr size_t WS_H = 192 * MiB;
constexpr size_t WS_SLAB = 464 * MiB;
constexpr size_t WS_END = 512 * MiB;
constexpr int BO_QK0 = 0, BO_V0 = BO_QK0 + 9 * NQK0, BO_UP0 = BO_V0 + 9 * NV0, BO_QK1 = BO_UP0 + 9 * DFF, BO_V1 = BO_QK1 + 9 * NQK1, BO_UP1 = BO_V1 + 9 * NV1;
constexpr int LDS_BYTES = 147456;
constexpr int NPHASE = 15;

__device__ __forceinline__ float silu_f(float v) { return v / (1.0f + expf(-v)); }
__device__ __forceinline__ void even_map(int c, int& isv, int& r) {
    if (c < 512) { isv = 0; r = c; } else if (c < 640) { isv = 0; r = 1024 + (c - 512); } else if (c < 768) { isv = 1; r = c - 640; }
    else if (c < 1280) { isv = 0; r = 512 + (c - 768); } else if (c < 1408) { isv = 0; r = 1152 + (c - 1280); } else { isv = 1; r = 128 + (c - 1408); }
}
__device__ __forceinline__ void gemv9_item(const float* __restrict__ W, int ldw, int csrc0, const LAS float* vec, LAS float* red, float* out, int ostride, int cdst0, const float* addb, int tid) {
    const int lane = tid & 63, kg = tid >> 6, cg = lane & 15, ks = lane >> 4;
    f32x4 a[9];
#pragma unroll
    for (int b = 0; b < 9; ++b) a[b] = (f32x4){0.f, 0.f, 0.f, 0.f};
    const float* wp = W + (size_t)(kg * 128 + ks) * ldw + csrc0 + 4 * cg;
    const LAS float* vp = vec + kg * 128 + ks;
#pragma unroll 8
    for (int i = 0; i < 32; ++i) {
        const f32x4 w = *(const f32x4*)(wp + (size_t)(4 * i) * ldw);
#pragma unroll
        for (int b = 0; b < 9; ++b) a[b] += w * vp[b * 1024 + 4 * i];
    }
    LAS float* rp = red + (kg * 4 + ks) * 576 + 4 * cg;
#pragma unroll
    for (int b = 0; b < 9; ++b) *(LAS f32x4*)(rp + b * 64) = a[b];
    __syncthreads();
    for (int idx = tid; idx < 576; idx += 512) {
        const int c = idx & 63; float s = 0.f;
#pragma unroll
        for (int g2 = 0; g2 < 32; ++g2) s += red[g2 * 576 + idx];
        if (addb) s += addb[csrc0 + c];
        out[(size_t)(idx >> 6) * ostride + cdst0 + c] = s;
    }
    __syncthreads();
}
__device__ __forceinline__ void transpose_item(const float* __restrict__ W, int K, int N, int k0, int n0, bf16_t* dst, LAS float* scr, int lane) {
    f32x4 v[8];
#pragma unroll
    for (int i = 0; i < 8; ++i) v[i] = *(const f32x4*)(W + (size_t)(k0 + 8 * i + (lane >> 3)) * N + n0 + 4 * (lane & 7));
#pragma unroll
    for (int i = 0; i < 8; ++i) { LAS float* sp = scr + (8 * i + (lane >> 3)) * 33 + 4 * (lane & 7); sp[0] = v[i][0]; sp[1] = v[i][1]; sp[2] = v[i][2]; sp[3] = v[i][3]; }
    asm volatile("s_waitcnt lgkmcnt(0)" ::: "memory");
    const int c = lane & 7;
#pragma unroll
    for (int j = 0; j < 4; ++j) { const int n = (lane >> 3) + 8 * j; const LAS float* s = scr + (8 * c) * 33 + n;
        u32x4 o; o.x = pk_bf16(s[0 * 33], s[1 * 33]); o.y = pk_bf16(s[2 * 33], s[3 * 33]); o.z = pk_bf16(s[4 * 33], s[5 * 33]); o.w = pk_bf16(s[6 * 33], s[7 * 33]);
        *(u32x4*)(dst + (size_t)n * K + k0 + 8 * c) = o; }
    asm volatile("s_waitcnt lgkmcnt(0)" ::: "memory");
}
__device__ __forceinline__ void sincos_small(double a, float& c, float& s) {
    const double TWO_PI = 6.283185307179586476925287;
    const double k = __builtin_rint(a / TWO_PI);
    const double x = a - k * TWO_PI, x2 = x * x;
    double ts = 1.0, tc = 1.0;
    for (int j = 15; j >= 1; --j) { ts = 1.0 - x2 / (double)((2 * j) * (2 * j + 1)) * ts; tc = 1.0 - x2 / (double)((2 * j - 1) * (2 * j)) * tc; }
    s = (float)(x * ts); c = (float)tc;
}

#define GAS __attribute__((address_space(1)))
#define XB_TMO      128
#define XB_XCNT(j)  (256  + 64 * (j))
#define XB_XSUB(j)  (1280 + 64 * (j))
#define XB_XGEN(j)  (2304 + 64 * (j))
#define XB_TOP      3328
#define XB_TOPGEN   3392
#define XCD_BAR_WORDS 3456
#define XB_SPIN_CAP (1u << 18)

__device__ __forceinline__ unsigned xb_ld(unsigned* p)              { return __hip_atomic_load(p, __ATOMIC_RELAXED, __HIP_MEMORY_SCOPE_AGENT); }
__device__ __forceinline__ unsigned xb_add(unsigned* p, unsigned v) { return __hip_atomic_fetch_add(p, v, __ATOMIC_RELAXED, __HIP_MEMORY_SCOPE_AGENT); }
__device__ __forceinline__ unsigned xb_xcc_id() { return (unsigned)__builtin_amdgcn_s_getreg((3 << 11) | 20) & 0xFu; }
#define XB_SPIN(cond, bar) do { unsigned _sp = 0; while (cond) { __builtin_amdgcn_s_sleep(1); \
    if ((++_sp & 255u) == 0u) { if (xb_ld(&(bar)[XB_TMO])) break; if (_sp > XB_SPIN_CAP) { atomicAdd(&(bar)[XB_TMO], 1u); break; } } } } while (0)

struct XcdBarrier {
    unsigned* bar; unsigned x;
    volatile LAS unsigned* st;
};

__device__ __forceinline__ XcdBarrier xcd_barrier_post(unsigned* bar, volatile LAS unsigned* st) {
    XcdBarrier b; b.bar = bar; b.x = xb_xcc_id(); b.st = st;
    if (threadIdx.x == 0) (void)xb_add(&bar[XB_XCNT(b.x)], 1u);
    return b;
}
__device__ __forceinline__ void xcd_barrier_complete(unsigned* bar, unsigned x, unsigned& nloc, unsigned& nx) {
    const unsigned G = gridDim.x * gridDim.y * gridDim.z;
    unsigned sum, cnt, mine, sp = 0u;
    for (;;) {
        sum = 0u; cnt = 0u; mine = 0u;
#pragma unroll
        for (unsigned j = 0; j < 16; ++j) { const unsigned c = xb_ld(&bar[XB_XCNT(j)]); sum += c; cnt += (c > 0u) ? 1u : 0u; mine = (j == x) ? c : mine; }
        if (sum == G) break;
        __builtin_amdgcn_s_sleep(1);
        if ((++sp & 255u) == 0u) { if (xb_ld(&bar[XB_TMO])) break; if (sp > XB_SPIN_CAP) { atomicAdd(&bar[XB_TMO], 1u); break; } }
    }
    nloc = mine > 0u ? mine : 1u; nx = cnt > 0u ? cnt : 1u;
}

__device__ __forceinline__ void xcd_barrier(const XcdBarrier& b) {
    asm volatile("s_waitcnt vmcnt(0)" ::: "memory");
    __syncthreads();
    if (threadIdx.x == 0) {
        unsigned* bar = b.bar;
        __builtin_amdgcn_s_waitcnt(0);
        unsigned nloc = b.st[0], nx = b.st[1];
        if (nloc == 0u) { xcd_barrier_complete(bar, b.x, nloc, nx); b.st[0] = nloc; b.st[1] = nx; }
        const unsigned old = xb_add(&bar[XB_XSUB(b.x)], 1u);
        const unsigned gen = old / nloc;
        if (old + 1u == (gen + 1u) * nloc) {
            __builtin_amdgcn_fence(__ATOMIC_RELEASE, "agent");
            asm volatile("s_waitcnt vmcnt(0)" ::: "memory");
            const unsigned og = xb_add(&bar[XB_TOP], 1u);
            const unsigned tg = og / nx;
            if (og + 1u == (tg + 1u) * nx) xb_add(&bar[XB_TOPGEN], 1u);
            else XB_SPIN(xb_ld(&bar[XB_TOPGEN]) == tg, bar);
            __builtin_amdgcn_fence(__ATOMIC_ACQUIRE, "agent");
            xb_add(&bar[XB_XGEN(b.x)], 1u);
            asm volatile("s_waitcnt vmcnt(0)" ::: "memory");
        } else {
            XB_SPIN(xb_ld(&bar[XB_XGEN(b.x)]) == gen, bar);
            __builtin_amdgcn_fence(__ATOMIC_ACQUIRE, "agent");
            asm volatile("s_waitcnt vmcnt(0)" ::: "memory");
        }
    }
    __syncthreads();
}

constexpr size_t WS_BAR = 2 * MiB;
constexpr int LDS_MISC_OFF = 131072;
template <bool HIN_BF> __device__ __forceinline__ void ctx_reduce(const float* slab_lo, const float* slab_hi, const void* hin, const float* gate, const float* scl, const float* ng, bf16_t* hout, bf16_t* xg, float* ss, int gw, int NGW, int lane) {
    for (int r = gw; r < MCTX; r += NGW) {
        f32x4 a[4];
#pragma unroll
        for (int j = 0; j < 4; ++j) a[j] = (f32x4){0.f, 0.f, 0.f, 0.f};
#pragma unroll
        for (int ks = 0; ks < 8; ++ks) {
            const float* sp = (ks < 6 ? slab_lo + (size_t)ks * MCTX * DM : slab_hi + (size_t)(ks - 6) * MCTX * DM) + (size_t)r * DM + 4 * lane;
#pragma unroll
            for (int j = 0; j < 4; ++j) a[j] += *(const f32x4*)(sp + 256 * j);
        }
        float ssum = 0.f;
#pragma unroll
        for (int j = 0; j < 4; ++j) {
            const int k = 4 * lane + 256 * j;
            f32x4 h0; if (HIN_BF) h0 = pg8::ld_bf4((const bf16_t*)hin + (size_t)r * DM + k); else h0 = *(const f32x4*)((const float*)hin + (size_t)r * DM + k);
            const f32x4 v = h0 + *(const f32x4*)(gate + 8 * 6144 + k) * a[j];
            if (hout) { u32x2 w; w.x = pk_bf16(v[0], v[1]); w.y = pk_bf16(v[2], v[3]); *(u32x2*)(hout + (size_t)r * DM + k) = w; }
            ssum += (v[0] * v[0] + v[1] * v[1]) + (v[2] * v[2] + v[3] * v[3]);
            const f32x4 y = v * (*(const f32x4*)(ng + k) * (*(const f32x4*)(scl + 8 * 6144 + k) + 1.0f));
            u32x2 w; w.x = pk_bf16(y[0], y[1]); w.y = pk_bf16(y[2], y[3]);
            *(u32x2*)(xg + (size_t)(MLAT + r) * DM + k) = w;
        }
        ssum = att::wave_sum(ssum);
        if (lane < 16) ss[(size_t)(MLAT + r) * 16 + lane] = (lane == 0) ? ssum : 0.f;
    }
}

__device__ __forceinline__ void transpose_dispatch(int it, LAS float* scr, int lane, const float* even_w_in, const float* even_w_out, const float* odd_w_in, const float* odd_w_out, const float* mlp_w1, const float* mlp_w2,
                                                   bf16_t* Wqk0, bf16_t* Wv0, bf16_t* Wo0, bf16_t* Wqk1, bf16_t* Wv1, bf16_t* Wo1, bf16_t* W10, bf16_t* W11, bf16_t* W20, bf16_t* W21) {
    int r = it;
    if (r < 768) { const int kb = r / 48, nb = r % 48; int isv, dr; even_map(32 * nb, isv, dr);
        transpose_item(even_w_in, DM, 1536, 64 * kb, 32 * nb, (isv ? Wv0 : Wqk0) + (size_t)dr * DM, scr, lane); return; } r -= 768;
    if (r < 512) { const int kb = r / 32, nb = r % 32; transpose_item(even_w_out, DM, DM, 64 * kb, 32 * nb, Wo0 + (size_t)(32 * nb) * DM, scr, lane); return; } r -= 512;
    if (r < 1536) { const int kb = r / 96, nb = r % 96; const int n0 = 32 * nb;
        transpose_item(odd_w_in, DM, 3072, 64 * kb, n0, n0 < 2048 ? Wqk1 + (size_t)n0 * DM : Wv1 + (size_t)(n0 - 2048) * DM, scr, lane); return; } r -= 1536;
    if (r < 512) { const int kb = r / 32, nb = r % 32; transpose_item(odd_w_out, DM, DM, 64 * kb, 32 * nb, Wo1 + (size_t)(32 * nb) * DM, scr, lane); return; } r -= 512;
    if (r < 4096) { const int l = r / 2048, q = r % 2048, kb = q / 128, nb = q % 128;
        transpose_item(mlp_w1 + (size_t)l * DM * DFF, DM, DFF, 64 * kb, 32 * nb, (l ? W11 : W10) + (size_t)(32 * nb) * DM, scr, lane); return; } r -= 4096;
    { const int l = r / 2048, q = r % 2048, kb = q / 32, nb = q % 32;
        transpose_item(mlp_w2 + (size_t)l * DFF * DM, DFF, DM, 64 * kb, 32 * nb, (l ? W21 : W20) + (size_t)(32 * nb) * DFF, scr, lane); }
}

#ifndef USE_FINAL
#define USE_FINAL 0
#endif
struct Args { const float* in[22]; float* out; unsigned char* ws; int ph_lo, ph_hi; };

__global__ void __launch_bounds__(512, 2) dit_fwd(Args args) {
    extern __shared__ __attribute__((aligned(16))) unsigned char lds_raw[];
    LAS unsigned char* lds = (LAS unsigned char*)lds_raw;
    const int tid = threadIdx.x, lane = tid & 63, wave = __builtin_amdgcn_readfirstlane(tid >> 6);
    const int bid = blockIdx.x, G = gridDim.x;
    const int gw = bid * 8 + wave, NGW = G * 8;
    unsigned char* ws = args.ws;
    const float* x = args.in[0]; const float* cvec = args.in[1]; const float* ctx = args.in[2]; const float* c_ctx = args.in[3];
    const float* ada_w = args.in[4]; const float* ada_b = args.in[5]; const float* norm1_g = args.in[6]; const float* norm2_g = args.in[7];
    const float* even_w_in = args.in[8]; const float* even_w_out = args.in[9]; const float* a_sink = args.in[10]; const float* b_rpb = args.in[11];
    const float* odd_w_in = args.in[12]; const float* odd_w_out = args.in[13];
    const float* mlp_w1 = args.in[19]; const float* mlp_w2 = args.in[20]; const float* final_g = args.in[21];
    float* mod = (float*)(ws + WS_MOD); float* ropetab = (float*)(ws + WS_ROPE); float* biasb = (float*)(ws + WS_BIAS); float* ssb = (float*)(ws + WS_SS);
    bf16_t* Wqk0 = (bf16_t*)(ws + WS_WQK0); bf16_t* Wv0 = (bf16_t*)(ws + WS_WV0); bf16_t* Wo0 = (bf16_t*)(ws + WS_WO0); bf16_t* W10 = (bf16_t*)(ws + WS_W10); bf16_t* W20 = (bf16_t*)(ws + WS_W20);
    bf16_t* Wqk1 = (bf16_t*)(ws + WS_WQK1); bf16_t* Wv1 = (bf16_t*)(ws + WS_WV1); bf16_t* Wo1 = (bf16_t*)(ws + WS_WO1); bf16_t* W11 = (bf16_t*)(ws + WS_W11); bf16_t* W21 = (bf16_t*)(ws + WS_W21);
    bf16_t* HR = (bf16_t*)(ws + WS_HR); bf16_t* QK = (bf16_t*)(ws + WS_QK); bf16_t* VT = (bf16_t*)(ws + WS_VT); bf16_t* Y = (bf16_t*)(ws + WS_Y); bf16_t* Hb = (bf16_t*)(ws + WS_H);
    bf16_t* XG = (bf16_t*)args.out;
    const int lo = args.ph_lo, hi = args.ph_hi;
#define IN(k) (lo <= (k) && (k) < hi)
#ifdef PROBE_STAMPS
    unsigned long long* stamps = (unsigned long long*)(ws + 3 * MiB);
    if (bid == 0 && tid == 0) stamps[0] = __builtin_amdgcn_s_memrealtime();
#define SEAM(k) do { if (IN(k) && IN((k) + 1)) { cg::this_grid().sync(); if (bid == 0 && tid == 0) stamps[(k) + 1] = __builtin_amdgcn_s_memrealtime(); } } while (0)
#else
    volatile LAS unsigned* misc = (volatile LAS unsigned*)(lds + LDS_MISC_OFF);
    if (tid < 4) misc[tid] = 0u;
    __syncthreads();
    XcdBarrier xbar; xbar.bar = (unsigned*)(ws + WS_BAR); xbar.x = 0; xbar.st = nullptr;
    if (hi - lo > 1) xbar = xcd_barrier_post((unsigned*)(ws + WS_BAR), misc);
#define SEAM(k) do { if (IN(k) && IN((k) + 1)) { xcd_barrier(xbar); } } while (0)
#endif

    if (IN(0)) {
        if (bid < 192) {
            LAS float* vec = (LAS float*)lds; LAS float* red = (LAS float*)(lds + 40960);
            for (int i = tid; i < 9 * 1024; i += 512) { const float v = (i < 8192) ? cvec[i] : c_ctx[i - 8192]; vec[i] = silu_f(v); }
            __syncthreads();
            const int l = bid / 96, cb = bid % 96;
            gemv9_item(ada_w + (size_t)l * DM * 6144, 6144, cb * 64, vec, red, mod + (size_t)l * 9 * 6144, 6144, cb * 64, ada_b + (size_t)l * 6144, tid);
        }
        if (bid == G - 1) {
            for (int idx = tid; idx < 1024; idx += 512) {
                const int pos = idx >> 4, i = idx & 15; double f = 1.0;
                for (int q = 0; q < i; ++q) f *= 0.56234132519034908;
                float c, s; sincos_small((double)pos * f, c, s);
                ropetab[2 * idx] = c; ropetab[2 * idx + 1] = s;
            }
        }
        __syncthreads();
        LAS float* scr = (LAS float*)(lds + wave * 8448);
        const bool defer = (G == 256);
        for (int it = gw; it < (defer ? 768 : 11520); it += NGW) transpose_dispatch(it, scr, lane, even_w_in, even_w_out, odd_w_in, odd_w_out, mlp_w1, mlp_w2, Wqk0, Wv0, Wo0, Wqk1, Wv1, Wo1, W10, W11, W20, W21);
    }
    SEAM(0);
    if (IN(1)) {
        if (bid < 200) {
            LAS float* vec = (LAS float*)lds; LAS float* red = (LAS float*)(lds + 40960);
            int l, soff; if (bid < 24) { l = 0; soff = 0; } else if (bid < 88) { l = 0; soff = 3072; } else if (bid < 136) { l = 1; soff = 0; } else { l = 1; soff = 3072; }
            for (int i = tid; i < 9 * 1024; i += 512) vec[i] = mod[(size_t)(l * 9 + (i >> 10)) * 6144 + soff + (i & 1023)];
            __syncthreads();
            if (bid < 24) { const int c0 = 64 * bid; int isv, dr; even_map(c0, isv, dr);
                gemv9_item(even_w_in, 1536, c0, vec, red, biasb + (isv ? BO_V0 : BO_QK0), isv ? NV0 : NQK0, dr, nullptr, tid); }
            else if (bid < 88) { const int c0 = 64 * (bid - 24); gemv9_item(mlp_w1, DFF, c0, vec, red, biasb + BO_UP0, DFF, c0, nullptr, tid); }
            else if (bid < 136) { const int c0 = 64 * (bid - 88);
                if (c0 < 2048) gemv9_item(odd_w_in, 3072, c0, vec, red, biasb + BO_QK1, NQK1, c0, nullptr, tid);
                else gemv9_item(odd_w_in, 3072, c0, vec, red, biasb + BO_V1, NV1, c0 - 2048, nullptr, tid); }
            else { const int c0 = 64 * (bid - 136); gemv9_item(mlp_w1 + (size_t)DM * DFF, DFF, c0, vec, red, biasb + BO_UP1, DFF, c0, nullptr, tid); }
        }
        for (int r4 = gw; r4 < MTOT / 4; r4 += NGW) {
            const int row0 = 4 * r4;
            const float* src = row0 < MLAT ? x + (size_t)row0 * DM : ctx + (size_t)(row0 - MLAT) * DM;
            const int b = row0 < MLAT ? (row0 >> 12) : 8;
            const float* scl = mod + (size_t)b * 6144 + 1024;
            f32x4 v[4][4];
#pragma unroll
            for (int rr = 0; rr < 4; ++rr)
#pragma unroll
                for (int j = 0; j < 4; ++j) v[rr][j] = *(const f32x4*)(src + (size_t)rr * DM + 4 * lane + 256 * j);
            f32x4 gp[4];
#pragma unroll
            for (int j = 0; j < 4; ++j) { const int k = 4 * lane + 256 * j; gp[j] = *(const f32x4*)(norm1_g + k) * (*(const f32x4*)(scl + k) + 1.0f); }
#pragma unroll
            for (int rr = 0; rr < 4; ++rr) {
                float ssum = 0.f;
#pragma unroll
                for (int j = 0; j < 4; ++j) {
                    const f32x4 t = v[rr][j];
                    ssum += (t[0] * t[0] + t[1] * t[1]) + (t[2] * t[2] + t[3] * t[3]);
                    const f32x4 y = t * gp[j];
                    u32x2 w; w.x = pk_bf16(y[0], y[1]); w.y = pk_bf16(y[2], y[3]);
                    *(u32x2*)(XG + (size_t)(row0 + rr) * DM + 4 * lane + 256 * j) = w;
                }
                ssum = att::wave_sum(ssum);
                if (lane < 16) ssb[(size_t)(row0 + rr) * 16 + lane] = (lane == 0) ? ssum : 0.f;
            }
        }
    }
    SEAM(1);
    if (IN(2)) {
        { pg8::Gemm g{XG, Wqk0, MTOT, NQK0, DM}; pg8::StaticOrder S; S.init(MTOT, NQK0, G, bid, DM);
          pg8::EpiQK E{QK, NQK0, ssb, biasb + BO_QK0, 0x10Fu, 0x0FFu, ropetab, lds}; pg8::fill_rstd_table<pg8::StaticOrder, false>(lds, S, ssb);
          pg8::gemm_phase<pg8::EpiQK, pg8::StaticOrder, true, true>(lds, g, S, E); }
        { pg8::Gemm g{Wv0, XG, NV0, MTOT, DM}; pg8::StaticOrder S; S.init(NV0, MTOT, G, bid, DM);
          pg8::EpiVT E{VT, MTOT, ssb, biasb + BO_V0, NV0, lds}; pg8::fill_rstd_table<pg8::StaticOrder, true>(lds, S, ssb);
          pg8::gemm_phase<pg8::EpiVT, pg8::StaticOrder, true, true>(lds, g, S, E); }
        if (G == 256 && bid >= 168) {
            LAS float* scr = (LAS float*)(lds + wave * 8448);
            for (int it = 768 + (bid - 168) * 8 + wave; it < 11520; it += 88 * 8) transpose_dispatch(it, scr, lane, even_w_in, even_w_out, odd_w_in, odd_w_out, mlp_w1, mlp_w2, Wqk0, Wv0, Wo0, Wqk1, Wv1, Wo1, W10, W11, W20, W21);
        }
    }
    SEAM(2);
    if (IN(3)) { att::L0Args P{QK, VT, Y, a_sink, b_rpb}; att::attn_l0_phase(lds, P, bid, G, tid); }
    SEAM(3);
    if (IN(4)) {
        pg8::Gemm g{Y, Wo0, MTOT, DM, DM};
        pg8::EpiResT<false, true> E{x, ctx, HR, XG, ssb, mod + 2048, mod + 4096, norm2_g};
        { pg8::StaticOrder S; S.init(G == 256 ? MLAT : MTOT, DM, G, bid, DM); pg8::gemm_phase<pg8::EpiResT<false, true>, pg8::StaticOrder, true, true>(lds, g, S, E); }
        if (G == 256) { pg8::SplitCtxOrder S; S.init(bid, DM);
            pg8::EpiSlab E2{(float*)(ws + WS_QK), (float*)(ws + WS_QK) + (size_t)6 * MCTX * DM};
            pg8::gemm_phase<pg8::EpiSlab, pg8::SplitCtxOrder, true, true>(lds, g, S, E2); }
    }
    SEAM(4);
    if (IN(5)) { if (G == 256) ctx_reduce<false>((const float*)(ws + WS_QK), (const float*)(ws + WS_QK) + (size_t)6 * MCTX * DM, ctx, mod + 2048, mod + 4096, norm2_g, HR + (size_t)MLAT * DM, XG, ssb, gw, NGW, lane); }
    SEAM(5);
    if (IN(6)) {
        pg8::Gemm g{XG, W10, MTOT, DFF, DM}; pg8::StaticOrder S; S.init(MTOT, DFF, G, bid, DM);
        pg8::EpiUp E{Hb, ssb, biasb + BO_UP0, lds}; pg8::fill_rstd_table<pg8::StaticOrder, false>(lds, S, ssb);
        pg8::gemm_phase<pg8::EpiUp, pg8::StaticOrder, true, true>(lds, g, S, E);
    }
    SEAM(6);
    if (IN(7)) {
        pg8::Gemm g{Hb, W20, MTOT, DM, DFF};
        pg8::EpiResT<true, true> E{HR, HR + (size_t)MLAT * DM, HR, XG, ssb, mod + 5120, mod + 9 * 6144 + 1024, norm1_g + DM};
        { pg8::StaticOrder S; S.init(G == 256 ? MLAT : MTOT, DM, G, bid, DFF); pg8::gemm_phase<pg8::EpiResT<true, true>, pg8::StaticOrder, true, true>(lds, g, S, E); }
        if (G == 256) { pg8::SplitCtxOrder S; S.init(bid, DFF);
            pg8::EpiSlab E2{(float*)(ws + WS_SLAB), (float*)((unsigned char*)args.out + 72 * MiB)};
            pg8::gemm_phase<pg8::EpiSlab, pg8::SplitCtxOrder, true, true>(lds, g, S, E2); }
    }
    SEAM(7);
    if (IN(8)) { if (G == 256) ctx_reduce<true>((const float*)(ws + WS_SLAB), (const float*)((const unsigned char*)args.out + 72 * MiB), HR + (size_t)MLAT * DM, mod + 5120, mod + 9 * 6144 + 1024, norm1_g + DM, nullptr, XG, ssb, gw, NGW, lane); }
    SEAM(8);
    if (IN(9)) {
        { pg8::Gemm g{XG, Wqk1, MTOT, NQK1, DM}; pg8::StaticOrder S; S.init(MTOT, NQK1, G, bid, DM);
          pg8::EpiQK E{QK, NQK1, ssb, biasb + BO_QK1, 0xFFFFu, 0x00FFu, ropetab, lds}; pg8::fill_rstd_table<pg8::StaticOrder, false>(lds, S, ssb);
          pg8::gemm_phase<pg8::EpiQK, pg8::StaticOrder, true, true>(lds, g, S, E); }
        { pg8::Gemm g{Wv1, XG, NV1, MTOT, DM}; pg8::StaticOrder S; S.init(NV1, MTOT, G, (bid + G / 2) % G, DM);
          pg8::EpiVT E{VT, MTOT, ssb, biasb + BO_V1, NV1, lds}; pg8::fill_rstd_table<pg8::StaticOrder, true>(lds, S, ssb);
          pg8::gemm_phase<pg8::EpiVT, pg8::StaticOrder, true, true>(lds, g, S, E); }
    }
    SEAM(9);
    if (IN(10)) { att::DiffArgs P{QK, VT, Y, args.in[14], args.in[15], args.in[16], args.in[17], args.in[18]}; att::attn_diff_phase(lds, P, bid, G, tid); }
    SEAM(10);
    if (IN(11)) {
        pg8::Gemm g{Y, Wo1, MLAT, DM, DM}; pg8::StaticOrder S; S.init(MLAT, DM, G, bid, DM);
        pg8::EpiResT<true, true> E{HR, HR, HR, XG, ssb, mod + 9 * 6144 + 2048, mod + 9 * 6144 + 4096, norm2_g + DM};
        pg8::gemm_phase<pg8::EpiResT<true, true>, pg8::StaticOrder, true, true>(lds, g, S, E);
    }
    SEAM(11);
    if (IN(12)) {
        pg8::Gemm g{XG, W11, MLAT, DFF, DM}; pg8::StaticOrder S; S.init(MLAT, DFF, G, bid, DM);
        pg8::EpiUp E{Hb, ssb, biasb + BO_UP1, lds}; pg8::fill_rstd_table<pg8::StaticOrder, false>(lds, S, ssb);
        pg8::gemm_phase<pg8::EpiUp, pg8::StaticOrder, true, true>(lds, g, S, E);
    }
    SEAM(12);
    if (IN(13)) {
        pg8::Gemm g{Hb, W21, MLAT, DM, DFF}; pg8::StaticOrder S; S.init(MLAT, DM, G, bid, DFF);
        if (G == 256 && USE_FINAL) {
            pg8::EpiFinal E{(const float*)HR, args.out, ssb, mod + 9 * 6144 + 5120, final_g, (unsigned*)(ws + WS_BAR) + 4096};
            pg8::gemm_phase<pg8::EpiFinal, pg8::StaticOrder, true, true>(lds, g, S, E);
        } else {
            pg8::EpiResT<true, false> E{HR, HR, args.out, nullptr, ssb, mod + 9 * 6144 + 5120, nullptr, nullptr};
            pg8::gemm_phase<pg8::EpiResT<true, false>, pg8::StaticOrder, true, true>(lds, g, S, E);
        }
    }
    if (G != 256 || !USE_FINAL) { SEAM(13); }
    if (IN(14) && (G != 256 || !USE_FINAL)) {
        for (int row = gw; row < MLAT; row += NGW) {
            const float rs = pg8::row_rstd(ssb, row);
            float* op = args.out + (size_t)row * DM;
#pragma unroll
            for (int j = 0; j < 4; ++j) { const int k = 4 * lane + 256 * j; const f32x4 v = *(const f32x4*)(op + k), g = *(const f32x4*)(final_g + k); *(f32x4*)(op + k) = v * rs * g; }
        }
    }
#ifdef PROBE_STAMPS
    cg::this_grid().sync();
    if (bid == 0 && tid == 0) stamps[13] = __builtin_amdgcn_s_memrealtime();
    cg::this_grid().sync();
    {
        const float da = (float)(stamps[PA_HI] - stamps[PA_LO]) * 0.01f, db = (float)(stamps[PB_HI] - stamps[PB_LO]) * 0.01f;
        for (size_t i = (size_t)bid * 512 + tid; i < (size_t)(1u << 22); i += (size_t)G * 512) args.out[i] += (i == 0) ? 0.1f * da : 1e-3f * db;
    }
#endif
#undef IN
#undef SEAM
}

#ifndef N_LAUNCH_MODE
#define N_LAUNCH_MODE 0
#endif
extern "C" void kernel_launch(void* const* d_in, const int* in_sizes, int n_in, void* d_out, int out_size, void* d_ws, size_t ws_size, hipStream_t stream) {
    static int grid = 0;
    if (grid == 0) {
        if (n_in != 22 || out_size != MLAT * DM || ws_size < WS_END) { fprintf(stderr, "kernel_launch: unexpected shapes (n_in %d out %d ws %zu)\n", n_in, out_size, ws_size); grid = -1; return; }
        int dev = 0, cus = 0, per_cu = 0;
        if (hipGetDevice(&dev) != hipSuccess || hipDeviceGetAttribute(&cus, hipDeviceAttributeMultiprocessorCount, dev) != hipSuccess) { grid = -1; return; }
        if (hipFuncSetAttribute((const void*)dit_fwd, hipFuncAttributeMaxDynamicSharedMemorySize, LDS_BYTES) != hipSuccess) { fprintf(stderr, "kernel_launch: hipFuncSetAttribute failed\n"); grid = -1; return; }
        if (hipOccupancyMaxActiveBlocksPerMultiprocessor(&per_cu, (const void*)dit_fwd, 512, LDS_BYTES) != hipSuccess || per_cu < 1) { fprintf(stderr, "kernel_launch: occupancy query says %d\n", per_cu); per_cu = 1; }
        (void)hipGetLastError();
        grid = cus;
        if (grid % 8 != 0 || grid < 8) { fprintf(stderr, "kernel_launch: unexpected CU count %d\n", cus); }
    }
    if (grid < 0) return;
    (void)hipMemsetAsync((unsigned char*)d_ws + WS_BAR, 0, 65536, stream);
    Args a{};
    for (int i = 0; i < 22; ++i) a.in[i] = (const float*)d_in[i];
    a.out = (float*)d_out; a.ws = (unsigned char*)d_ws;
#if N_LAUNCH_MODE == 0
    a.ph_lo = 0; a.ph_hi = NPHASE;
    void* kargs[] = {&a};
    hipError_t e = hipLaunchCooperativeKernel((const void*)dit_fwd, dim3(grid), dim3(512), kargs, LDS_BYTES, stream);
    if (e != hipSuccess) fprintf(stderr, "kernel_launch: cooperative launch failed: %s (grid %d)\n", hipGetErrorString(e), grid);
#else
    for (int p = 0; p < NPHASE; ++p) { a.ph_lo = p; a.ph_hi = p + 1; hipLaunchKernelGGL(dit_fwd, dim3(grid), dim3(512), LDS_BYTES, stream, a); }
#endif
}
```

```cpp
#include <hip/hip_runtime.h>
#include <hip/hip_cooperative_groups.h>
#include <cstdio>
#include <cstdint>
namespace cg = cooperative_groups;

#define LAS __attribute__((address_space(3)))
typedef unsigned short bf16_t;
typedef short bf16x8 __attribute__((ext_vector_type(8)));
typedef float f32x4 __attribute__((ext_vector_type(4)));
typedef float f32x16 __attribute__((ext_vector_type(16)));
typedef unsigned u32x4 __attribute__((ext_vector_type(4)));
typedef unsigned u32x2 __attribute__((ext_vector_type(2)));
typedef float f32x2_t __attribute__((ext_vector_type(2)));
typedef __bf16 bf16x2_t __attribute__((ext_vector_type(2)));
__device__ __forceinline__ unsigned pk_bf16(float lo, float hi) { f32x2_t v = {lo, hi}; bf16x2_t b = __builtin_convertvector(v, bf16x2_t); return __builtin_bit_cast(unsigned, b); }

constexpr int DM = 1024, NBATCH = 8, SEQ = 4096, CTXL = 256, DFF = 4096;
constexpr int MLAT = NBATCH * SEQ;
constexpr int MCTX = NBATCH * CTXL;
constexpr int MTOT = MLAT + MCTX;
constexpr float EPS_F = 1e-6f;
constexpr float LOG2E_F = 1.4426950408889634f;
constexpr float QSCALE = 0.125f * LOG2E_F;
constexpr float LAM_INIT = 0.35550906759096926f;
constexpr int NQK0 = 1280, NV0 = 256, NQK1 = 2048, NV1 = 1024;

namespace pg8 {
#define PG8_LAS __attribute__((address_space(3)))
constexpr int BM = 256, BK = 64, HALF = 128, HTB = HALF * BK * 2  , STAGE_BYTES = 8 * HTB, NXCD = 8, WGM = 8;

__host__ __device__ __forceinline__ int lds_byte(int r, int c) { const int st = (r >> 4) * 2 + (c >> 5), rr = r & 15, cc = c & 31, ob = rr * 64 + cc * 2; return st * 1024 + (ob ^ (((ob >> 9) & 1) << 5)); }
__host__ __device__ __forceinline__ void stage_rc(int b, int& R, int& C) { const int st = b / 1024, sb = b % 1024, swz = sb ^ (((sb >> 9) & 1) << 5); R = (st >> 1) * 16 + swz / 64; C = (st & 1) * 32 + (swz % 64) / 2; }
__host__ __device__ __forceinline__ int perm32(int rho) { const int n = rho >> 4, i = rho & 15; return 8 * (i >> 2) + 4 * n + (i & 3); }

struct Unit { int pm, pn, koff, nt, ord; };
struct Gemm { const bf16_t* A; const bf16_t* Bt; int M, N, K; };

struct StaticOrder {
    int nM, nN, nwg, G, c, ntf;
    __host__ __device__ void init(int M, int N, int G_, int c_, int K_) { nM = M / BM; nN = N / BM; nwg = nM * nN; G = G_; c = c_; ntf = K_ / BK; }
    __host__ __device__ bool next(int i, Unit& u) const {
        const long L = (long)i * G + c; if (L >= nwg) return false;
        int wgid = (int)L; { const int q = nwg / NXCD, r = nwg % NXCD, xcd = wgid % NXCD, off = wgid / NXCD; wgid = (xcd < r ? xcd * (q + 1) : r * (q + 1) + (xcd - r) * q) + off; }
        const int nig = WGM * nN, gid = wgid / nig, fm = gid * WGM, gsz = (nM - fm) < WGM ? (nM - fm) : WGM;
        u.pm = fm + ((wgid % nig) % gsz); u.pn = (wgid % nig) / gsz; u.koff = 0; u.nt = ntf; u.ord = i; return true;
    }
    __device__ __forceinline__ void a_ready(const Unit&) const {}
    __device__ __forceinline__ void done(const Unit&) const {}
};

__device__ __forceinline__ int batch_of_tile(int p) { return p < 128 ? (p >> 4) : 8; }
__device__ __forceinline__ float row_rstd(const float* ss, int row) {
    const f32x4* sp = (const f32x4*)(ss + (size_t)row * 16);
    const f32x4 a = sp[0], b = sp[1], c = sp[2], d = sp[3];
    const f32x4 t = (a + b) + (c + d);
    const float tot = (t[0] + t[1]) + (t[2] + t[3]);
    return rsqrtf(tot * (1.0f / 1024.0f) + EPS_F);
}

__device__ __forceinline__ void rows_rstd8(float (&rsv)[2][4], const float* ss, int row0, int fq) {
    f32x4 a[2][4];
#pragma unroll
    for (int ai = 0; ai < 2; ++ai)
#pragma unroll
        for (int m = 0; m < 4; ++m) a[ai][m] = *(const f32x4*)(ss + (size_t)(row0 + ai * HALF + m * 16) * 16 + 4 * fq);
#pragma unroll
    for (int ai = 0; ai < 2; ++ai)
#pragma unroll
        for (int m = 0; m < 4; ++m) {
            float t = (a[ai][m][0] + a[ai][m][1]) + (a[ai][m][2] + a[ai][m][3]);
            t += __shfl_xor(t, 16); t += __shfl_xor(t, 32);
            rsv[ai][m] = rsqrtf(t * (1.0f / 1024.0f) + EPS_F);
        }
}
constexpr int RSTAB_OFF = 131072 + 256, RSTAB_MAX_UNITS = 15;
template <class Sched, bool BY_PN>
__device__ __forceinline__ void fill_rstd_table(PG8_LAS unsigned char* lds, const Sched& S, const float* ss) {
    PG8_LAS float* tab = (PG8_LAS float*)(lds + RSTAB_OFF);
    const int t = threadIdx.x;
#pragma unroll 4
    for (int i0 = 0; i0 < RSTAB_MAX_UNITS + 1; i0 += 2) {
        Unit u; const int i = i0 + (t >> 8);
        if (i < RSTAB_MAX_UNITS && S.next(i, u)) tab[i * 256 + (t & 255)] = row_rstd(ss, (BY_PN ? u.pn : u.pm) * BM + (t & 255));
    }
    __syncthreads();
}
struct EpiQK {
    static constexpr bool PERM = false, AFTER_DRAIN = false;
    bf16_t* O; int ldc; const float* ss; const float* bias; unsigned ropemask, scalemask; const float* ropetab; PG8_LAS unsigned char* lds_base;
    __device__ __forceinline__ void operator()(const f32x4 (&acc)[2][2][4][2], const Unit& u, int wr, int wc, int fr, int fq) const {
        const int bidx = batch_of_tile(u.pm);
        const int colb = u.pn * BM + wc * 32 + 4 * fq;
        f32x4 bv[2][2];
#pragma unroll
        for (int bj = 0; bj < 2; ++bj)
#pragma unroll
            for (int n = 0; n < 2; ++n) bv[bj][n] = *(const f32x4*)(bias + (size_t)bidx * ldc + colb + bj * HALF + n * 16);
        const PG8_LAS float* rtab = (const PG8_LAS float*)(lds_base + RSTAB_OFF) + u.ord * 256 + wr * 64 + fr;
#pragma unroll
        for (int ai = 0; ai < 2; ++ai) {
#pragma unroll
            for (int m = 0; m < 4; ++m) {
                const int row = u.pm * BM + ai * HALF + wr * 64 + m * 16 + fr;
                const float rs = rtab[ai * HALF + m * 16];
                const bool islat = row < MLAT;
                const int tpos = row & (SEQ - 1);
                const int pos = (wc & 1) ? (tpos & 63) : (tpos >> 6);
                const f32x4* rt = (const f32x4*)(ropetab + (size_t)(pos * 16 + 4 * fq) * 2);
                const f32x4 c0 = rt[0], c1 = rt[1];
                const float cc[4] = {c0[0], c0[2], c1[0], c1[2]}, sn[4] = {c0[1], c0[3], c1[1], c1[3]};
                bf16_t* rowp = O + (size_t)row * ldc + colb;
#pragma unroll
                for (int bj = 0; bj < 2; ++bj) {
                    const int c128 = u.pn * 2 + bj;
                    f32x4 v0 = acc[ai][bj][m][0] * rs + bv[bj][0], v1 = acc[ai][bj][m][1] * rs + bv[bj][1];
                    if (((ropemask >> c128) & 1u) && islat) {
#pragma unroll
                        for (int e = 0; e < 4; ++e) { const float x0 = v0[e], x1 = v1[e]; v0[e] = x0 * cc[e] - x1 * sn[e]; v1[e] = x1 * cc[e] + x0 * sn[e]; }
                    }
                    if ((scalemask >> c128) & 1u) { v0 = v0 * QSCALE; v1 = v1 * QSCALE; }
                    u32x2 w0, w1; w0.x = pk_bf16(v0[0], v0[1]); w0.y = pk_bf16(v0[2], v0[3]); w1.x = pk_bf16(v1[0], v1[1]); w1.y = pk_bf16(v1[2], v1[3]);
                    *(u32x2*)(rowp + bj * HALF) = w0; *(u32x2*)(rowp + bj * HALF + 16) = w1;
                }
            }
        }
    }
};

struct EpiVT {
    static constexpr bool PERM = true, AFTER_DRAIN = false;
    bf16_t* O; int ldc; const float* ss; const float* bias; int NV; PG8_LAS unsigned char* lds_base;
    __device__ __forceinline__ void operator()(const f32x4 (&acc)[2][2][4][2], const Unit& u, int wr, int wc, int fr, int fq) const {
        const int bidx = batch_of_tile(u.pn);
        const int tok0 = u.pn * BM + wc * 32 + 8 * fq;
        float rr[2][8];
        { const PG8_LAS float* rtab = (const PG8_LAS float*)(lds_base + RSTAB_OFF) + u.ord * 256 + wc * 32 + 8 * fq;
#pragma unroll
          for (int bj = 0; bj < 2; ++bj) { const f32x4 a = *(const PG8_LAS f32x4*)(rtab + bj * HALF), b2 = *(const PG8_LAS f32x4*)(rtab + bj * HALF + 4);
              rr[bj][0] = a[0]; rr[bj][1] = a[1]; rr[bj][2] = a[2]; rr[bj][3] = a[3]; rr[bj][4] = b2[0]; rr[bj][5] = b2[1]; rr[bj][6] = b2[2]; rr[bj][7] = b2[3]; } }
        float bb[2][4];
#pragma unroll
        for (int ai = 0; ai < 2; ++ai)
#pragma unroll
            for (int m = 0; m < 4; ++m) bb[ai][m] = bias[(size_t)bidx * NV + u.pm * BM + ai * HALF + wr * 64 + m * 16 + fr];
#pragma unroll
        for (int ai = 0; ai < 2; ++ai)
#pragma unroll
            for (int m = 0; m < 4; ++m) {
                const int nrow = u.pm * BM + ai * HALF + wr * 64 + m * 16 + fr;
                const float b = bb[ai][m];
                bf16_t* rowp = O + (size_t)nrow * ldc + tok0;
#pragma unroll
                for (int bj = 0; bj < 2; ++bj) {
                    const f32x4 a0 = acc[ai][bj][m][0], a1 = acc[ai][bj][m][1];
                    u32x4 w;
                    w.x = pk_bf16(a0[0] * rr[bj][0] + b, a0[1] * rr[bj][1] + b); w.y = pk_bf16(a0[2] * rr[bj][2] + b, a0[3] * rr[bj][3] + b);
                    w.z = pk_bf16(a1[0] * rr[bj][4] + b, a1[1] * rr[bj][5] + b); w.w = pk_bf16(a1[2] * rr[bj][6] + b, a1[3] * rr[bj][7] + b);
                    *(u32x4*)(rowp + bj * HALF) = w;
                }
            }
    }
};

struct EpiUp {
    static constexpr bool PERM = true, AFTER_DRAIN = false;
    bf16_t* O; const float* ss; const float* bias; PG8_LAS unsigned char* lds_base;
    __device__ __forceinline__ void operator()(const f32x4 (&acc)[2][2][4][2], const Unit& u, int wr, int wc, int fr, int fq) const {
        const int bidx = batch_of_tile(u.pm);
        const int colb = u.pn * BM + wc * 32 + 8 * fq;
        f32x4 bv[2][2];
#pragma unroll
        for (int bj = 0; bj < 2; ++bj)
#pragma unroll
            for (int n = 0; n < 2; ++n) bv[bj][n] = *(const f32x4*)(bias + (size_t)bidx * DFF + colb + bj * HALF + 4 * n);
        const PG8_LAS float* rtab = (const PG8_LAS float*)(lds_base + RSTAB_OFF) + u.ord * 256 + wr * 64 + fr;
#pragma unroll
        for (int ai = 0; ai < 2; ++ai)
#pragma unroll
            for (int m = 0; m < 4; ++m) {
                const int row = u.pm * BM + ai * HALF + wr * 64 + m * 16 + fr;
                const float rs = rtab[ai * HALF + m * 16];
                bf16_t* rowp = O + (size_t)row * DFF + colb;
#pragma unroll
                for (int bj = 0; bj < 2; ++bj) {
                    f32x4 v0 = acc[ai][bj][m][0] * rs + bv[bj][0], v1 = acc[ai][bj][m][1] * rs + bv[bj][1];
#pragma unroll
                    for (int e = 0; e < 4; ++e) { const float a = fmaxf(v0[e], 0.f), b = fmaxf(v1[e], 0.f); v0[e] = a * a; v1[e] = b * b; }
                    u32x4 w; w.x = pk_bf16(v0[0], v0[1]); w.y = pk_bf16(v0[2], v0[3]); w.z = pk_bf16(v1[0], v1[1]); w.w = pk_bf16(v1[2], v1[3]);
                    *(u32x4*)(rowp + bj * HALF) = w;
                }
            }
    }
};

__device__ __forceinline__ f32x4 ld_bf4(const bf16_t* p) { const u32x2 w = *(const u32x2*)p; f32x4 v; v[0] = __uint_as_float(w.x << 16); v[1] = __uint_as_float(w.x & 0xffff0000u); v[2] = __uint_as_float(w.y << 16); v[3] = __uint_as_float(w.y & 0xffff0000u); return v; }
template <bool HIN_BF, bool HOUT_BF>
struct EpiResT {
    static constexpr bool PERM = false, AFTER_DRAIN = false;
    const void* hin_lat; const void* hin_ctx; void* hout; bf16_t* xg; float* ss;
    const float* gate; const float* scl; const float* ng;
    __device__ __forceinline__ void operator()(const f32x4 (&acc)[2][2][4][2], const Unit& u, int wr, int wc, int fr, int fq) const {
        const int bidx = batch_of_tile(u.pm);
        const int colb = u.pn * BM + wc * 32 + 4 * fq;
        f32x4 gv[2][2], gp[2][2];
#pragma unroll
        for (int bj = 0; bj < 2; ++bj)
#pragma unroll
            for (int n = 0; n < 2; ++n) {
                const int c = colb + bj * HALF + n * 16;
                gv[bj][n] = *(const f32x4*)(gate + (size_t)bidx * 6144 + c);
                if (xg) { const f32x4 s = *(const f32x4*)(scl + (size_t)bidx * 6144 + c); const f32x4 g = *(const f32x4*)(ng + c); gp[bj][n] = g * (s + 1.0f); }
                else gp[bj][n] = (f32x4){0.f, 0.f, 0.f, 0.f};
            }
#pragma unroll
        for (int ab = 0; ab < 4; ++ab) { const int ai = ab >> 1;
            f32x4 hv[4][2][2];
#pragma unroll
            for (int m = 2 * (ab & 1); m < 2 * (ab & 1) + 2; ++m) {
                const int row = u.pm * BM + ai * HALF + wr * 64 + m * 16 + fr;
                const size_t hoff = (row < MLAT ? (size_t)row : (size_t)(row - MLAT)) * DM + colb;
                const void* hb = row < MLAT ? hin_lat : hin_ctx;
#pragma unroll
                for (int bj = 0; bj < 2; ++bj)
#pragma unroll
                    for (int n = 0; n < 2; ++n) { const int co = bj * HALF + n * 16;
                        if (HIN_BF) hv[m][bj][n] = ld_bf4((const bf16_t*)hb + hoff + co); else hv[m][bj][n] = *(const f32x4*)((const float*)hb + hoff + co); }
            }
#pragma unroll
            for (int m = 2 * (ab & 1); m < 2 * (ab & 1) + 2; ++m) {
                const int row = u.pm * BM + ai * HALF + wr * 64 + m * 16 + fr;
                float ssum = 0.f;
#pragma unroll
                for (int bj = 0; bj < 2; ++bj)
#pragma unroll
                    for (int n = 0; n < 2; ++n) {
                        const int co = bj * HALF + n * 16;
                        const f32x4 v = hv[m][bj][n] + gv[bj][n] * acc[ai][bj][m][n];
                        if (HOUT_BF) { u32x2 w; w.x = pk_bf16(v[0], v[1]); w.y = pk_bf16(v[2], v[3]); *(u32x2*)((bf16_t*)hout + (size_t)row * DM + colb + co) = w; }
                        else *(f32x4*)((float*)hout + (size_t)row * DM + colb + co) = v;
                        ssum += (v[0] * v[0] + v[1] * v[1]) + (v[2] * v[2] + v[3] * v[3]);
                        if (xg) { const f32x4 y = v * gp[bj][n]; u32x2 w; w.x = pk_bf16(y[0], y[1]); w.y = pk_bf16(y[2], y[3]); *(u32x2*)(xg + (size_t)row * DM + colb + co) = w; }
                    }
                ssum += __shfl_xor(ssum, 16); ssum += __shfl_xor(ssum, 32);
                if (fq == 0) ss[(size_t)row * 16 + u.pn * 4 + wc] = ssum;
            }
        }
    }
};
typedef EpiResT<false, false> EpiRes;

struct EpiFinal {
    static constexpr bool PERM = false, AFTER_DRAIN = false;
    const float* hin; float* out; float* ss; const float* gate; const float* fg; unsigned* cnt;
    __device__ __forceinline__ void operator()(f32x4 (&acc)[2][2][4][2], const Unit& u, int wr, int wc, int fr, int fq) const {
        const int bidx = batch_of_tile(u.pm);
        const int colb = u.pn * BM + wc * 32 + 4 * fq;
        f32x4 gv[2][2];
#pragma unroll
        for (int bj = 0; bj < 2; ++bj)
#pragma unroll
            for (int n = 0; n < 2; ++n) gv[bj][n] = *(const f32x4*)(gate + (size_t)bidx * 6144 + colb + bj * HALF + n * 16);
#pragma unroll
        for (int ai = 0; ai < 2; ++ai)
#pragma unroll
            for (int m = 0; m < 4; ++m) {
                const int row = u.pm * BM + ai * HALF + wr * 64 + m * 16 + fr;
                const float* hp = hin + (size_t)row * DM + colb;
                float ssum = 0.f;
#pragma unroll
                for (int bj = 0; bj < 2; ++bj)
#pragma unroll
                    for (int n = 0; n < 2; ++n) {
                        const f32x4 v = *(const f32x4*)(hp + bj * HALF + n * 16) + gv[bj][n] * acc[ai][bj][m][n];
                        acc[ai][bj][m][n] = v;
                        ssum += (v[0] * v[0] + v[1] * v[1]) + (v[2] * v[2] + v[3] * v[3]);
                    }
                ssum += __shfl_xor(ssum, 16); ssum += __shfl_xor(ssum, 32);
                if (fq == 0) __hip_atomic_store(ss + (size_t)row * 16 + u.pn * 4 + wc, ssum, __ATOMIC_RELAXED, __HIP_MEMORY_SCOPE_AGENT);
            }
        asm volatile("s_waitcnt vmcnt(0)" ::: "memory");
        unsigned* cw = cnt + 64 * u.pm;
        if ((threadIdx.x & 63) == 0) __hip_atomic_fetch_add(cw, 1u, __ATOMIC_RELAXED, __HIP_MEMORY_SCOPE_AGENT);
        { const unsigned long long t0 = __builtin_amdgcn_s_memrealtime();
          while ((unsigned)__builtin_amdgcn_readfirstlane(__hip_atomic_load(cw, __ATOMIC_RELAXED, __HIP_MEMORY_SCOPE_AGENT)) < 32u) {
              if (__builtin_amdgcn_s_memrealtime() - t0 > 1000000ull) break;
              __builtin_amdgcn_s_sleep(2); } }
        __builtin_amdgcn_fence(__ATOMIC_ACQUIRE, "agent");
        asm volatile("s_waitcnt vmcnt(0)" ::: "memory");
        f32x4 fv[2][2];
#pragma unroll
        for (int bj = 0; bj < 2; ++bj)
#pragma unroll
            for (int n = 0; n < 2; ++n) fv[bj][n] = *(const f32x4*)(fg + colb + bj * HALF + n * 16);
#pragma unroll
        for (int ai = 0; ai < 2; ++ai)
#pragma unroll
            for (int m = 0; m < 4; ++m) {
                const int row = u.pm * BM + ai * HALF + wr * 64 + m * 16 + fr;
                const float rs = row_rstd(ss, row);
                float* op = out + (size_t)row * DM + colb;
#pragma unroll
                for (int bj = 0; bj < 2; ++bj)
#pragma unroll
                    for (int n = 0; n < 2; ++n) *(f32x4*)(op + bj * HALF + n * 16) = acc[ai][bj][m][n] * rs * fv[bj][n];
            }
    }
};

struct SplitCtxOrder {
    int c, nts;
    __host__ __device__ void init(int c_, int K_) { c = c_; nts = K_ / BK / 8; }
    __host__ __device__ bool next(int i, Unit& u) const {
        if (i != 0) return false;
        const int ti = c >> 3, ks = c & 7;
        u.pm = 128 + (ti >> 2); u.pn = ti & 3; u.nt = nts; u.koff = ks * nts * BK; u.ord = 0; return true;
    }
    __device__ __forceinline__ void a_ready(const Unit&) const {}
    __device__ __forceinline__ void done(const Unit&) const {}
};
struct EpiSlab {
    static constexpr bool PERM = false, AFTER_DRAIN = false;
    float* slab_lo; float* slab_hi;
    __device__ __forceinline__ void operator()(const f32x4 (&acc)[2][2][4][2], const Unit& u, int wr, int wc, int fr, int fq) const {
        const int ks = u.koff / (u.nt * BK);
        float* sl = (ks < 6 ? slab_lo + (size_t)ks * MCTX * DM : slab_hi + (size_t)(ks - 6) * MCTX * DM);
        const int colb = u.pn * BM + wc * 32 + 4 * fq;
#pragma unroll
        for (int ai = 0; ai < 2; ++ai)
#pragma unroll
            for (int m = 0; m < 4; ++m) {
                const int row = (u.pm - 128) * BM + ai * HALF + wr * 64 + m * 16 + fr;
                float* op = sl + (size_t)row * DM + colb;
#pragma unroll
                for (int bj = 0; bj < 2; ++bj)
#pragma unroll
                    for (int n = 0; n < 2; ++n) *(f32x4*)(op + bj * HALF + n * 16) = acc[ai][bj][m][n];
            }
    }
};

template <class Epi, class Sched, bool ALIGN_EPI = false, bool SP2 = false>
__device__ __forceinline__ void gemm_phase(PG8_LAS unsigned char* lds, const Gemm g, const Sched& S, const Epi& E) {
    const int tid = threadIdx.x, wid = __builtin_amdgcn_readfirstlane(tid >> 6), lane = tid & 63, wr = wid >> 2, wc = wid & 3, fr = lane & 15, fq = lane >> 4;
    const int K = g.K;
    unsigned voffA[2], voffB[2];
#pragma unroll
    for (int i = 0; i < 2; ++i) { int R, C; stage_rc(tid * 16 + i * 8192, R, C); const int Rb = Epi::PERM ? ((R & ~31) + perm32(R & 31)) : R;
        voffA[i] = (unsigned)(R * K + C) * 2u; voffB[i] = (unsigned)(Rb * K + C) * 2u; }
    const size_t kstep = (size_t)(BK * 2);
    const size_t hstep = (size_t)HALF * K * 2;
    const size_t tstep = 2 * hstep;
    const unsigned ldsw = (unsigned)wid * 1024u;
    const int aoff = lds_byte(wr * 64 + fr, fq * 8), boff = lds_byte(wc * 32 + fr, fq * 8);
#define PG8_SA(b, h) (((b) * 2 + (h)) * HTB)
#define PG8_SB(b, h) ((4 + (b) * 2 + (h)) * HTB)
#define PG8_STAGE(bufoff, gbase, voff) do { _Pragma("unroll") for (int _i = 0; _i < 2; ++_i) \
        __builtin_amdgcn_global_load_lds((const unsigned*)((const char*)(gbase) + (voff)[_i]), (PG8_LAS unsigned*)(lds + (bufoff) + ldsw + _i * 8192), 16, 0, 0); } while (0)
#define PG8_LDA(dst, b, h) do { _Pragma("unroll") for (int m = 0; m < 4; ++m) _Pragma("unroll") for (int k = 0; k < 2; ++k) dst[m][k] = *(const PG8_LAS bf16x8*)(lds + PG8_SA(b, h) + aoff + m * 2048 + k * 1024); } while (0)
#define PG8_LDB(dst, b, h) do { _Pragma("unroll") for (int n = 0; n < 2; ++n) _Pragma("unroll") for (int k = 0; k < 2; ++k) dst[n][k] = *(const PG8_LAS bf16x8*)(lds + PG8_SB(b, h) + boff + n * 2048 + k * 1024); } while (0)
#define PG8_MMA(ai, bj, At, Bt) do { __builtin_amdgcn_s_setprio(1); _Pragma("unroll") for (int m = 0; m < 4; ++m) _Pragma("unroll") for (int n = 0; n < 2; ++n) _Pragma("unroll") for (int k = 0; k < 2; ++k) \
        acc[ai][bj][m][n] = __builtin_amdgcn_mfma_f32_16x16x32_bf16(Bt[n][k], At[m][k], acc[ai][bj][m][n], 0, 0, 0); __builtin_amdgcn_s_setprio(0); } while (0)
#define PG8_WAIT_V(n) asm volatile("s_waitcnt vmcnt(" #n ")" ::: "memory")
#define PG8_WAIT_L(n) asm volatile("s_waitcnt lgkmcnt(" #n ")" ::: "memory")
#define PG8_BAR __builtin_amdgcn_s_barrier()
#define PG8_SCHED __builtin_amdgcn_sched_barrier(0)
    Unit cur, nxt; int ui = 0;
    if (!S.next(0, cur)) return;
    f32x4 acc[2][2][4][2];
#pragma unroll
    for (int a = 0; a < 2; ++a)
#pragma unroll
        for (int b = 0; b < 2; ++b)
#pragma unroll
            for (int m = 0; m < 4; ++m)
#pragma unroll
                for (int n = 0; n < 2; ++n) acc[a][b][m][n] = (f32x4){0.f, 0.f, 0.f, 0.f};
    bf16x8 At[4][2], B0[2][2], B1[2][2];
    const char* cA = (const char*)g.A + (size_t)cur.pm * tstep + (size_t)cur.koff * 2; const char* cB = (const char*)g.Bt + (size_t)cur.pn * tstep + (size_t)cur.koff * 2;
    S.a_ready(cur);
    if constexpr (SP2) {
        PG8_STAGE(PG8_SB(0, 0), cB, voffB); PG8_STAGE(PG8_SB(0, 1), cB + hstep, voffB); PG8_STAGE(PG8_SA(0, 0), cA, voffA); PG8_STAGE(PG8_SA(0, 1), cA + hstep, voffA);
        if (wr == 1) PG8_BAR;
        PG8_WAIT_V(2); PG8_BAR;
        PG8_STAGE(PG8_SB(1, 0), cB + kstep, voffB); PG8_STAGE(PG8_SA(1, 0), cA + kstep, voffA); PG8_STAGE(PG8_SB(1, 1), cB + hstep + kstep, voffB);
        PG8_WAIT_V(6); PG8_BAR;
    } else {
        PG8_STAGE(PG8_SB(0, 0), cB, voffB); PG8_STAGE(PG8_SA(0, 0), cA, voffA); PG8_STAGE(PG8_SB(0, 1), cB + hstep, voffB); PG8_STAGE(PG8_SA(0, 1), cA + hstep, voffA);
        if (wr == 1) PG8_BAR;
        PG8_WAIT_V(4); PG8_BAR;
        PG8_STAGE(PG8_SB(1, 0), cB + kstep, voffB); PG8_STAGE(PG8_SA(1, 0), cA + kstep, voffA); PG8_STAGE(PG8_SB(1, 1), cB + hstep + kstep, voffB);
        PG8_WAIT_V(6); PG8_BAR;
    }
    for (;;) {
        const bool has_next = S.next(ui + 1, nxt);
        const char* nA = has_next ? (const char*)g.A + (size_t)nxt.pm * tstep + (size_t)nxt.koff * 2 : cA; const char* nB = has_next ? (const char*)g.Bt + (size_t)nxt.pn * tstep + (size_t)nxt.koff * 2 : cB;
        const int nt = cur.nt;
        for (int t = 0; t < nt; t += 2) {
            const bool last = (t == nt - 2);
            const char* a1 = cA + (size_t)(t + 1) * kstep;
            const char* a2 = last ? nA : cA + (size_t)(t + 2) * kstep; const char* b2 = last ? nB : cB + (size_t)(t + 2) * kstep;
            const char* a3 = a2 + kstep; const char* b3 = b2 + kstep;
            if (last && has_next) S.a_ready(nxt);
            if constexpr (SP2) {
            PG8_LDB(B0, 0, 0); PG8_LDB(B1, 0, 1); PG8_SCHED; PG8_LDA(At, 0, 0); PG8_STAGE(PG8_SA(1, 1), a1 + hstep, voffA);
            PG8_WAIT_V(8); PG8_WAIT_L(0); PG8_BAR; PG8_MMA(0, 0, At, B0); PG8_MMA(0, 1, At, B1); PG8_BAR; PG8_SCHED;
            PG8_LDA(At, 0, 1); PG8_STAGE(PG8_SB(0, 0), b2, voffB); PG8_STAGE(PG8_SB(0, 1), b2 + hstep, voffB); PG8_STAGE(PG8_SA(0, 0), a2, voffA);
            PG8_WAIT_V(8); PG8_WAIT_L(0); PG8_BAR; PG8_MMA(1, 0, At, B0); PG8_MMA(1, 1, At, B1); PG8_BAR; PG8_SCHED;
            PG8_LDB(B0, 1, 0); PG8_LDB(B1, 1, 1); PG8_SCHED; PG8_LDA(At, 1, 0); PG8_STAGE(PG8_SA(0, 1), a2 + hstep, voffA);
            PG8_WAIT_V(8); PG8_WAIT_L(0); PG8_BAR; PG8_MMA(0, 0, At, B0); PG8_MMA(0, 1, At, B1); PG8_BAR; PG8_SCHED;
            PG8_LDA(At, 1, 1); PG8_STAGE(PG8_SB(1, 0), b3, voffB); PG8_STAGE(PG8_SB(1, 1), b3 + hstep, voffB); PG8_STAGE(PG8_SA(1, 0), a3, voffA);
            PG8_WAIT_V(8); PG8_WAIT_L(0); PG8_BAR; PG8_MMA(1, 0, At, B0); PG8_MMA(1, 1, At, B1); PG8_BAR; PG8_SCHED;
            } else {
            PG8_LDB(B0, 0, 0); PG8_SCHED; PG8_LDA(At, 0, 0); PG8_STAGE(PG8_SA(1, 1), a1 + hstep, voffA);
            PG8_WAIT_L(8); PG8_BAR; PG8_WAIT_L(0); PG8_MMA(0, 0, At, B0); PG8_BAR; PG8_SCHED;
            PG8_LDB(B1, 0, 1); PG8_STAGE(PG8_SB(0, 0), b2, voffB);
            PG8_BAR; PG8_WAIT_L(0); PG8_MMA(0, 1, At, B1); PG8_BAR;
            PG8_LDA(At, 0, 1); PG8_STAGE(PG8_SA(0, 0), a2, voffA);
            PG8_BAR; PG8_WAIT_L(0); PG8_MMA(1, 0, At, B0); PG8_BAR; PG8_SCHED;
            PG8_STAGE(PG8_SB(0, 1), b2 + hstep, voffB);
            PG8_WAIT_V(6); PG8_BAR; PG8_MMA(1, 1, At, B1); PG8_BAR;
            PG8_LDB(B0, 1, 0); PG8_SCHED; PG8_LDA(At, 1, 0); PG8_STAGE(PG8_SA(0, 1), a2 + hstep, voffA);
            PG8_WAIT_L(8); PG8_BAR; PG8_WAIT_L(0); PG8_MMA(0, 0, At, B0); PG8_BAR; PG8_SCHED;
            PG8_LDB(B1, 1, 1); PG8_STAGE(PG8_SB(1, 0), b3, voffB);
            PG8_BAR; PG8_WAIT_L(0); PG8_MMA(0, 1, At, B1); PG8_BAR;
            PG8_LDA(At, 1, 1); PG8_STAGE(PG8_SA(1, 0), a3, voffA);
            PG8_BAR; PG8_WAIT_L(0); PG8_MMA(1, 0, At, B0); PG8_BAR; PG8_SCHED;
            PG8_STAGE(PG8_SB(1, 1), b3 + hstep, voffB);
            PG8_WAIT_V(6); PG8_BAR; PG8_MMA(1, 1, At, B1); PG8_BAR;
            }
        }
        if constexpr (ALIGN_EPI) { if (wr == 0) PG8_BAR; }
        if constexpr (!Epi::AFTER_DRAIN) { E(acc, cur, wr, wc, fr, fq); S.done(cur); }
        if (!has_next) break;
#pragma unroll
        for (int a = 0; a < 2; ++a)
#pragma unroll
            for (int b = 0; b < 2; ++b)
#pragma unroll
                for (int m = 0; m < 4; ++m)
#pragma unroll
                    for (int n = 0; n < 2; ++n) acc[a][b][m][n] = (f32x4){0.f, 0.f, 0.f, 0.f};
        cur = nxt; cA = nA; cB = nB; ++ui;
        if constexpr (ALIGN_EPI) { if (wr == 1) PG8_BAR; }
    }
    PG8_WAIT_V(0);
    if constexpr (!ALIGN_EPI) { if (wr == 0) PG8_BAR; }
    PG8_BAR;
    if constexpr (Epi::AFTER_DRAIN) { E.fused(acc, cur, wr, wc, fr, fq, lds, wid, lane); S.done(cur); }
#undef PG8_SA
#undef PG8_SB
#undef PG8_STAGE
#undef PG8_LDA
#undef PG8_LDB
#undef PG8_MMA
#undef PG8_WAIT_V
#undef PG8_WAIT_L
#undef PG8_BAR
#undef PG8_SCHED
}
}

namespace att {
#define MFMA32(a, b, c) __builtin_amdgcn_mfma_f32_32x32x16_bf16((a), (b), (c), 0, 0, 0)
__device__ __forceinline__ int koff(int r, int h) { return 16 * (r >> 3) + 8 * h + (r & 7); }
__device__ __forceinline__ int crow(int r, int h) { return (r & 3) + 8 * (r >> 2) + 4 * h; }
__device__ __forceinline__ float ex2(float x) { return __builtin_amdgcn_exp2f(x); }
__device__ __forceinline__ float wave_sum(float v) {
#pragma unroll
    for (int o = 1; o < 64; o <<= 1) v += __shfl_xor(v, o);
    return v;
}

__device__ __forceinline__ void qk_tile(f32x16 (&s)[2], const LAS unsigned char* Kt, const bf16x8 (&qf)[4], int pi, int h) {
    const int sw = (pi >> 1) & 7;
#pragma unroll
    for (int kb = 0; kb < 2; ++kb) {
        f32x16 a = {};
#pragma unroll
        for (int d0 = 0; d0 < 4; ++d0) {
            const bf16x8 kf = *(const LAS bf16x8*)(Kt + (32 * kb + pi) * 128 + (((2 * d0 + h) ^ sw) << 4));
            a = MFMA32(kf, qf[d0], a);
        }
        s[kb] = a;
    }
}
template <int DVB>
__device__ __forceinline__ void softmax_pv(f32x16 (&s)[2], const LAS unsigned char* VTt, f32x16 (&oT)[DVB], float& m_run, float& l_run, int i31, int h) {
    float mx = s[0][0];
#pragma unroll
    for (int r = 1; r < 16; ++r) mx = fmaxf(mx, s[0][r]);
#pragma unroll
    for (int r = 0; r < 16; ++r) mx = fmaxf(mx, s[1][r]);
    mx = fmaxf(mx, __shfl_xor(mx, 32));
    if (__any(mx > m_run)) {
        const float mn = fmaxf(m_run, mx); const float alpha = ex2(m_run - mn); m_run = mn; l_run *= alpha;
#pragma unroll
        for (int db = 0; db < DVB; ++db)
#pragma unroll
            for (int r = 0; r < 16; ++r) oT[db][r] *= alpha;
    }
    float ps = 0.f;
#pragma unroll
    for (int kb = 0; kb < 2; ++kb)
#pragma unroll
        for (int r = 0; r < 16; ++r) { const float p = ex2(s[kb][r] - m_run); s[kb][r] = p; ps += p; }
    l_run += ps;
    const int sw = (i31 >> 1) & 7;
#pragma unroll
    for (int kb = 0; kb < 2; ++kb)
#pragma unroll
        for (int st = 0; st < 2; ++st) {
            u32x4 pw;
            pw.x = pk_bf16(s[kb][8 * st + 0], s[kb][8 * st + 1]); pw.y = pk_bf16(s[kb][8 * st + 2], s[kb][8 * st + 3]);
            pw.z = pk_bf16(s[kb][8 * st + 4], s[kb][8 * st + 5]); pw.w = pk_bf16(s[kb][8 * st + 6], s[kb][8 * st + 7]);
            const bf16x8 pb = __builtin_bit_cast(bf16x8, pw);
#pragma unroll
            for (int db = 0; db < DVB; ++db) {
                const bf16x8 vf = *(const LAS bf16x8*)(VTt + (32 * db + i31) * 128 + (((4 * kb + 2 * st + h) ^ sw) << 4));
                oT[db] = MFMA32(vf, pb, oT[db]);
            }
        }
}


#ifndef THR2V
#define THR2V 6.0f
#endif
constexpr float THR2 = THR2V;
__device__ __forceinline__ void qk_tile2(f32x16 (&s)[2], const LAS unsigned char* Kt, const bf16x8 (&qf)[4], const f32x16& negm, int pi, int h) {
    const int sw = (pi >> 1) & 7;
#pragma unroll
    for (int kb = 0; kb < 2; ++kb) {
        f32x16 a = negm;
#pragma unroll
        for (int d0 = 0; d0 < 4; ++d0) {
            const bf16x8 kf = *(const LAS bf16x8*)(Kt + (32 * kb + pi) * 128 + (((2 * d0 + h) ^ sw) << 4));
            a = MFMA32(kf, qf[d0], a);
        }
        s[kb] = a;
    }
}
template <int DVB>
__device__ __forceinline__ void softmax_pv2(f32x16 (&s)[2], const LAS unsigned char* VTt, f32x16 (&oT)[DVB], f32x16& negm, float& m_run, float& l_run, bool first, int i31, int h) {
    float mx = fmaxf(fmaxf(s[0][0], s[0][1]), s[0][2]);
#pragma unroll
    for (int r = 3; r < 15; r += 2) mx = fmaxf(fmaxf(mx, s[0][r]), s[0][r + 1]);
    mx = fmaxf(mx, s[0][15]);
#pragma unroll
    for (int r = 0; r < 16; r += 2) mx = fmaxf(fmaxf(mx, s[1][r]), s[1][r + 1]);
    if (first || __any(mx > THR2)) {
        mx = fmaxf(mx, __shfl_xor(mx, 32));
        float delta = first ? mx : fmaxf(mx, 0.f);
        if (delta == -INFINITY) delta = 0.f;
        const float alpha = first ? 1.0f : ex2(-delta);
        m_run += delta; l_run *= alpha;
#pragma unroll
        for (int db = 0; db < DVB; ++db)
#pragma unroll
            for (int r = 0; r < 16; ++r) oT[db][r] *= alpha;
#pragma unroll
        for (int kb = 0; kb < 2; ++kb)
#pragma unroll
            for (int r = 0; r < 16; ++r) s[kb][r] -= delta;
        const float nm = -m_run;
#pragma unroll
        for (int r = 0; r < 16; ++r) negm[r] = nm;
    }
    float ps = 0.f;
#pragma unroll
    for (int kb = 0; kb < 2; ++kb)
#pragma unroll
        for (int r = 0; r < 16; ++r) { const float p = ex2(s[kb][r]); s[kb][r] = p; ps += p; }
    l_run += ps;
    const int sw = (i31 >> 1) & 7;
#pragma unroll
    for (int kb = 0; kb < 2; ++kb)
#pragma unroll
        for (int st = 0; st < 2; ++st) {
            u32x4 pw;
            pw.x = pk_bf16(s[kb][8 * st + 0], s[kb][8 * st + 1]); pw.y = pk_bf16(s[kb][8 * st + 2], s[kb][8 * st + 3]);
            pw.z = pk_bf16(s[kb][8 * st + 4], s[kb][8 * st + 5]); pw.w = pk_bf16(s[kb][8 * st + 6], s[kb][8 * st + 7]);
            const bf16x8 pb = __builtin_bit_cast(bf16x8, pw);
#pragma unroll
            for (int db = 0; db < DVB; ++db) {
                const bf16x8 vf = *(const LAS bf16x8*)(VTt + (32 * db + i31) * 128 + (((4 * kb + 2 * st + h) ^ sw) << 4));
                oT[db] = MFMA32(vf, pb, oT[db]);
            }
        }
}


#define ATT_SB() do {} while (0)
#ifdef ATT_PRIO
#define ATT_P1() __builtin_amdgcn_s_setprio(1)
#define ATT_P0() __builtin_amdgcn_s_setprio(0)
#else
#define ATT_P1() do {} while (0)
#define ATT_P0() do {} while (0)
#endif
__device__ __forceinline__ bf16x8 exp_pack8(f32x16& sv, const int st, float& ps) {
    float p[8];
#pragma unroll
    for (int j = 0; j < 8; ++j) { p[j] = ex2(sv[8 * st + j]); }
    ps += ((p[0] + p[1]) + (p[2] + p[3])) + ((p[4] + p[5]) + (p[6] + p[7]));
    u32x4 pw; pw.x = pk_bf16(p[0], p[1]); pw.y = pk_bf16(p[2], p[3]); pw.z = pk_bf16(p[4], p[5]); pw.w = pk_bf16(p[6], p[7]);
    return __builtin_bit_cast(bf16x8, pw);
}
struct NoMask { __device__ __forceinline__ void operator()(f32x16&, f32x16&) const {} };
template <int DVB, class MF = NoMask>
__device__ __forceinline__ void tile_compute(const LAS unsigned char* Kt, const LAS unsigned char* VTt, const bf16x8 (&qf)[4], f32x16 (&oT)[DVB], f32x16& negm,
                                             float& m_run, float& l_run, bool first, int pi, int i31, int h, const MF mf = MF()) {
#ifdef IGLP_ID
    __builtin_amdgcn_iglp_opt(IGLP_ID);
#endif
    const int swk = (pi >> 1) & 7, swv = (i31 >> 1) & 7;
    bf16x8 kf[8];
#pragma unroll
    for (int kb = 0; kb < 2; ++kb)
#pragma unroll
        for (int d0 = 0; d0 < 4; ++d0) kf[kb * 4 + d0] = *(const LAS bf16x8*)(Kt + (32 * kb + pi) * 128 + (((2 * d0 + h) ^ swk) << 4));
    ATT_SB();
    f32x16 s0 = negm, s1 = negm;
    bf16x8 vf[4][DVB];
#pragma unroll
    for (int d0 = 0; d0 < 4; ++d0) { s0 = MFMA32(kf[d0], qf[d0], s0); s1 = MFMA32(kf[4 + d0], qf[d0], s1); }
#pragma unroll
    for (int j = 0; j < 2; ++j)
#pragma unroll
        for (int db = 0; db < DVB; ++db) vf[j][db] = *(const LAS bf16x8*)(VTt + (32 * db + i31) * 128 + (((2 * j + h) ^ swv) << 4));
    ATT_SB();
    mf(s0, s1);
    float mx = fmaxf(fmaxf(s0[0], s0[1]), s0[2]);
#pragma unroll
    for (int r = 3; r < 15; r += 2) mx = fmaxf(fmaxf(mx, s0[r]), s0[r + 1]);
    mx = fmaxf(mx, s0[15]);
#pragma unroll
    for (int r = 0; r < 16; r += 2) mx = fmaxf(fmaxf(mx, s1[r]), s1[r + 1]);
    if (first || __any(mx > THR2)) {
        mx = fmaxf(mx, __shfl_xor(mx, 32));
        float delta = first ? mx : fmaxf(mx, 0.f);
        if (delta == -INFINITY) delta = 0.f;
        const float alpha = first ? 1.0f : ex2(-delta);
        m_run += delta; l_run *= alpha;
#pragma unroll
        for (int db = 0; db < DVB; ++db)
#pragma unroll
            for (int r = 0; r < 16; ++r) oT[db][r] *= alpha;
#pragma unroll
        for (int r = 0; r < 16; ++r) { s0[r] -= delta; s1[r] -= delta; }
        const float nm = -m_run;
#pragma unroll
        for (int r = 0; r < 16; ++r) negm[r] = nm;
    }
    ATT_SB();
    float ps = 0.f;
    bf16x8 pb0 = exp_pack8(s0, 0, ps);
#pragma unroll
    for (int j = 2; j < 4; ++j)
#pragma unroll
        for (int db = 0; db < DVB; ++db) vf[j][db] = *(const LAS bf16x8*)(VTt + (32 * db + i31) * 128 + (((2 * j + h) ^ swv) << 4));
    ATT_SB();
#pragma unroll
    for (int db = 0; db < DVB; ++db) { ATT_P1(); oT[db] = MFMA32(vf[0][db], pb0, oT[db]); ATT_P0(); }
    bf16x8 pb1 = exp_pack8(s0, 1, ps);
    ATT_SB();
#pragma unroll
    for (int db = 0; db < DVB; ++db) { ATT_P1(); oT[db] = MFMA32(vf[1][db], pb1, oT[db]); ATT_P0(); }
    bf16x8 pb2 = exp_pack8(s1, 0, ps);
    ATT_SB();
#pragma unroll
    for (int db = 0; db < DVB; ++db) { ATT_P1(); oT[db] = MFMA32(vf[2][db], pb2, oT[db]); ATT_P0(); }
    bf16x8 pb3 = exp_pack8(s1, 1, ps);
    ATT_SB();
#pragma unroll
    for (int db = 0; db < DVB; ++db) { ATT_P1(); oT[db] = MFMA32(vf[3][db], pb3, oT[db]); ATT_P0(); }
    l_run += ps;
    ATT_SB();
}


template <int DVB>
__device__ __forceinline__ void tile_compute128(const LAS unsigned char* KtA, const LAS unsigned char* VTtA, const LAS unsigned char* KtB, const LAS unsigned char* VTtB, const bf16x8 (&qf)[4],
                                                f32x16 (&oT)[DVB], f32x16& negm, float& m_run, float& l_run, bool first, int pi, int i31, int h) {
    const int swk = (pi >> 1) & 7, swv = (i31 >> 1) & 7;
    f32x16 a0 = negm, a1 = negm, b0 = negm, b1 = negm;
    {
        bf16x8 kf[8];
#pragma unroll
        for (int kb = 0; kb < 2; ++kb)
#pragma unroll
            for (int d0 = 0; d0 < 4; ++d0) kf[kb * 4 + d0] = *(const LAS bf16x8*)(KtA + (32 * kb + pi) * 128 + (((2 * d0 + h) ^ swk) << 4));
#pragma unroll
        for (int d0 = 0; d0 < 4; ++d0) { a0 = MFMA32(kf[d0], qf[d0], a0); a1 = MFMA32(kf[4 + d0], qf[d0], a1); }
    }
    {
        bf16x8 kf[8];
#pragma unroll
        for (int kb = 0; kb < 2; ++kb)
#pragma unroll
            for (int d0 = 0; d0 < 4; ++d0) kf[kb * 4 + d0] = *(const LAS bf16x8*)(KtB + (32 * kb + pi) * 128 + (((2 * d0 + h) ^ swk) << 4));
#pragma unroll
        for (int d0 = 0; d0 < 4; ++d0) { b0 = MFMA32(kf[d0], qf[d0], b0); b1 = MFMA32(kf[4 + d0], qf[d0], b1); }
    }
    float mx = fmaxf(fmaxf(a0[0], a0[1]), a0[2]), my = fmaxf(fmaxf(b0[0], b0[1]), b0[2]);
#pragma unroll
    for (int r = 3; r < 15; r += 2) { mx = fmaxf(fmaxf(mx, a0[r]), a0[r + 1]); my = fmaxf(fmaxf(my, b0[r]), b0[r + 1]); }
    mx = fmaxf(mx, a0[15]); my = fmaxf(my, b0[15]);
#pragma unroll
    for (int r = 0; r < 16; r += 2) { mx = fmaxf(fmaxf(mx, a1[r]), a1[r + 1]); my = fmaxf(fmaxf(my, b1[r]), b1[r + 1]); }
    mx = fmaxf(mx, my);
    if (first || __any(mx > THR2)) {
        mx = fmaxf(mx, __shfl_xor(mx, 32));
        float delta = first ? mx : fmaxf(mx, 0.f);
        if (delta == -INFINITY) delta = 0.f;
        const float alpha = first ? 1.0f : ex2(-delta);
        m_run += delta; l_run *= alpha;
#pragma unroll
        for (int db = 0; db < DVB; ++db)
#pragma unroll
            for (int r = 0; r < 16; ++r) oT[db][r] *= alpha;
#pragma unroll
        for (int r = 0; r < 16; ++r) { a0[r] -= delta; a1[r] -= delta; b0[r] -= delta; b1[r] -= delta; }
        const float nm = -m_run;
#pragma unroll
        for (int r = 0; r < 16; ++r) negm[r] = nm;
    }
    float ps = 0.f;
    {
#pragma unroll
        for (int jp = 0; jp < 2; ++jp) {
            bf16x8 vf[2][DVB];
#pragma unroll
            for (int j = 0; j < 2; ++j)
#pragma unroll
                for (int db = 0; db < DVB; ++db) vf[j][db] = *(const LAS bf16x8*)(VTtA + (32 * db + i31) * 128 + (((2 * (2 * jp + j) + h) ^ swv) << 4));
            const bf16x8 p0 = exp_pack8(jp == 0 ? a0 : a1, 0, ps), p1 = exp_pack8(jp == 0 ? a0 : a1, 1, ps);
#pragma unroll
            for (int db = 0; db < DVB; ++db) oT[db] = MFMA32(vf[0][db], p0, oT[db]);
#pragma unroll
            for (int db = 0; db < DVB; ++db) oT[db] = MFMA32(vf[1][db], p1, oT[db]);
        }
    }
    {
#pragma unroll
        for (int jp = 0; jp < 2; ++jp) {
            bf16x8 vf[2][DVB];
#pragma unroll
            for (int j = 0; j < 2; ++j)
#pragma unroll
                for (int db = 0; db < DVB; ++db) vf[j][db] = *(const LAS bf16x8*)(VTtB + (32 * db + i31) * 128 + (((2 * (2 * jp + j) + h) ^ swv) << 4));
            const bf16x8 p0 = exp_pack8(jp == 0 ? b0 : b1, 0, ps), p1 = exp_pack8(jp == 0 ? b0 : b1, 1, ps);
#pragma unroll
            for (int db = 0; db < DVB; ++db) oT[db] = MFMA32(vf[0][db], p0, oT[db]);
#pragma unroll
            for (int db = 0; db < DVB; ++db) oT[db] = MFMA32(vf[1][db], p1, oT[db]);
        }
    }
    l_run += ps;
}

constexpr int L0_UNITS = 2176;
constexpr int L0_BUF = 16384;
constexpr int L0_RPB_OFF = 98304;
struct L0Args { const bf16_t* QK; const bf16_t* VT; bf16_t* Y; const float* sink; const float* rpb; };
#define L0_WAIT_BAR(N) asm volatile("s_waitcnt vmcnt(" #N ") lgkmcnt(0)\n\ts_barrier" ::: "memory")
struct L0Mask {
    int mode; const LAS float* tab; int vb; int dq;
    __device__ __forceinline__ void operator()(f32x16& s0, f32x16& s1) const {
        if (mode == 1) {
#pragma unroll
            for (int r = 0; r < 16; ++r) {
                const int kc0 = 16 * (r >> 3) + (r & 7), kc1 = 32 + kc0;
                const float b0 = tab[kc0], b1 = tab[kc1];
                s0[r] = ((unsigned)(kc0 + vb) < 16u) ? s0[r] + b0 : -INFINITY;
                s1[r] = ((unsigned)(kc1 + vb) < 16u) ? s1[r] + b1 : -INFINITY;
            }
        } else if (mode == 2) {
#pragma unroll
            for (int r = 0; r < 16; ++r) {
                const int kc0 = 16 * (r >> 3) + (r & 7), kc1 = 32 + kc0;
                const int d0 = dq - kc0, d1 = dq - kc1;
                if (d0 > 128 || d0 < -128) s0[r] = -INFINITY;
                if (d1 > 128 || d1 < -128) s1[r] = -INFINITY;
            }
        }
    }
};

struct L0Unit { int mode, b, qx, isB, lat0, nlat, nt, qtok0, hq, qcol, kcol, vrow; };
__device__ __forceinline__ L0Unit l0_decode(int u, int g) {
    L0Unit d; int kvh;
    if (u < 1024) { d.mode = 0; d.b = u >> 7; kvh = (u >> 6) & 1; d.qx = u & 63; d.isB = 1; }
    else if (u < 2048) { const int v = u - 1024; d.mode = 1; d.b = v >> 7; kvh = (v >> 6) & 1; d.qx = v & 63; d.isB = 0; }
    else { const int v = u - 2048; d.mode = 2; d.b = v >> 4; kvh = (v >> 2) & 1; d.isB = (v >> 3) & 1; d.qx = v & 3; }
    d.lat0 = 0; d.nlat = 0;
    if (d.mode == 0) { d.lat0 = min(max(d.qx - 4, 0), 56); d.nlat = 8; d.qtok0 = d.b * SEQ + 64 * d.qx; }
    else if (d.mode == 1) { d.lat0 = max(d.qx - 2, 0); d.nlat = min(d.qx + 2, 63) - d.lat0 + 1; d.qtok0 = d.b * SEQ + 64 * d.qx; }
    else { d.qtok0 = MLAT + d.b * CTXL + 64 * d.qx; }
    d.nt = d.nlat + 4;
    d.hq = 4 * kvh + g;
    d.qcol = d.isB * 512 + d.hq * 64; d.kcol = (d.isB ? 1152 : 1024) + 64 * kvh; d.vrow = d.isB * 128 + 64 * kvh;
    return d;
}
constexpr int L0_NSLOT = 6, L0_AHEAD = 4;
constexpr int L0_Q_OFF = L0_NSLOT * L0_BUF;
constexpr int L0_RPB2_OFF = 131072 + 256;
__device__ __forceinline__ void attn_l0_phase(LAS unsigned char* lds, const L0Args P, int bid, int G, int tid) {
    const int lane = tid & 63, wid = __builtin_amdgcn_readfirstlane(tid >> 6), i31 = lane & 31, h = lane >> 5;
    const int pi = (i31 & 0x13) | ((i31 & 4) << 1) | ((i31 & 8) >> 1);
    const int g = wid >> 1, jh = wid & 1;
    LAS float* rpbl = (LAS float*)(lds + L0_RPB2_OFF);
    for (int i = tid; i < 8 * 15 * 31; i += 512) rpbl[i] = P.rpb[i] * LOG2E_F;
    __syncthreads();
    int goff[2];
#pragma unroll
    for (int i = 0; i < 2; ++i) {
        const int p = 2 * wid + i, rl = lane >> 3, sl = lane & 7;
        if (wid < 4) { const int kr = 8 * p + rl, c = sl ^ ((kr >> 1) & 7); goff[i] = kr * NQK0 + c * 8; }
        else { const int e = 8 * (p - 8) + rl, c = sl ^ ((e >> 1) & 7); goff[i] = e * MTOT + c * 8; }
    }
    int qoff[4];
#pragma unroll
    for (int p = 0; p < 4; ++p) { const int row = 8 * p + (lane >> 3), c = (lane & 7) ^ ((row >> 1) & 7); qoff[p] = row * NQK0 + c * 8; }
#define L0_TOK0(D, t_) (((t_) < (D).nlat) ? (D).b * SEQ + 64 * ((D).lat0 + (t_)) : MLAT + (D).b * CTXL + 64 * ((t_) - (D).nlat))
#define L0_ISSUE(D, t_, slot_) do { const int tok0_ = L0_TOK0(D, t_); \
        const bf16_t* gb_ = (wid < 4) ? P.QK + (D).kcol + (size_t)tok0_ * NQK0 : P.VT + (size_t)(D).vrow * MTOT + tok0_; \
        _Pragma("unroll") for (int i_ = 0; i_ < 2; ++i_) __builtin_amdgcn_global_load_lds((const unsigned*)(gb_ + goff[i_]), (LAS unsigned*)(lds + (slot_) * L0_BUF + (2 * wid + i_) * 1024), 16, 0, 0); } while (0)
#define L0_ISSUE_Q(D) do { const bf16_t* gq_ = P.QK + (size_t)((D).qtok0 + 32 * jh) * NQK0 + (D).qcol; \
        _Pragma("unroll") for (int p_ = 0; p_ < 4; ++p_) __builtin_amdgcn_global_load_lds((const unsigned*)(gq_ + qoff[p_]), (LAS unsigned*)(lds + L0_Q_OFF + wid * 4096 + p_ * 1024), 16, 0, 0); } while (0)
    const int vcu = (G % 8 == 0) ? (bid % 8) * (G / 8) + bid / 8 : bid;
    int u = vcu;
    if (u >= L0_UNITS) return;
    L0Unit D = l0_decode(u, g);
    int sp = 0; bool later = false;
    L0_ISSUE(D, 0, 0); L0_ISSUE(D, 1, 1); L0_ISSUE(D, 2, 2); L0_ISSUE(D, 3, 3); L0_ISSUE_Q(D);
    L0_WAIT_BAR(0);
    for (;;) {
        const int un = u + G; const bool has_next = un < L0_UNITS;
        L0Unit Dn = D; if (has_next) Dn = l0_decode(un, g);
        const int nt = D.nt;
        bf16x8 qf[4];
        { const LAS unsigned char* qb = lds + L0_Q_OFF + wid * 4096; const int sw = (i31 >> 1) & 7;
#pragma unroll
          for (int d0 = 0; d0 < 4; ++d0) qf[d0] = *(const LAS bf16x8*)(qb + i31 * 128 + (((2 * d0 + h) ^ sw) << 4)); }
        float m_run, l_run;
        if (!D.isB) { m_run = P.sink[D.hq] * LOG2E_F; l_run = (h == 0) ? 1.f : 0.f; } else { m_run = 0.f; l_run = 0.f; }
        f32x16 negm;
#pragma unroll
        for (int r = 0; r < 16; ++r) negm[r] = -m_run;
        f32x16 oT[2]; oT[0] = f32x16{}; oT[1] = f32x16{};
        for (int t = 0; t < nt; ++t) {
            bool issued = false, issued_q = false;
            { int sl = sp + L0_AHEAD; if (sl >= L0_NSLOT) sl -= L0_NSLOT;
              if (t + L0_AHEAD < nt) { L0_ISSUE(D, t + L0_AHEAD, sl); issued = true; }
              else if (has_next) { L0_ISSUE(Dn, t + L0_AHEAD - nt, sl); issued = true; if (t == nt - 1) { L0_ISSUE_Q(Dn); issued_q = true; } } }
            const LAS unsigned char* buf = lds + sp * L0_BUF;
            L0Mask mk; mk.mode = 0; mk.tab = rpbl; mk.vb = 0; mk.dq = 0;
            if (t < D.nlat) {
                if (D.mode == 0) {
                    const int krow = D.lat0 + t, c = 32 * jh + i31, cstart = min(max(c - 8, 0), 48);
                    mk.mode = 1; mk.tab = rpbl + (D.hq * 15 + (krow - D.qx + 7)) * 31 + (8 * h - c + 15); mk.vb = 8 * h - cstart;
                } else {
                    const int tl = D.lat0 + t;
                    if (tl == D.qx - 2 || tl == D.qx + 2) { mk.mode = 2; mk.dq = 64 * D.qx + 32 * jh + i31 - 64 * tl - 8 * h; }
                }
            }
            tile_compute<2, L0Mask>(buf, buf + 8192, qf, oT, negm, m_run, l_run, D.isB && t == 0, pi, i31, h, mk);
            if (later && t < 3) L0_WAIT_BAR(63); else if (issued_q) L0_WAIT_BAR(10); else if (issued) L0_WAIT_BAR(6); else L0_WAIT_BAR(0);
            sp = (sp + 1 == L0_NSLOT) ? 0 : sp + 1;
        }
        if (has_next) asm volatile("s_waitcnt vmcnt(0)" ::: "memory");
        const float l = l_run + __shfl_xor(l_run, 32);
        const float inv = 1.0f / l;
        bf16_t* yp = P.Y + (size_t)(D.qtok0 + 32 * jh + i31) * DM + D.qcol;
#pragma unroll
        for (int db = 0; db < 2; ++db)
#pragma unroll
            for (int rg = 0; rg < 4; ++rg) {
                u32x2 w; w.x = pk_bf16(oT[db][4 * rg] * inv, oT[db][4 * rg + 1] * inv); w.y = pk_bf16(oT[db][4 * rg + 2] * inv, oT[db][4 * rg + 3] * inv);
                *(u32x2*)(yp + 32 * db + 8 * rg + 4 * h) = w;
            }
        if (!has_next) break;
        u = un; D = Dn; later = true;
    }
#undef L0_ISSUE
#undef L0_ISSUE_Q
#undef L0_TOK0
}
#undef L0_WAIT_BAR

constexpr int DF_SUB = 32768;
constexpr int DF_BUF = 65536;
constexpr int DF_X_OFF = 65536;
struct DiffArgs { const bf16_t* QK; const bf16_t* VT; bf16_t* Y; const float* lq1; const float* lk1; const float* lq2; const float* lk2; const float* subg; };
#define DF_WAIT_BAR(N) asm volatile("s_waitcnt vmcnt(" #N ") lgkmcnt(0)\n\ts_barrier" ::: "memory")

__device__ __forceinline__ void attn_diff_phase(LAS unsigned char* lds, const DiffArgs P, int bid, int G, int tid) {
    const int lane = tid & 63, wid = __builtin_amdgcn_readfirstlane(tid >> 6), i31 = lane & 31, h = lane >> 5;
    const int pi = (i31 & 0x13) | ((i31 & 4) << 1) | ((i31 & 8) >> 1);
    const int msub = wid & 1, jg = wid >> 1;
    const float lam = expf(wave_sum(P.lq1[lane] * P.lk1[lane])) - expf(wave_sum(P.lq2[lane] * P.lk2[lane])) + LAM_INIT;
    int goff[4];
#pragma unroll
    for (int i = 0; i < 4; ++i) {
        const int p = 4 * wid + i, rl = lane >> 3, sl = lane & 7;
        if (wid < 4) { const int kr = 8 * (p & 7) + rl, c = sl ^ ((kr >> 1) & 7); goff[i] = kr * NQK1 + (p >> 3) * 64 + c * 8; }
        else { const int e = 8 * (p - 16) + rl, c = sl ^ ((e >> 1) & 7); goff[i] = e * MTOT + c * 8; }
    }
    LAS float* subg_l = (LAS float*)(lds + 131072 + 256);
    if (tid < 128) subg_l[tid] = P.subg[tid];
    __syncthreads();
    const int nunits = NBATCH * 8 * 32;
#define DF_DECODE(it_, ok_, b_, hd_, qb_) do { int pair_; if (G == 256) { ok_ = (it_) < 8; pair_ = (bid & 7) * 8 + (it_); qb_ = bid >> 3; } \
        else { const int u_ = bid + (it_) * G; ok_ = u_ < nunits; pair_ = u_ >> 5; qb_ = u_ & 31; } b_ = pair_ >> 3; hd_ = pair_ & 7; } while (0)
#define DF_ISSUE(B_, KB_, VB_, st_, bo_) do { _Pragma("unroll") for (int sub_ = 0; sub_ < 2; ++sub_) { const int t_ = 2 * (st_) + sub_; \
            const int tok0_ = (t_ < 64) ? (B_) * SEQ + 64 * t_ : MLAT + (B_) * CTXL + 64 * (t_ - 64); \
            const bf16_t* gb_ = (wid < 4) ? (KB_) + (size_t)tok0_ * NQK1 : (VB_) + tok0_; \
            _Pragma("unroll") for (int i_ = 0; i_ < 4; ++i_) __builtin_amdgcn_global_load_lds((const unsigned*)(gb_ + goff[i_]), (LAS unsigned*)(lds + (bo_) + sub_ * DF_SUB + (4 * wid + i_) * 1024), 16, 0, 0); } } while (0)
    bool ok; int b, hd, qb;
    DF_DECODE(0, ok, b, hd, qb);
    if (!ok) return;
    const bf16_t* kbase = P.QK + 1024 + hd * 128;
    const bf16_t* vbase = P.VT + (size_t)(hd * 128) * MTOT;
    bf16x8 qf[4];
    { const int qtok0 = b * SEQ + 128 * qb + 32 * jg + i31;
#pragma unroll
      for (int d0 = 0; d0 < 4; ++d0) qf[d0] = *(const bf16x8*)(P.QK + (size_t)qtok0 * NQK1 + hd * 128 + msub * 64 + 16 * d0 + 8 * h); }
    DF_ISSUE(b, kbase, vbase, 0, 0);
    for (int it = 0; ; ++it) {
        const int qtok = b * SEQ + 128 * qb + 32 * jg + i31;
        float m_run = 0.f, l_run = 0.f;
        f32x16 oT[4]; oT[0] = f32x16{}; oT[1] = f32x16{}; oT[2] = f32x16{}; oT[3] = f32x16{};
        f32x16 negm = f32x16{};
        int b0 = 0, b1 = DF_BUF;
        asm volatile("" : "+v"(qf[0]), "+v"(qf[1]), "+v"(qf[2]), "+v"(qf[3]));
        DF_WAIT_BAR(0);
        constexpr int NST = 34;
        for (int st = 0; st < NST; ++st) {
            if (st + 1 < NST) DF_ISSUE(b, kbase, vbase, st + 1, b1);
            const LAS unsigned char* buf = lds + b0;
            tile_compute128<4>(buf + msub * 8192, buf + 16384, buf + DF_SUB + msub * 8192, buf + DF_SUB + 16384, qf, oT, negm, m_run, l_run, st == 0, pi, i31, h);
            DF_WAIT_BAR(0);
            { const int tmp = b0; b0 = b1; b1 = tmp; }
        }
        bool nok; int nb, nhd, nqb;
        DF_DECODE(it + 1, nok, nb, nhd, nqb);
        const int hd_cur = hd;
        if (nok) {
            kbase = P.QK + 1024 + nhd * 128; vbase = P.VT + (size_t)(nhd * 128) * MTOT;
            DF_ISSUE(nb, kbase, vbase, 0, 0);
            const int qtokn = nb * SEQ + 128 * nqb + 32 * jg + i31;
#pragma unroll
            for (int d0 = 0; d0 < 4; ++d0) qf[d0] = *(const bf16x8*)(P.QK + (size_t)qtokn * NQK1 + nhd * 128 + msub * 64 + 16 * d0 + 8 * h);
            b = nb; hd = nhd; qb = nqb;
        }
        const float l = l_run + __shfl_xor(l_run, 32);
        const float inv = 1.0f / l;
        LAS float* X = (LAS float*)(lds + DF_X_OFF) + jg * 4096;
        if (msub == 1) {
            const float f = lam * inv;
#pragma unroll
            for (int db = 0; db < 4; ++db)
#pragma unroll
                for (int r = 0; r < 16; ++r) X[(32 * db + crow(r, h)) * 32 + i31] = oT[db][r] * f;
        }
        __syncthreads();
        if (msub == 0) {
            float ssq = 0.f;
#pragma unroll
            for (int db = 0; db < 4; ++db)
#pragma unroll
                for (int r = 0; r < 16; ++r) { const float d = oT[db][r] * inv - X[(32 * db + crow(r, h)) * 32 + i31]; oT[db][r] = d; ssq += d * d; }
            ssq += __shfl_xor(ssq, 32);
            const float rn = rsqrtf(ssq * (1.0f / 128.0f) + EPS_F) * (1.0f - LAM_INIT);
            bf16_t* yp = P.Y + (size_t)qtok * DM + hd_cur * 128;
            f32x4 gqv[4][4];
#pragma unroll
            for (int db = 0; db < 4; ++db)
#pragma unroll
                for (int rg = 0; rg < 4; ++rg) gqv[db][rg] = *(const LAS f32x4*)(subg_l + 32 * db + 8 * rg + 4 * h);
#pragma unroll
            for (int db = 0; db < 4; ++db)
#pragma unroll
                for (int rg = 0; rg < 4; ++rg) {
                    const int e0 = 32 * db + 8 * rg + 4 * h;
                    const f32x4 gq = gqv[db][rg];
                    u32x2 w; w.x = pk_bf16(oT[db][4 * rg] * rn * gq[0], oT[db][4 * rg + 1] * rn * gq[1]); w.y = pk_bf16(oT[db][4 * rg + 2] * rn * gq[2], oT[db][4 * rg + 3] * rn * gq[3]);
                    *(u32x2*)(yp + e0) = w;
                }
        }
        __syncthreads();
        if (!nok) break;
    }
#undef DF_ISSUE
#undef DF_DECODE
}
#undef DF_WAIT_BAR
#undef MFMA32
}

constexpr size_t MiB = 1u << 20;
constexpr size_t WS_MOD = 0;
constexpr size_t WS_ROPE = 512 * 1024;
constexpr size_t WS_BIAS = 1 * MiB;
constexpr size_t WS_SS = 4 * MiB;
constexpr size_t WS_WQK0 = 8 * MiB, WS_WV0 = 11 * MiB, WS_WO0 = 12 * MiB, WS_W10 = 14 * MiB, WS_W20 = 22 * MiB;
constexpr size_t WS_WQK1 = 30 * MiB, WS_WV1 = 34 * MiB, WS_WO1 = 36 * MiB, WS_W11 = 38 * MiB, WS_W21 = 46 * MiB;
constexpr size_t WS_HR = 56 * MiB;
constexpr size_t WS_QK = 192 * MiB;
constexpr size_t WS_VT = 328 * MiB;
constexpr size_t WS_Y = 396 * MiB;
constexpr size_t WS_H = 192 * MiB;
constexpr size_t WS_SLAB = 464 * MiB;
constexpr size_t WS_END = 512 * MiB;
constexpr int BO_QK0 = 0, BO_V0 = BO_QK0 + 9 * NQK0, BO_UP0 = BO_V0 + 9 * NV0, BO_QK1 = BO_UP0 + 9 * DFF, BO_V1 = BO_QK1 + 9 * NQK1, BO_UP1 = BO_V1 + 9 * NV1;
constexpr int LDS_BYTES = 147456;
constexpr int NPHASE = 15;

__device__ __forceinline__ float silu_f(float v) { return v / (1.0f + expf(-v)); }
__device__ __forceinline__ void even_map(int c, int& isv, int& r) {
    if (c < 512) { isv = 0; r = c; } else if (c < 640) { isv = 0; r = 1024 + (c - 512); } else if (c < 768) { isv = 1; r = c - 640; }
    else if (c < 1280) { isv = 0; r = 512 + (c - 768); } else if (c < 1408) { isv = 0; r = 1152 + (c - 1280); } else { isv = 1; r = 128 + (c - 1408); }
}
__device__ __forceinline__ void gemv9_item(const float* __restrict__ W, int ldw, int csrc0, const LAS float* vec, LAS float* red, float* out, int ostride, int cdst0, const float* addb, int tid) {
    const int lane = tid & 63, kg = tid >> 6, cg = lane & 15, ks = lane >> 4;
    f32x4 a[9];
#pragma unroll
    for (int b = 0; b < 9; ++b) a[b] = (f32x4){0.f, 0.f, 0.f, 0.f};
    const float* wp = W + (size_t)(kg * 128 + ks) * ldw + csrc0 + 4 * cg;
    const LAS float* vp = vec + kg * 128 + ks;
#pragma unroll 8
    for (int i = 0; i < 32; ++i) {
        const f32x4 w = *(const f32x4*)(wp + (size_t)(4 * i) * ldw);
#pragma unroll
        for (int b = 0; b < 9; ++b) a[b] += w * vp[b * 1024 + 4 * i];
    }
    LAS float* rp = red + (kg * 4 + ks) * 576 + 4 * cg;
#pragma unroll
    for (int b = 0; b < 9; ++b) *(LAS f32x4*)(rp + b * 64) = a[b];
    __syncthreads();
    for (int idx = tid; idx < 576; idx += 512) {
        const int c = idx & 63; float s = 0.f;
#pragma unroll
        for (int g2 = 0; g2 < 32; ++g2) s += red[g2 * 576 + idx];
        if (addb) s += addb[csrc0 + c];
        out[(size_t)(idx >> 6) * ostride + cdst0 + c] = s;
    }
    __syncthreads();
}
__device__ __forceinline__ void transpose_item(const float* __restrict__ W, int K, int N, int k0, int n0, bf16_t* dst, LAS float* scr, int lane) {
    f32x4 v[8];
#pragma unroll
    for (int i = 0; i < 8; ++i) v[i] = *(const f32x4*)(W + (size_t)(k0 + 8 * i + (lane >> 3)) * N + n0 + 4 * (lane & 7));
#pragma unroll
    for (int i = 0; i < 8; ++i) { LAS float* sp = scr + (8 * i + (lane >> 3)) * 33 + 4 * (lane & 7); sp[0] = v[i][0]; sp[1] = v[i][1]; sp[2] = v[i][2]; sp[3] = v[i][3]; }
    asm volatile("s_waitcnt lgkmcnt(0)" ::: "memory");
    const int c = lane & 7;
#pragma unroll
    for (int j = 0; j < 4; ++j) { const int n = (lane >> 3) + 8 * j; const LAS float* s = scr + (8 * c) * 33 + n;
        u32x4 o; o.x = pk_bf16(s[0 * 33], s[1 * 33]); o.y = pk_bf16(s[2 * 33], s[3 * 33]); o.z = pk_bf16(s[4 * 33], s[5 * 33]); o.w = pk_bf16(s[6 * 33], s[7 * 33]);
        *(u32x4*)(dst + (size_t)n * K + k0 + 8 * c) = o; }
    asm volatile("s_waitcnt lgkmcnt(0)" ::: "memory");
}
__device__ __forceinline__ void sincos_small(double a, float& c, float& s) {
    const double TWO_PI = 6.283185307179586476925287;
    const double k = __builtin_rint(a / TWO_PI);
    const double x = a - k * TWO_PI, x2 = x * x;
    double ts = 1.0, tc = 1.0;
    for (int j = 15; j >= 1; --j) { ts = 1.0 - x2 / (double)((2 * j) * (2 * j + 1)) * ts; tc = 1.0 - x2 / (double)((2 * j - 1) * (2 * j)) * tc; }
    s = (float)(x * ts); c = (float)tc;
}

#define GAS __attribute__((address_space(1)))
#define XB_TMO      128
#define XB_XCNT(j)  (256  + 64 * (j))
#define XB_XSUB(j)  (1280 + 64 * (j))
#define XB_XGEN(j)  (2304 + 64 * (j))
#define XB_TOP      3328
#define XB_TOPGEN   3392
#define XCD_BAR_WORDS 3456
#define XB_SPIN_CAP (1u << 18)

__device__ __forceinline__ unsigned xb_ld(unsigned* p)              { return __hip_atomic_load(p, __ATOMIC_RELAXED, __HIP_MEMORY_SCOPE_AGENT); }
__device__ __forceinline__ unsigned xb_add(unsigned* p, unsigned v) { return __hip_atomic_fetch_add(p, v, __ATOMIC_RELAXED, __HIP_MEMORY_SCOPE_AGENT); }
__device__ __forceinline__ unsigned xb_xcc_id() { return (unsigned)__builtin_amdgcn_s_getreg((3 << 11) | 20) & 0xFu; }
#define XB_SPIN(cond, bar) do { unsigned _sp = 0; while (cond) { __builtin_amdgcn_s_sleep(1); \
    if ((++_sp & 255u) == 0u) { if (xb_ld(&(bar)[XB_TMO])) break; if (_sp > XB_SPIN_CAP) { atomicAdd(&(bar)[XB_TMO], 1u); break; } } } } while (0)

struct XcdBarrier {
    unsigned* bar; unsigned x;
    volatile LAS unsigned* st;
};

__device__ __forceinline__ XcdBarrier xcd_barrier_post(unsigned* bar, volatile LAS unsigned* st) {
    XcdBarrier b; b.bar = bar; b.x = xb_xcc_id(); b.st = st;
    if (threadIdx.x == 0) (void)xb_add(&bar[XB_XCNT(b.x)], 1u);
    return b;
}
__device__ __forceinline__ void xcd_barrier_complete(unsigned* bar, unsigned x, unsigned& nloc, unsigned& nx) {
    const unsigned G = gridDim.x * gridDim.y * gridDim.z;
    unsigned sum, cnt, mine, sp = 0u;
    for (;;) {
        sum = 0u; cnt = 0u; mine = 0u;
#pragma unroll
        for (unsigned j = 0; j < 16; ++j) { const unsigned c = xb_ld(&bar[XB_XCNT(j)]); sum += c; cnt += (c > 0u) ? 1u : 0u; mine = (j == x) ? c : mine; }
        if (sum == G) break;
        __builtin_amdgcn_s_sleep(1);
        if ((++sp & 255u) == 0u) { if (xb_ld(&bar[XB_TMO])) break; if (sp > XB_SPIN_CAP) { atomicAdd(&bar[XB_TMO], 1u); break; } }
    }
    nloc = mine > 0u ? mine : 1u; nx = cnt > 0u ? cnt : 1u;
}

__device__ __forceinline__ void xcd_barrier(const XcdBarrier& b) {
    asm volatile("s_waitcnt vmcnt(0)" ::: "memory");
    __syncthreads();
    if (threadIdx.x == 0) {
        unsigned* bar = b.bar;
        __builtin_amdgcn_s_waitcnt(0);
        unsigned nloc = b.st[0], nx = b.st[1];
        if (nloc == 0u) { xcd_barrier_complete(bar, b.x, nloc, nx); b.st[0] = nloc; b.st[1] = nx; }
        const unsigned old = xb_add(&bar[XB_XSUB(b.x)], 1u);
        const unsigned gen = old / nloc;
        if (old + 1u == (gen + 1u) * nloc) {
            __builtin_amdgcn_fence(__ATOMIC_RELEASE, "agent");
            asm volatile("s_waitcnt vmcnt(0)" ::: "memory");
            const unsigned og = xb_add(&bar[XB_TOP], 1u);
            const unsigned tg = og / nx;
            if (og + 1u == (tg + 1u) * nx) xb_add(&bar[XB_TOPGEN], 1u);
            else XB_SPIN(xb_ld(&bar[XB_TOPGEN]) == tg, bar);
            __builtin_amdgcn_fence(__ATOMIC_ACQUIRE, "agent");
            xb_add(&bar[XB_XGEN(b.x)], 1u);
            asm volatile("s_waitcnt vmcnt(0)" ::: "memory");
        } else {
            XB_SPIN(xb_ld(&bar[XB_XGEN(b.x)]) == gen, bar);
            __builtin_amdgcn_fence(__ATOMIC_ACQUIRE, "agent");
            asm volatile("s_waitcnt vmcnt(0)" ::: "memory");
        }
    }
    __syncthreads();
}

constexpr size_t WS_BAR = 2 * MiB;
constexpr int LDS_MISC_OFF = 131072;
template <bool HIN_BF> __device__ __forceinline__ void ctx_reduce(const float* slab_lo, const float* slab_hi, const void* hin, const float* gate, const float* scl, const float* ng, bf16_t* hout, bf16_t* xg, float* ss, int gw, int NGW, int lane) {
    for (int r = gw; r < MCTX; r += NGW) {
        f32x4 a[4];
#pragma unroll
        for (int j = 0; j < 4; ++j) a[j] = (f32x4){0.f, 0.f, 0.f, 0.f};
#pragma unroll
        for (int ks = 0; ks < 8; ++ks) {
            const float* sp = (ks < 6 ? slab_lo + (size_t)ks * MCTX * DM : slab_hi + (size_t)(ks - 6) * MCTX * DM) + (size_t)r * DM + 4 * lane;
#pragma unroll
            for (int j = 0; j < 4; ++j) a[j] += *(const f32x4*)(sp + 256 * j);
        }
        float ssum = 0.f;
#pragma unroll
        for (int j = 0; j < 4; ++j) {
            const int k = 4 * lane + 256 * j;
            f32x4 h0; if (HIN_BF) h0 = pg8::ld_bf4((const bf16_t*)hin + (size_t)r * DM + k); else h0 = *(const f32x4*)((const float*)hin + (size_t)r * DM + k);
            const f32x4 v = h0 + *(const f32x4*)(gate + 8 * 6144 + k) * a[j];
            if (hout) { u32x2 w; w.x = pk_bf16(v[0], v[1]); w.y = pk_bf16(v[2], v[3]); *(u32x2*)(hout + (size_t)r * DM + k) = w; }
            ssum += (v[0] * v[0] + v[1] * v[1]) + (v[2] * v[2] + v[3] * v[3]);
            const f32x4 y = v * (*(const f32x4*)(ng + k) * (*(const f32x4*)(scl + 8 * 6144 + k) + 1.0f));
            u32x2 w; w.x = pk_bf16(y[0], y[1]); w.y = pk_bf16(y[2], y[3]);
            *(u32x2*)(xg + (size_t)(MLAT + r) * DM + k) = w;
        }
        ssum = att::wave_sum(ssum);
        if (lane < 16) ss[(size_t)(MLAT + r) * 16 + lane] = (lane == 0) ? ssum : 0.f;
    }
}

__device__ __forceinline__ void transpose_dispatch(int it, LAS float* scr, int lane, const float* even_w_in, const float* even_w_out, const float* odd_w_in, const float* odd_w_out, const float* mlp_w1, const float* mlp_w2,
                                                   bf16_t* Wqk0, bf16_t* Wv0, bf16_t* Wo0, bf16_t* Wqk1, bf16_t* Wv1, bf16_t* Wo1, bf16_t* W10, bf16_t* W11, bf16_t* W20, bf16_t* W21) {
    int r = it;
    if (r < 768) { const int kb = r / 48, nb = r % 48; int isv, dr; even_map(32 * nb, isv, dr);
        transpose_item(even_w_in, DM, 1536, 64 * kb, 32 * nb, (isv ? Wv0 : Wqk0) + (size_t)dr * DM, scr, lane); return; } r -= 768;
    if (r < 512) { const int kb = r / 32, nb = r % 32; transpose_item(even_w_out, DM, DM, 64 * kb, 32 * nb, Wo0 + (size_t)(32 * nb) * DM, scr, lane); return; } r -= 512;
    if (r < 1536) { const int kb = r / 96, nb = r % 96; const int n0 = 32 * nb;
        transpose_item(odd_w_in, DM, 3072, 64 * kb, n0, n0 < 2048 ? Wqk1 + (size_t)n0 * DM : Wv1 + (size_t)(n0 - 2048) * DM, scr, lane); return; } r -= 1536;
    if (r < 512) { const int kb = r / 32, nb = r % 32; transpose_item(odd_w_out, DM, DM, 64 * kb, 32 * nb, Wo1 + (size_t)(32 * nb) * DM, scr, lane); return; } r -= 512;
    if (r < 4096) { const int l = r / 2048, q = r % 2048, kb = q / 128, nb = q % 128;
        transpose_item(mlp_w1 + (size_t)l * DM * DFF, DM, DFF, 64 * kb, 32 * nb, (l ? W11 : W10) + (size_t)(32 * nb) * DM, scr, lane); return; } r -= 4096;
    { const int l = r / 2048, q = r % 2048, kb = q / 32, nb = q % 32;
        transpose_item(mlp_w2 + (size_t)l * DFF * DM, DFF, DM, 64 * kb, 32 * nb, (l ? W21 : W20) + (size_t)(32 * nb) * DFF, scr, lane); }
}

#ifndef USE_FINAL
#define USE_FINAL 0
#endif
struct Args { const float* in[22]; float* out; unsigned char* ws; int ph_lo, ph_hi; };

__global__ void __launch_bounds__(512, 2) dit_fwd(Args args) {
    extern __shared__ __attribute__((aligned(16))) unsigned char lds_raw[];
    LAS unsigned char* lds = (LAS unsigned char*)lds_raw;
    const int tid = threadIdx.x, lane = tid & 63, wave = __builtin_amdgcn_readfirstlane(tid >> 6);
    const int bid = blockIdx.x, G = gridDim.x;
    const int gw = bid * 8 + wave, NGW = G * 8;
    unsigned char* ws = args.ws;
    const float* x = args.in[0]; const float* cvec = args.in[1]; const float* ctx = args.in[2]; const float* c_ctx = args.in[3];
    const float* ada_w = args.in[4]; const float* ada_b = args.in[5]; const float* norm1_g = args.in[6]; const float* norm2_g = args.in[7];
    const float* even_w_in = args.in[8]; const float* even_w_out = args.in[9]; const float* a_sink = args.in[10]; const float* b_rpb = args.in[11];
    const float* odd_w_in = args.in[12]; const float* odd_w_out = args.in[13];
    const float* mlp_w1 = args.in[19]; const float* mlp_w2 = args.in[20]; const float* final_g = args.in[21];
    float* mod = (float*)(ws + WS_MOD); float* ropetab = (float*)(ws + WS_ROPE); float* biasb = (float*)(ws + WS_BIAS); float* ssb = (float*)(ws + WS_SS);
    bf16_t* Wqk0 = (bf16_t*)(ws + WS_WQK0); bf16_t* Wv0 = (bf16_t*)(ws + WS_WV0); bf16_t* Wo0 = (bf16_t*)(ws + WS_WO0); bf16_t* W10 = (bf16_t*)(ws + WS_W10); bf16_t* W20 = (bf16_t*)(ws + WS_W20);
    bf16_t* Wqk1 = (bf16_t*)(ws + WS_WQK1); bf16_t* Wv1 = (bf16_t*)(ws + WS_WV1); bf16_t* Wo1 = (bf16_t*)(ws + WS_WO1); bf16_t* W11 = (bf16_t*)(ws + WS_W11); bf16_t* W21 = (bf16_t*)(ws + WS_W21);
    bf16_t* HR = (bf16_t*)(ws + WS_HR); bf16_t* QK = (bf16_t*)(ws + WS_QK); bf16_t* VT = (bf16_t*)(ws + WS_VT); bf16_t* Y = (bf16_t*)(ws + WS_Y); bf16_t* Hb = (bf16_t*)(ws + WS_H);
    bf16_t* XG = (bf16_t*)args.out;
    const int lo = args.ph_lo, hi = args.ph_hi;
#define IN(k) (lo <= (k) && (k) < hi)
#ifdef PROBE_STAMPS
    unsigned long long* stamps = (unsigned long long*)(ws + 3 * MiB);
    if (bid == 0 && tid == 0) stamps[0] = __builtin_amdgcn_s_memrealtime();
#define SEAM(k) do { if (IN(k) && IN((k) + 1)) { cg::this_grid().sync(); if (bid == 0 && tid == 0) stamps[(k) + 1] = __builtin_amdgcn_s_memrealtime(); } } while (0)
#else
    volatile LAS unsigned* misc = (volatile LAS unsigned*)(lds + LDS_MISC_OFF);
    if (tid < 4) misc[tid] = 0u;
    __syncthreads();
    XcdBarrier xbar; xbar.bar = (unsigned*)(ws + WS_BAR); xbar.x = 0; xbar.st = nullptr;
    if (hi - lo > 1) xbar = xcd_barrier_post((unsigned*)(ws + WS_BAR), misc);
#define SEAM(k) do { if (IN(k) && IN((k) + 1)) { xcd_barrier(xbar); } } while (0)
#endif

    if (IN(0)) {
        if (bid < 192) {
            LAS float* vec = (LAS float*)lds; LAS float* red = (LAS float*)(lds + 40960);
            for (int i = tid; i < 9 * 1024; i += 512) { const float v = (i < 8192) ? cvec[i] : c_ctx[i - 8192]; vec[i] = silu_f(v); }
            __syncthreads();
            const int l = bid / 96, cb = bid % 96;
            gemv9_item(ada_w + (size_t)l * DM * 6144, 6144, cb * 64, vec, red, mod + (size_t)l * 9 * 6144, 6144, cb * 64, ada_b + (size_t)l * 6144, tid);
        }
        if (bid == G - 1) {
            for (int idx = tid; idx < 1024; idx += 512) {
                const int pos = idx >> 4, i = idx & 15; double f = 1.0;
                for (int q = 0; q < i; ++q) f *= 0.56234132519034908;
                float c, s; sincos_small((double)pos * f, c, s);
                ropetab[2 * idx] = c; ropetab[2 * idx + 1] = s;
            }
        }
        __syncthreads();
        LAS float* scr = (LAS float*)(lds + wave * 8448);
        const bool defer = (G == 256);
        for (int it = gw; it < (defer ? 768 : 11520); it += NGW) transpose_dispatch(it, scr, lane, even_w_in, even_w_out, odd_w_in, odd_w_out, mlp_w1, mlp_w2, Wqk0, Wv0, Wo0, Wqk1, Wv1, Wo1, W10, W11, W20, W21);
    }
    SEAM(0);
    if (IN(1)) {
        if (bid < 200) {
            LAS float* vec = (LAS float*)lds; LAS float* red = (LAS float*)(lds + 40960);
            int l, soff; if (bid < 24) { l = 0; soff = 0; } else if (bid < 88) { l = 0; soff = 3072; } else if (bid < 136) { l = 1; soff = 0; } else { l = 1; soff = 3072; }
            for (int i = tid; i < 9 * 1024; i += 512) vec[i] = mod[(size_t)(l * 9 + (i >> 10)) * 6144 + soff + (i & 1023)];
            __syncthreads();
            if (bid < 24) { const int c0 = 64 * bid; int isv, dr; even_map(c0, isv, dr);
                gemv9_item(even_w_in, 1536, c0, vec, red, biasb + (isv ? BO_V0 : BO_QK0), isv ? NV0 : NQK0, dr, nullptr, tid); }
            else if (bid < 88) { const int c0 = 64 * (bid - 24); gemv9_item(mlp_w1, DFF, c0, vec, red, biasb + BO_UP0, DFF, c0, nullptr, tid); }
            else if (bid < 136) { const int c0 = 64 * (bid - 88);
                if (c0 < 2048) gemv9_item(odd_w_in, 3072, c0, vec, red, biasb + BO_QK1, NQK1, c0, nullptr, tid);
                else gemv9_item(odd_w_in, 3072, c0, vec, red, biasb + BO_V1, NV1, c0 - 2048, nullptr, tid); }
            else { const int c0 = 64 * (bid - 136); gemv9_item(mlp_w1 + (size_t)DM * DFF, DFF, c0, vec, red, biasb + BO_UP1, DFF, c0, nullptr, tid); }
        }
        for (int r4 = gw; r4 < MTOT / 4; r4 += NGW) {
            const int row0 = 4 * r4;
            const float* src = row0 < MLAT ? x + (size_t)row0 * DM : ctx + (size_t)(row0 - MLAT) * DM;
            const int b = row0 < MLAT ? (row0 >> 12) : 8;
            const float* scl = mod + (size_t)b * 6144 + 1024;
            f32x4 v[4][4];
#pragma unroll
            for (int rr = 0; rr < 4; ++rr)
#pragma unroll
                for (int j = 0; j < 4; ++j) v[rr][j] = *(const f32x4*)(src + (size_t)rr * DM + 4 * lane + 256 * j);
            f32x4 gp[4];
#pragma unroll
            for (int j = 0; j < 4; ++j) { const int k = 4 * lane + 256 * j; gp[j] = *(const f32x4*)(norm1_g + k) * (*(const f32x4*)(scl + k) + 1.0f); }
#pragma unroll
            for (int rr = 0; rr < 4; ++rr) {
                float ssum = 0.f;
#pragma unroll
                for (int j = 0; j < 4; ++j) {
                    const f32x4 t = v[rr][j];
                    ssum += (t[0] * t[0] + t[1] * t[1]) + (t[2] * t[2] + t[3] * t[3]);
                    const f32x4 y = t * gp[j];
                    u32x2 w; w.x = pk_bf16(y[0], y[1]); w.y = pk_bf16(y[2], y[3]);
                    *(u32x2*)(XG + (size_t)(row0 + rr) * DM + 4 * lane + 256 * j) = w;
                }
                ssum = att::wave_sum(ssum);
                if (lane < 16) ssb[(size_t)(row0 + rr) * 16 + lane] = (lane == 0) ? ssum : 0.f;
            }
        }
    }
    SEAM(1);
    if (IN(2)) {
        { pg8::Gemm g{XG, Wqk0, MTOT, NQK0, DM}; pg8::StaticOrder S; S.init(MTOT, NQK0, G, bid, DM);
          pg8::EpiQK E{QK, NQK0, ssb, biasb + BO_QK0, 0x10Fu, 0x0FFu, ropetab, lds}; pg8::fill_rstd_table<pg8::StaticOrder, false>(lds, S, ssb);
          pg8::gemm_phase<pg8::EpiQK, pg8::StaticOrder, true, true>(lds, g, S, E); }
        { pg8::Gemm g{Wv0, XG, NV0, MTOT, DM}; pg8::StaticOrder S; S.init(NV0, MTOT, G, bid, DM);
          pg8::EpiVT E{VT, MTOT, ssb, biasb + BO_V0, NV0, lds}; pg8::fill_rstd_table<pg8::StaticOrder, true>(lds, S, ssb);
          pg8::gemm_phase<pg8::EpiVT, pg8::StaticOrder, true, true>(lds, g, S, E); }
        if (G == 256 && bid >= 168) {
            LAS float* scr = (LAS float*)(lds + wave * 8448);
            for (int it = 768 + (bid - 168) * 8 + wave; it < 11520; it += 88 * 8) transpose_dispatch(it, scr, lane, even_w_in, even_w_out, odd_w_in, odd_w_out, mlp_w1, mlp_w2, Wqk0, Wv0, Wo0, Wqk1, Wv1, Wo1, W10, W11, W20, W21);
        }
    }
    SEAM(2);
    if (IN(3)) { att::L0Args P{QK, VT, Y, a_sink, b_rpb}; att::attn_l0_phase(lds, P, bid, G, tid); }
    SEAM(3);
    if (IN(4)) {
        pg8::Gemm g{Y, Wo0, MTOT, DM, DM};
        pg8::EpiResT<false, true> E{x, ctx, HR, XG, ssb, mod + 2048, mod + 4096, norm2_g};
        { pg8::StaticOrder S; S.init(G == 256 ? MLAT : MTOT, DM, G, bid, DM); pg8::gemm_phase<pg8::EpiResT<false, true>, pg8::StaticOrder, true, true>(lds, g, S, E); }
        if (G == 256) { pg8::SplitCtxOrder S; S.init(bid, DM);
            pg8::EpiSlab E2{(float*)(ws + WS_QK), (float*)(ws + WS_QK) + (size_t)6 * MCTX * DM};
            pg8::gemm_phase<pg8::EpiSlab, pg8::SplitCtxOrder, true, true>(lds, g, S, E2); }
    }
    SEAM(4);
    if (IN(5)) { if (G == 256) ctx_reduce<false>((const float*)(ws + WS_QK), (const float*)(ws + WS_QK) + (size_t)6 * MCTX * DM, ctx, mod + 2048, mod + 4096, norm2_g, HR + (size_t)MLAT * DM, XG, ssb, gw, NGW, lane); }
    SEAM(5);
    if (IN(6)) {
        pg8::Gemm g{XG, W10, MTOT, DFF, DM}; pg8::StaticOrder S; S.init(MTOT, DFF, G, bid, DM);
        pg8::EpiUp E{Hb, ssb, biasb + BO_UP0, lds}; pg8::fill_rstd_table<pg8::StaticOrder, false>(lds, S, ssb);
        pg8::gemm_phase<pg8::EpiUp, pg8::StaticOrder, true, true>(lds, g, S, E);
    }
    SEAM(6);
    if (IN(7)) {
        pg8::Gemm g{Hb, W20, MTOT, DM, DFF};
        pg8::EpiResT<true, true> E{HR, HR + (size_t)MLAT * DM, HR, XG, ssb, mod + 5120, mod + 9 * 6144 + 1024, norm1_g + DM};
        { pg8::StaticOrder S; S.init(G == 256 ? MLAT : MTOT, DM, G, bid, DFF); pg8::gemm_phase<pg8::EpiResT<true, true>, pg8::StaticOrder, true, true>(lds, g, S, E); }
        if (G == 256) { pg8::SplitCtxOrder S; S.init(bid, DFF);
            pg8::EpiSlab E2{(float*)(ws + WS_SLAB), (float*)((unsigned char*)args.out + 72 * MiB)};
            pg8::gemm_phase<pg8::EpiSlab, pg8::SplitCtxOrder, true, true>(lds, g, S, E2); }
    }
    SEAM(7);
    if (IN(8)) { if (G == 256) ctx_reduce<true>((const float*)(ws + WS_SLAB), (const float*)((const unsigned char*)args.out + 72 * MiB), HR + (size_t)MLAT * DM, mod + 5120, mod + 9 * 6144 + 1024, norm1_g + DM, nullptr, XG, ssb, gw, NGW, lane); }
    SEAM(8);
    if (IN(9)) {
        { pg8::Gemm g{XG, Wqk1, MTOT, NQK1, DM}; pg8::StaticOrder S; S.init(MTOT, NQK1, G, bid, DM);
          pg8::EpiQK E{QK, NQK1, ssb, biasb + BO_QK1, 0xFFFFu, 0x00FFu, ropetab, lds}; pg8::fill_rstd_table<pg8::StaticOrder, false>(lds, S, ssb);
          pg8::gemm_phase<pg8::EpiQK, pg8::StaticOrder, true, true>(lds, g, S, E); }
        { pg8::Gemm g{Wv1, XG, NV1, MTOT, DM}; pg8::StaticOrder S; S.init(NV1, MTOT, G, (bid + G / 2) % G, DM);
          pg8::EpiVT E{VT, MTOT, ssb, biasb + BO_V1, NV1, lds}; pg8::fill_rstd_table<pg8::StaticOrder, true>(lds, S, ssb);
          pg8::gemm_phase<pg8::EpiVT, pg8::StaticOrder, true, true>(lds, g, S, E); }
    }
    SEAM(9);
    if (IN(10)) { att::DiffArgs P{QK, VT, Y, args.in[14], args.in[15], args.in[16], args.in[17], args.in[18]}; att::attn_diff_phase(lds, P, bid, G, tid); }
    SEAM(10);
    if (IN(11)) {
        pg8::Gemm g{Y, Wo1, MLAT, DM, DM}; pg8::StaticOrder S; S.init(MLAT, DM, G, bid, DM);
        pg8::EpiResT<true, true> E{HR, HR, HR, XG, ssb, mod + 9 * 6144 + 2048, mod + 9 * 6144 + 4096, norm2_g + DM};
        pg8::gemm_phase<pg8::EpiResT<true, true>, pg8::StaticOrder, true, true>(lds, g, S, E);
    }
    SEAM(11);
    if (IN(12)) {
        pg8::Gemm g{XG, W11, MLAT, DFF, DM}; pg8::StaticOrder S; S.init(MLAT, DFF, G, bid, DM);
        pg8::EpiUp E{Hb, ssb, biasb + BO_UP1, lds}; pg8::fill_rstd_table<pg8::StaticOrder, false>(lds, S, ssb);
        pg8::gemm_phase<pg8::EpiUp, pg8::StaticOrder, true, true>(lds, g, S, E);
    }
    SEAM(12);
    if (IN(13)) {
        pg8::Gemm g{Hb, W21, MLAT, DM, DFF}; pg8::StaticOrder S; S.init(MLAT, DM, G, bid, DFF);
        if (G == 256 && USE_FINAL) {
            pg8::EpiFinal E{(const float*)HR, args.out, ssb, mod + 9 * 6144 + 5120, final_g, (unsigned*)(ws + WS_BAR) + 4096};
            pg8::gemm_phase<pg8::EpiFinal, pg8::StaticOrder, true, true>(lds, g, S, E);
        } else {
            pg8::EpiResT<true, false> E{HR, HR, args.out, nullptr, ssb, mod + 9 * 6144 + 5120, nullptr, nullptr};
            pg8::gemm_phase<pg8::EpiResT<true, false>, pg8::StaticOrder, true, true>(lds, g, S, E);
        }
    }
    if (G != 256 || !USE_FINAL) { SEAM(13); }
    if (IN(14) && (G != 256 || !USE_FINAL)) {
        for (int row = gw; row < MLAT; row += NGW) {
            const float rs = pg8::row_rstd(ssb, row);
            float* op = args.out + (size_t)row * DM;
#pragma unroll
            for (int j = 0; j < 4; ++j) { const int k = 4 * lane + 256 * j; const f32x4 v = *(const f32x4*)(op + k), g = *(const f32x4*)(final_g + k); *(f32x4*)(op + k) = v * rs * g; }
        }
    }
#ifdef PROBE_STAMPS
    cg::this_grid().sync();
    if (bid == 0 && tid == 0) stamps[13] = __builtin_amdgcn_s_memrealtime();
    cg::this_grid().sync();
    {
        const float da = (float)(stamps[PA_HI] - stamps[PA_LO]) * 0.01f, db = (float)(stamps[PB_HI] - stamps[PB_LO]) * 0.01f;
        for (size_t i = (size_t)bid * 512 + tid; i < (size_t)(1u << 22); i += (size_t)G * 512) args.out[i] += (i == 0) ? 0.1f * da : 1e-3f * db;
    }
#endif
#undef IN
#undef SEAM
}

#ifndef N_LAUNCH_MODE
#define N_LAUNCH_MODE 0
#endif
extern "C" void kernel_launch(void* const* d_in, const int* in_sizes, int n_in, void* d_out, int out_size, void* d_ws, size_t ws_size, hipStream_t stream) {
    static int grid = 0;
    if (grid == 0) {
        if (n_in != 22 || out_size != MLAT * DM || ws_size < WS_END) { fprintf(stderr, "kernel_launch: unexpected shapes (n_in %d out %d ws %zu)\n", n_in, out_size, ws_size); grid = -1; return; }
        int dev = 0, cus = 0, per_cu = 0;
        if (hipGetDevice(&dev) != hipSuccess || hipDeviceGetAttribute(&cus, hipDeviceAttributeMultiprocessorCount, dev) != hipSuccess) { grid = -1; return; }
        if (hipFuncSetAttribute((const void*)dit_fwd, hipFuncAttributeMaxDynamicSharedMemorySize, LDS_BYTES) != hipSuccess) { fprintf(stderr, "kernel_launch: hipFuncSetAttribute failed\n"); grid = -1; return; }
        if (hipOccupancyMaxActiveBlocksPerMultiprocessor(&per_cu, (const void*)dit_fwd, 512, LDS_BYTES) != hipSuccess || per_cu < 1) { fprintf(stderr, "kernel_launch: occupancy query says %d\n", per_cu); per_cu = 1; }
        (void)hipGetLastError();
        grid = cus;
        if (grid % 8 != 0 || grid < 8) { fprintf(stderr, "kernel_launch: unexpected CU count %d\n", cus); }
    }
    if (grid < 0) return;
    (void)hipMemsetAsync((unsigned char*)d_ws + WS_BAR, 0, 65536, stream);
    Args a{};
    for (int i = 0; i < 22; ++i) a.in[i] = (const float*)d_in[i];
    a.out = (float*)d_out; a.ws = (unsigned char*)d_ws;
#if N_LAUNCH_MODE == 0
    a.ph_lo = 0; a.ph_hi = NPHASE;
    void* kargs[] = {&a};
    hipError_t e = hipLaunchCooperativeKernel((const void*)dit_fwd, dim3(grid), dim3(512), kargs, LDS_BYTES, stream);
    if (e != hipSuccess) fprintf(stderr, "kernel_launch: cooperative launch failed: %s (grid %d)\n", hipGetErrorString(e), grid);
#else
    for (int p = 0; p < NPHASE; ++p) { a.ph_lo = p; a.ph_hi = p + 1; hipLaunchKernelGGL(dit_fwd, dim3(grid), dim3(512), LDS_BYTES, stream, a); }
#endif
}
```

```cpp
#define PRIO_FLIP 2
#define PRIO_FIRST 1
#include <hip/hip_runtime.h>
#include <hip/hip_cooperative_groups.h>
#include <cstdio>
#include <cstdint>
namespace cg = cooperative_groups;

#define LAS __attribute__((address_space(3)))
typedef unsigned short bf16_t;
typedef short bf16x8 __attribute__((ext_vector_type(8)));
typedef float f32x4 __attribute__((ext_vector_type(4)));
typedef float f32x16 __attribute__((ext_vector_type(16)));
typedef unsigned u32x4 __attribute__((ext_vector_type(4)));
typedef unsigned u32x2 __attribute__((ext_vector_type(2)));
typedef float f32x2_t __attribute__((ext_vector_type(2)));
typedef __bf16 bf16x2_t __attribute__((ext_vector_type(2)));
__device__ __forceinline__ unsigned pk_bf16(float lo, float hi) { f32x2_t v = {lo, hi}; bf16x2_t b = __builtin_convertvector(v, bf16x2_t); return __builtin_bit_cast(unsigned, b); }

constexpr int DM = 1024, NBATCH = 8, SEQ = 4096, CTXL = 256, DFF = 4096;
constexpr int MLAT = NBATCH * SEQ;
constexpr int MCTX = NBATCH * CTXL;
constexpr int MTOT = MLAT + MCTX;
constexpr float EPS_F = 1e-6f;
constexpr float LOG2E_F = 1.4426950408889634f;
constexpr float QSCALE = 0.125f * LOG2E_F;
constexpr float LAM_INIT = 0.35550906759096926f;
constexpr int NQK0 = 1280, NV0 = 256, NQK1 = 2048, NV1 = 1024;

namespace pg8 {
#define PG8_LAS __attribute__((address_space(3)))
constexpr int BM = 256, BK = 64, HALF = 128, HTB = HALF * BK * 2  , STAGE_BYTES = 8 * HTB, NXCD = 8, WGM = 8;

__host__ __device__ __forceinline__ int lds_byte(int r, int c) { const int st = (r >> 4) * 2 + (c >> 5), rr = r & 15, cc = c & 31, ob = rr * 64 + cc * 2; return st * 1024 + (ob ^ (((ob >> 9) & 1) << 5)); }
__host__ __device__ __forceinline__ void stage_rc(int b, int& R, int& C) { const int st = b / 1024, sb = b % 1024, swz = sb ^ (((sb >> 9) & 1) << 5); R = (st >> 1) * 16 + swz / 64; C = (st & 1) * 32 + (swz % 64) / 2; }
__host__ __device__ __forceinline__ int perm32(int rho) { const int n = rho >> 4, i = rho & 15; return 8 * (i >> 2) + 4 * n + (i & 3); }

struct Unit { int pm, pn, koff, nt, ord; };
struct Gemm { const bf16_t* A; const bf16_t* Bt; int M, N, K; };

struct StaticOrder {
    int nM, nN, nwg, G, c, ntf;
    __host__ __device__ void init(int M, int N, int G_, int c_, int K_) { nM = M / BM; nN = N / BM; nwg = nM * nN; G = G_; c = c_; ntf = K_ / BK; }
    __host__ __device__ bool next(int i, Unit& u) const {
        const long L = (long)i * G + c; if (L >= nwg) return false;
        int wgid = (int)L; { const int q = nwg / NXCD, r = nwg % NXCD, xcd = wgid % NXCD, off = wgid / NXCD; wgid = (xcd < r ? xcd * (q + 1) : r * (q + 1) + (xcd - r) * q) + off; }
        const int nig = WGM * nN, gid = wgid / nig, fm = gid * WGM, gsz = (nM - fm) < WGM ? (nM - fm) : WGM;
        u.pm = fm + ((wgid % nig) % gsz); u.pn = (wgid % nig) / gsz; u.koff = 0; u.nt = ntf; u.ord = i; return true;
    }
    __device__ __forceinline__ void a_ready(const Unit&) const {}
    __device__ __forceinline__ void done(const Unit&) const {}
};

__device__ __forceinline__ int batch_of_tile(int p) { return p < 128 ? (p >> 4) : 8; }
__device__ __forceinline__ float row_rstd(const float* ss, int row) {
    const f32x4* sp = (const f32x4*)(ss + (size_t)row * 16);
    const f32x4 a = sp[0], b = sp[1], c = sp[2], d = sp[3];
    const f32x4 t = (a + b) + (c + d);
    const float tot = (t[0] + t[1]) + (t[2] + t[3]);
    return rsqrtf(tot * (1.0f / 1024.0f) + EPS_F);
}

__device__ __forceinline__ void rows_rstd8(float (&rsv)[2][4], const float* ss, int row0, int fq) {
    f32x4 a[2][4];
#pragma unroll
    for (int ai = 0; ai < 2; ++ai)
#pragma unroll
        for (int m = 0; m < 4; ++m) a[ai][m] = *(const f32x4*)(ss + (size_t)(row0 + ai * HALF + m * 16) * 16 + 4 * fq);
#pragma unroll
    for (int ai = 0; ai < 2; ++ai)
#pragma unroll
        for (int m = 0; m < 4; ++m) {
            float t = (a[ai][m][0] + a[ai][m][1]) + (a[ai][m][2] + a[ai][m][3]);
            t += __shfl_xor(t, 16); t += __shfl_xor(t, 32);
            rsv[ai][m] = rsqrtf(t * (1.0f / 1024.0f) + EPS_F);
        }
}
constexpr int RSTAB_OFF = 131072 + 256, RSTAB_MAX_UNITS = 15;
template <class Sched, bool BY_PN>
__device__ __forceinline__ void fill_rstd_table(PG8_LAS unsigned char* lds, const Sched& S, const float* ss) {
    PG8_LAS float* tab = (PG8_LAS float*)(lds + RSTAB_OFF);
    const int t = threadIdx.x;
#pragma unroll 4
    for (int i0 = 0; i0 < RSTAB_MAX_UNITS + 1; i0 += 2) {
        Unit u; const int i = i0 + (t >> 8);
        if (i < RSTAB_MAX_UNITS && S.next(i, u)) tab[i * 256 + (t & 255)] = row_rstd(ss, (BY_PN ? u.pn : u.pm) * BM + (t & 255));
    }
    __syncthreads();
}
struct EpiQK {
    static constexpr bool PERM = false, AFTER_DRAIN = false;
    bf16_t* O; int ldc; const float* ss; const float* bias; unsigned ropemask, scalemask; const float* ropetab; PG8_LAS unsigned char* lds_base;
    __device__ __forceinline__ void operator()(const f32x4 (&acc)[2][2][4][2], const Unit& u, int wr, int wc, int fr, int fq) const {
        const int bidx = batch_of_tile(u.pm);
        const int colb = u.pn * BM + wc * 32 + 4 * fq;
        f32x4 bv[2][2];
#pragma unroll
        for (int bj = 0; bj < 2; ++bj)
#pragma unroll
            for (int n = 0; n < 2; ++n) bv[bj][n] = *(const f32x4*)(bias + (size_t)bidx * ldc + colb + bj * HALF + n * 16);
        const PG8_LAS float* rtab = (const PG8_LAS float*)(lds_base + RSTAB_OFF) + u.ord * 256 + wr * 64 + fr;
#pragma unroll
        for (int ai = 0; ai < 2; ++ai) {
#pragma unroll
            for (int m = 0; m < 4; ++m) {
                const int row = u.pm * BM + ai * HALF + wr * 64 + m * 16 + fr;
                const float rs = rtab[ai * HALF + m * 16];
                const bool islat = row < MLAT;
                const int tpos = row & (SEQ - 1);
                const int pos = (wc & 1) ? (tpos & 63) : (tpos >> 6);
                const f32x4* rt = (const f32x4*)(ropetab + (size_t)(pos * 16 + 4 * fq) * 2);
                const f32x4 c0 = rt[0], c1 = rt[1];
                const float cc[4] = {c0[0], c0[2], c1[0], c1[2]}, sn[4] = {c0[1], c0[3], c1[1], c1[3]};
                bf16_t* rowp = O + (size_t)row * ldc + colb;
#pragma unroll
                for (int bj = 0; bj < 2; ++bj) {
                    const int c128 = u.pn * 2 + bj;
                    f32x4 v0 = acc[ai][bj][m][0] * rs + bv[bj][0], v1 = acc[ai][bj][m][1] * rs + bv[bj][1];
                    if (((ropemask >> c128) & 1u) && islat) {
#pragma unroll
                        for (int e = 0; e < 4; ++e) { const float x0 = v0[e], x1 = v1[e]; v0[e] = x0 * cc[e] - x1 * sn[e]; v1[e] = x1 * cc[e] + x0 * sn[e]; }
                    }
                    if ((scalemask >> c128) & 1u) { v0 = v0 * QSCALE; v1 = v1 * QSCALE; }
                    u32x2 w0, w1; w0.x = pk_bf16(v0[0], v0[1]); w0.y = pk_bf16(v0[2], v0[3]); w1.x = pk_bf16(v1[0], v1[1]); w1.y = pk_bf16(v1[2], v1[3]);
                    *(u32x2*)(rowp + bj * HALF) = w0; *(u32x2*)(rowp + bj * HALF + 16) = w1;
                }
            }
        }
    }
};

struct EpiVT {
    static constexpr bool PERM = true, AFTER_DRAIN = false;
    bf16_t* O; int ldc; const float* ss; const float* bias; int NV; PG8_LAS unsigned char* lds_base;
    __device__ __forceinline__ void operator()(const f32x4 (&acc)[2][2][4][2], const Unit& u, int wr, int wc, int fr, int fq) const {
        const int bidx = batch_of_tile(u.pn);
        const int tok0 = u.pn * BM + wc * 32 + 8 * fq;
        float rr[2][8];
        { const PG8_LAS float* rtab = (const PG8_LAS float*)(lds_base + RSTAB_OFF) + u.ord * 256 + wc * 32 + 8 * fq;
#pragma unroll
          for (int bj = 0; bj < 2; ++bj) { const f32x4 a = *(const PG8_LAS f32x4*)(rtab + bj * HALF), b2 = *(const PG8_LAS f32x4*)(rtab + bj * HALF + 4);
              rr[bj][0] = a[0]; rr[bj][1] = a[1]; rr[bj][2] = a[2]; rr[bj][3] = a[3]; rr[bj][4] = b2[0]; rr[bj][5] = b2[1]; rr[bj][6] = b2[2]; rr[bj][7] = b2[3]; } }
        float bb[2][4];
#pragma unroll
        for (int ai = 0; ai < 2; ++ai)
#pragma unroll
            for (int m = 0; m < 4; ++m) bb[ai][m] = bias[(size_t)bidx * NV + u.pm * BM + ai * HALF + wr * 64 + m * 16 + fr];
#pragma unroll
        for (int ai = 0; ai < 2; ++ai)
#pragma unroll
            for (int m = 0; m < 4; ++m) {
                const int nrow = u.pm * BM + ai * HALF + wr * 64 + m * 16 + fr;
                const float b = bb[ai][m];
                bf16_t* rowp = O + (size_t)nrow * ldc + tok0;
#pragma unroll
                for (int bj = 0; bj < 2; ++bj) {
                    const f32x4 a0 = acc[ai][bj][m][0], a1 = acc[ai][bj][m][1];
                    u32x4 w;
                    w.x = pk_bf16(a0[0] * rr[bj][0] + b, a0[1] * rr[bj][1] + b); w.y = pk_bf16(a0[2] * rr[bj][2] + b, a0[3] * rr[bj][3] + b);
                    w.z = pk_bf16(a1[0] * rr[bj][4] + b, a1[1] * rr[bj][5] + b); w.w = pk_bf16(a1[2] * rr[bj][6] + b, a1[3] * rr[bj][7] + b);
                    *(u32x4*)(rowp + bj * HALF) = w;
                }
            }
    }
};

struct EpiUp {
    static constexpr bool PERM = true, AFTER_DRAIN = false;
    bf16_t* O; const float* ss; const float* bias; PG8_LAS unsigned char* lds_base;
    __device__ __forceinline__ void operator()(const f32x4 (&acc)[2][2][4][2], const Unit& u, int wr, int wc, int fr, int fq) const {
        const int bidx = batch_of_tile(u.pm);
        const int colb = u.pn * BM + wc * 32 + 8 * fq;
        f32x4 bv[2][2];
#pragma unroll
        for (int bj = 0; bj < 2; ++bj)
#pragma unroll
            for (int n = 0; n < 2; ++n) bv[bj][n] = *(const f32x4*)(bias + (size_t)bidx * DFF + colb + bj * HALF + 4 * n);
        const PG8_LAS float* rtab = (const PG8_LAS float*)(lds_base + RSTAB_OFF) + u.ord * 256 + wr * 64 + fr;
#pragma unroll
        for (int ai = 0; ai < 2; ++ai)
#pragma unroll
            for (int m = 0; m < 4; ++m) {
                const int row = u.pm * BM + ai * HALF + wr * 64 + m * 16 + fr;
                const float rs = rtab[ai * HALF + m * 16];
                bf16_t* rowp = O + (size_t)row * DFF + colb;
#pragma unroll
                for (int bj = 0; bj < 2; ++bj) {
                    f32x4 v0 = acc[ai][bj][m][0] * rs + bv[bj][0], v1 = acc[ai][bj][m][1] * rs + bv[bj][1];
#pragma unroll
                    for (int e = 0; e < 4; ++e) { const float a = fmaxf(v0[e], 0.f), b = fmaxf(v1[e], 0.f); v0[e] = a * a; v1[e] = b * b; }
                    u32x4 w; w.x = pk_bf16(v0[0], v0[1]); w.y = pk_bf16(v0[2], v0[3]); w.z = pk_bf16(v1[0], v1[1]); w.w = pk_bf16(v1[2], v1[3]);
                    *(u32x4*)(rowp + bj * HALF) = w;
                }
            }
    }
};

__device__ __forceinline__ f32x4 ld_bf4(const bf16_t* p) { const u32x2 w = *(const u32x2*)p; f32x4 v; v[0] = __uint_as_float(w.x << 16); v[1] = __uint_as_float(w.x & 0xffff0000u); v[2] = __uint_as_float(w.y << 16); v[3] = __uint_as_float(w.y & 0xffff0000u); return v; }
template <bool HIN_BF, bool HOUT_BF>
struct EpiResT {
    static constexpr bool PERM = false, AFTER_DRAIN = false;
    const void* hin_lat; const void* hin_ctx; void* hout; bf16_t* xg; float* ss;
    const float* gate; const float* scl; const float* ng;
    __device__ __forceinline__ void operator()(const f32x4 (&acc)[2][2][4][2], const Unit& u, int wr, int wc, int fr, int fq) const {
        const int bidx = batch_of_tile(u.pm);
        const int colb = u.pn * BM + wc * 32 + 4 * fq;
        f32x4 gv[2][2], gp[2][2];
#pragma unroll
        for (int bj = 0; bj < 2; ++bj)
#pragma unroll
            for (int n = 0; n < 2; ++n) {
                const int c = colb + bj * HALF + n * 16;
                gv[bj][n] = *(const f32x4*)(gate + (size_t)bidx * 6144 + c);
                if (xg) { const f32x4 s = *(const f32x4*)(scl + (size_t)bidx * 6144 + c); const f32x4 g = *(const f32x4*)(ng + c); gp[bj][n] = g * (s + 1.0f); }
                else gp[bj][n] = (f32x4){0.f, 0.f, 0.f, 0.f};
            }
#pragma unroll
        for (int ab = 0; ab < 4; ++ab) { const int ai = ab >> 1;
            f32x4 hv[4][2][2];
#pragma unroll
            for (int m = 2 * (ab & 1); m < 2 * (ab & 1) + 2; ++m) {
                const int row = u.pm * BM + ai * HALF + wr * 64 + m * 16 + fr;
                const size_t hoff = (row < MLAT ? (size_t)row : (size_t)(row - MLAT)) * DM + colb;
                const void* hb = row < MLAT ? hin_lat : hin_ctx;
#pragma unroll
                for (int bj = 0; bj < 2; ++bj)
#pragma unroll
                    for (int n = 0; n < 2; ++n) { const int co = bj * HALF + n * 16;
                        if (HIN_BF) hv[m][bj][n] = ld_bf4((const bf16_t*)hb + hoff + co); else hv[m][bj][n] = *(const f32x4*)((const float*)hb + hoff + co); }
            }
#pragma unroll
            for (int m = 2 * (ab & 1); m < 2 * (ab & 1) + 2; ++m) {
                const int row = u.pm * BM + ai * HALF + wr * 64 + m * 16 + fr;
                float ssum = 0.f;
#pragma unroll
                for (int bj = 0; bj < 2; ++bj)
#pragma unroll
                    for (int n = 0; n < 2; ++n) {
                        const int co = bj * HALF + n * 16;
                        const f32x4 v = hv[m][bj][n] + gv[bj][n] * acc[ai][bj][m][n];
                        if (HOUT_BF) { u32x2 w; w.x = pk_bf16(v[0], v[1]); w.y = pk_bf16(v[2], v[3]); *(u32x2*)((bf16_t*)hout + (size_t)row * DM + colb + co) = w; }
                        else *(f32x4*)((float*)hout + (size_t)row * DM + colb + co) = v;
                        ssum += (v[0] * v[0] + v[1] * v[1]) + (v[2] * v[2] + v[3] * v[3]);
                        if (xg) { const f32x4 y = v * gp[bj][n]; u32x2 w; w.x = pk_bf16(y[0], y[1]); w.y = pk_bf16(y[2], y[3]); *(u32x2*)(xg + (size_t)row * DM + colb + co) = w; }
                    }
                ssum += __shfl_xor(ssum, 16); ssum += __shfl_xor(ssum, 32);
                if (fq == 0) ss[(size_t)row * 16 + u.pn * 4 + wc] = ssum;
            }
        }
    }
};
typedef EpiResT<false, false> EpiRes;

struct EpiFinal {
    static constexpr bool PERM = false, AFTER_DRAIN = false;
    const float* hin; float* out; float* ss; const float* gate; const float* fg; unsigned* cnt;
    __device__ __forceinline__ void operator()(f32x4 (&acc)[2][2][4][2], const Unit& u, int wr, int wc, int fr, int fq) const {
        const int bidx = batch_of_tile(u.pm);
        const int colb = u.pn * BM + wc * 32 + 4 * fq;
        f32x4 gv[2][2];
#pragma unroll
        for (int bj = 0; bj < 2; ++bj)
#pragma unroll
            for (int n = 0; n < 2; ++n) gv[bj][n] = *(const f32x4*)(gate + (size_t)bidx * 6144 + colb + bj * HALF + n * 16);
#pragma unroll
        for (int ai = 0; ai < 2; ++ai)
#pragma unroll
            for (int m = 0; m < 4; ++m) {
                const int row = u.pm * BM + ai * HALF + wr * 64 + m * 16 + fr;
                const float* hp = hin + (size_t)row * DM + colb;
                float ssum = 0.f;
#pragma unroll
                for (int bj = 0; bj < 2; ++bj)
#pragma unroll
                    for (int n = 0; n < 2; ++n) {
                        const f32x4 v = *(const f32x4*)(hp + bj * HALF + n * 16) + gv[bj][n] * acc[ai][bj][m][n];
                        acc[ai][bj][m][n] = v;
                        ssum += (v[0] * v[0] + v[1] * v[1]) + (v[2] * v[2] + v[3] * v[3]);
                    }
                ssum += __shfl_xor(ssum, 16); ssum += __shfl_xor(ssum, 32);
                if (fq == 0) __hip_atomic_store(ss + (size_t)row * 16 + u.pn * 4 + wc, ssum, __ATOMIC_RELAXED, __HIP_MEMORY_SCOPE_AGENT);
            }
        asm volatile("s_waitcnt vmcnt(0)" ::: "memory");
        unsigned* cw = cnt + 64 * u.pm;
        if ((threadIdx.x & 63) == 0) __hip_atomic_fetch_add(cw, 1u, __ATOMIC_RELAXED, __HIP_MEMORY_SCOPE_AGENT);
        { const unsigned long long t0 = __builtin_amdgcn_s_memrealtime();
          while ((unsigned)__builtin_amdgcn_readfirstlane(__hip_atomic_load(cw, __ATOMIC_RELAXED, __HIP_MEMORY_SCOPE_AGENT)) < 32u) {
              if (__builtin_amdgcn_s_memrealtime() - t0 > 1000000ull) break;
              __builtin_amdgcn_s_sleep(2); } }
        __builtin_amdgcn_fence(__ATOMIC_ACQUIRE, "agent");
        asm volatile("s_waitcnt vmcnt(0)" ::: "memory");
        f32x4 fv[2][2];
#pragma unroll
        for (int bj = 0; bj < 2; ++bj)
#pragma unroll
            for (int n = 0; n < 2; ++n) fv[bj][n] = *(const f32x4*)(fg + colb + bj * HALF + n * 16);
#pragma unroll
        for (int ai = 0; ai < 2; ++ai)
#pragma unroll
            for (int m = 0; m < 4; ++m) {
                const int row = u.pm * BM + ai * HALF + wr * 64 + m * 16 + fr;
                const float rs = row_rstd(ss, row);
                float* op = out + (size_t)row * DM + colb;
#pragma unroll
                for (int bj = 0; bj < 2; ++bj)
#pragma unroll
                    for (int n = 0; n < 2; ++n) *(f32x4*)(op + bj * HALF + n * 16) = acc[ai][bj][m][n] * rs * fv[bj][n];
            }
    }
};

struct SplitCtxOrder {
    int c, nts;
    __host__ __device__ void init(int c_, int K_) { c = c_; nts = K_ / BK / 8; }
    __host__ __device__ bool next(int i, Unit& u) const {
        if (i != 0) return false;
        const int ti = c >> 3, ks = c & 7;
        u.pm = 128 + (ti >> 2); u.pn = ti & 3; u.nt = nts; u.koff = ks * nts * BK; u.ord = 0; return true;
    }
    __device__ __forceinline__ void a_ready(const Unit&) const {}
    __device__ __forceinline__ void done(const Unit&) const {}
};
struct EpiSlab {
    static constexpr bool PERM = false, AFTER_DRAIN = false;
    float* slab_lo; float* slab_hi;
    __device__ __forceinline__ void operator()(const f32x4 (&acc)[2][2][4][2], const Unit& u, int wr, int wc, int fr, int fq) const {
        const int ks = u.koff / (u.nt * BK);
        float* sl = (ks < 6 ? slab_lo + (size_t)ks * MCTX * DM : slab_hi + (size_t)(ks - 6) * MCTX * DM);
        const int colb = u.pn * BM + wc * 32 + 4 * fq;
#pragma unroll
        for (int ai = 0; ai < 2; ++ai)
#pragma unroll
            for (int m = 0; m < 4; ++m) {
                const int row = (u.pm - 128) * BM + ai * HALF + wr * 64 + m * 16 + fr;
                float* op = sl + (size_t)row * DM + colb;
#pragma unroll
                for (int bj = 0; bj < 2; ++bj)
#pragma unroll
                    for (int n = 0; n < 2; ++n) *(f32x4*)(op + bj * HALF + n * 16) = acc[ai][bj][m][n];
            }
    }
};

template <class Epi, class Sched, bool ALIGN_EPI = false, bool SP2 = false>
__device__ __forceinline__ void gemm_phase(PG8_LAS unsigned char* lds, const Gemm g, const Sched& S, const Epi& E) {
    const int tid = threadIdx.x, wid = __builtin_amdgcn_readfirstlane(tid >> 6), lane = tid & 63, wr = wid >> 2, wc = wid & 3, fr = lane & 15, fq = lane >> 4;
    const int K = g.K;
    unsigned voffA[2], voffB[2];
#pragma unroll
    for (int i = 0; i < 2; ++i) { int R, C; stage_rc(tid * 16 + i * 8192, R, C); const int Rb = Epi::PERM ? ((R & ~31) + perm32(R & 31)) : R;
        voffA[i] = (unsigned)(R * K + C) * 2u; voffB[i] = (unsigned)(Rb * K + C) * 2u; }
    const size_t kstep = (size_t)(BK * 2);
    const size_t hstep = (size_t)HALF * K * 2;
    const size_t tstep = 2 * hstep;
    const unsigned ldsw = (unsigned)wid * 1024u;
    const int aoff = lds_byte(wr * 64 + fr, fq * 8), boff = lds_byte(wc * 32 + fr, fq * 8);
#define PG8_SA(b, h) (((b) * 2 + (h)) * HTB)
#define PG8_SB(b, h) ((4 + (b) * 2 + (h)) * HTB)
#define PG8_STAGE(bufoff, gbase, voff) do { _Pragma("unroll") for (int _i = 0; _i < 2; ++_i) \
        __builtin_amdgcn_global_load_lds((const unsigned*)((const char*)(gbase) + (voff)[_i]), (PG8_LAS unsigned*)(lds + (bufoff) + ldsw + _i * 8192), 16, 0, 0); } while (0)
#define PG8_LDA(dst, b, h) do { _Pragma("unroll") for (int m = 0; m < 4; ++m) _Pragma("unroll") for (int k = 0; k < 2; ++k) dst[m][k] = *(const PG8_LAS bf16x8*)(lds + PG8_SA(b, h) + aoff + m * 2048 + k * 1024); } while (0)
#define PG8_LDB(dst, b, h) do { _Pragma("unroll") for (int n = 0; n < 2; ++n) _Pragma("unroll") for (int k = 0; k < 2; ++k) dst[n][k] = *(const PG8_LAS bf16x8*)(lds + PG8_SB(b, h) + boff + n * 2048 + k * 1024); } while (0)
#define PG8_MMA(ai, bj, At, Bt) do { __builtin_amdgcn_s_setprio(1); _Pragma("unroll") for (int m = 0; m < 4; ++m) _Pragma("unroll") for (int n = 0; n < 2; ++n) _Pragma("unroll") for (int k = 0; k < 2; ++k) \
        acc[ai][bj][m][n] = __builtin_amdgcn_mfma_f32_16x16x32_bf16(Bt[n][k], At[m][k], acc[ai][bj][m][n], 0, 0, 0); __builtin_amdgcn_s_setprio(0); } while (0)
#define PG8_WAIT_V(n) asm volatile("s_waitcnt vmcnt(" #n ")" ::: "memory")
#define PG8_WAIT_L(n) asm volatile("s_waitcnt lgkmcnt(" #n ")" ::: "memory")
#define PG8_BAR __builtin_amdgcn_s_barrier()
#define PG8_SCHED __builtin_amdgcn_sched_barrier(0)
    Unit cur, nxt; int ui = 0;
    if (!S.next(0, cur)) return;
    f32x4 acc[2][2][4][2];
#pragma unroll
    for (int a = 0; a < 2; ++a)
#pragma unroll
        for (int b = 0; b < 2; ++b)
#pragma unroll
            for (int m = 0; m < 4; ++m)
#pragma unroll
                for (int n = 0; n < 2; ++n) acc[a][b][m][n] = (f32x4){0.f, 0.f, 0.f, 0.f};
    bf16x8 At[4][2], B0[2][2], B1[2][2];
    const char* cA = (const char*)g.A + (size_t)cur.pm * tstep + (size_t)cur.koff * 2; const char* cB = (const char*)g.Bt + (size_t)cur.pn * tstep + (size_t)cur.koff * 2;
    S.a_ready(cur);
    if constexpr (SP2) {
        PG8_STAGE(PG8_SB(0, 0), cB, voffB); PG8_STAGE(PG8_SB(0, 1), cB + hstep, voffB); PG8_STAGE(PG8_SA(0, 0), cA, voffA); PG8_STAGE(PG8_SA(0, 1), cA + hstep, voffA);
        if (wr == 1) PG8_BAR;
        PG8_WAIT_V(2); PG8_BAR;
        PG8_STAGE(PG8_SB(1, 0), cB + kstep, voffB); PG8_STAGE(PG8_SA(1, 0), cA + kstep, voffA); PG8_STAGE(PG8_SB(1, 1), cB + hstep + kstep, voffB);
        PG8_WAIT_V(6); PG8_BAR;
    } else {
        PG8_STAGE(PG8_SB(0, 0), cB, voffB); PG8_STAGE(PG8_SA(0, 0), cA, voffA); PG8_STAGE(PG8_SB(0, 1), cB + hstep, voffB); PG8_STAGE(PG8_SA(0, 1), cA + hstep, voffA);
        if (wr == 1) PG8_BAR;
        PG8_WAIT_V(4); PG8_BAR;
        PG8_STAGE(PG8_SB(1, 0), cB + kstep, voffB); PG8_STAGE(PG8_SA(1, 0), cA + kstep, voffA); PG8_STAGE(PG8_SB(1, 1), cB + hstep + kstep, voffB);
        PG8_WAIT_V(6); PG8_BAR;
    }
    for (;;) {
        const bool has_next = S.next(ui + 1, nxt);
        const char* nA = has_next ? (const char*)g.A + (size_t)nxt.pm * tstep + (size_t)nxt.koff * 2 : cA; const char* nB = has_next ? (const char*)g.Bt + (size_t)nxt.pn * tstep + (size_t)nxt.koff * 2 : cB;
        const int nt = cur.nt;
        for (int t = 0; t < nt; t += 2) {
            const bool last = (t == nt - 2);
            const char* a1 = cA + (size_t)(t + 1) * kstep;
            const char* a2 = last ? nA : cA + (size_t)(t + 2) * kstep; const char* b2 = last ? nB : cB + (size_t)(t + 2) * kstep;
            const char* a3 = a2 + kstep; const char* b3 = b2 + kstep;
            if (last && has_next) S.a_ready(nxt);
            if constexpr (SP2) {
            PG8_LDB(B0, 0, 0); PG8_LDB(B1, 0, 1); PG8_SCHED; PG8_LDA(At, 0, 0); PG8_STAGE(PG8_SA(1, 1), a1 + hstep, voffA);
            PG8_WAIT_V(8); PG8_WAIT_L(0); PG8_BAR; PG8_MMA(0, 0, At, B0); PG8_MMA(0, 1, At, B1); PG8_BAR; PG8_SCHED;
            PG8_LDA(At, 0, 1); PG8_STAGE(PG8_SB(0, 0), b2, voffB); PG8_STAGE(PG8_SB(0, 1), b2 + hstep, voffB); PG8_STAGE(PG8_SA(0, 0), a2, voffA);
            PG8_WAIT_V(8); PG8_WAIT_L(0); PG8_BAR; PG8_MMA(1, 0, At, B0); PG8_MMA(1, 1, At, B1); PG8_BAR; PG8_SCHED;
            PG8_LDB(B0, 1, 0); PG8_LDB(B1, 1, 1); PG8_SCHED; PG8_LDA(At, 1, 0); PG8_STAGE(PG8_SA(0, 1), a2 + hstep, voffA);
            PG8_WAIT_V(8); PG8_WAIT_L(0); PG8_BAR; PG8_MMA(0, 0, At, B0); PG8_MMA(0, 1, At, B1); PG8_BAR; PG8_SCHED;
            PG8_LDA(At, 1, 1); PG8_STAGE(PG8_SB(1, 0), b3, voffB); PG8_STAGE(PG8_SB(1, 1), b3 + hstep, voffB); PG8_STAGE(PG8_SA(1, 0), a3, voffA);
            PG8_WAIT_V(8); PG8_WAIT_L(0); PG8_BAR; PG8_MMA(1, 0, At, B0); PG8_MMA(1, 1, At, B1); PG8_BAR; PG8_SCHED;
            } else {
            PG8_LDB(B0, 0, 0); PG8_SCHED; PG8_LDA(At, 0, 0); PG8_STAGE(PG8_SA(1, 1), a1 + hstep, voffA);
            PG8_WAIT_L(8); PG8_BAR; PG8_WAIT_L(0); PG8_MMA(0, 0, At, B0); PG8_BAR; PG8_SCHED;
            PG8_LDB(B1, 0, 1); PG8_STAGE(PG8_SB(0, 0), b2, voffB);
            PG8_BAR; PG8_WAIT_L(0); PG8_MMA(0, 1, At, B1); PG8_BAR;
            PG8_LDA(At, 0, 1); PG8_STAGE(PG8_SA(0, 0), a2, voffA);
            PG8_BAR; PG8_WAIT_L(0); PG8_MMA(1, 0, At, B0); PG8_BAR; PG8_SCHED;
            PG8_STAGE(PG8_SB(0, 1), b2 + hstep, voffB);
            PG8_WAIT_V(6); PG8_BAR; PG8_MMA(1, 1, At, B1); PG8_BAR;
            PG8_LDB(B0, 1, 0); PG8_SCHED; PG8_LDA(At, 1, 0); PG8_STAGE(PG8_SA(0, 1), a2 + hstep, voffA);
            PG8_WAIT_L(8); PG8_BAR; PG8_WAIT_L(0); PG8_MMA(0, 0, At, B0); PG8_BAR; PG8_SCHED;
            PG8_LDB(B1, 1, 1); PG8_STAGE(PG8_SB(1, 0), b3, voffB);
            PG8_BAR; PG8_WAIT_L(0); PG8_MMA(0, 1, At, B1); PG8_BAR;
            PG8_LDA(At, 1, 1); PG8_STAGE(PG8_SA(1, 0), a3, voffA);
            PG8_BAR; PG8_WAIT_L(0); PG8_MMA(1, 0, At, B0); PG8_BAR; PG8_SCHED;
            PG8_STAGE(PG8_SB(1, 1), b3 + hstep, voffB);
            PG8_WAIT_V(6); PG8_BAR; PG8_MMA(1, 1, At, B1); PG8_BAR;
            }
        }
        if constexpr (ALIGN_EPI) { if (wr == 0) PG8_BAR; }
        if constexpr (!Epi::AFTER_DRAIN) { E(acc, cur, wr, wc, fr, fq); S.done(cur); }
        if (!has_next) break;
#pragma unroll
        for (int a = 0; a < 2; ++a)
#pragma unroll
            for (int b = 0; b < 2; ++b)
#pragma unroll
                for (int m = 0; m < 4; ++m)
#pragma unroll
                    for (int n = 0; n < 2; ++n) acc[a][b][m][n] = (f32x4){0.f, 0.f, 0.f, 0.f};
        cur = nxt; cA = nA; cB = nB; ++ui;
        if constexpr (ALIGN_EPI) { if (wr == 1) PG8_BAR; }
    }
    PG8_WAIT_V(0);
    if constexpr (!ALIGN_EPI) { if (wr == 0) PG8_BAR; }
    PG8_BAR;
    if constexpr (Epi::AFTER_DRAIN) { E.fused(acc, cur, wr, wc, fr, fq, lds, wid, lane); S.done(cur); }
#undef PG8_SA
#undef PG8_SB
#undef PG8_STAGE
#undef PG8_LDA
#undef PG8_LDB
#undef PG8_MMA
#undef PG8_WAIT_V
#undef PG8_WAIT_L
#undef PG8_BAR
#undef PG8_SCHED
}
}

namespace att {
#define MFMA32(a, b, c) __builtin_amdgcn_mfma_f32_32x32x16_bf16((a), (b), (c), 0, 0, 0)
__device__ __forceinline__ int koff(int r, int h) { return 16 * (r >> 3) + 8 * h + (r & 7); }
__device__ __forceinline__ int crow(int r, int h) { return (r & 3) + 8 * (r >> 2) + 4 * h; }
__device__ __forceinline__ float ex2(float x) { return __builtin_amdgcn_exp2f(x); }
__device__ __forceinline__ float wave_sum(float v) {
#pragma unroll
    for (int o = 1; o < 64; o <<= 1) v += __shfl_xor(v, o);
    return v;
}

__device__ __forceinline__ void qk_tile(f32x16 (&s)[2], const LAS unsigned char* Kt, const bf16x8 (&qf)[4], int pi, int h) {
    const int sw = (pi >> 1) & 7;
#pragma unroll
    for (int kb = 0; kb < 2; ++kb) {
        f32x16 a = {};
#pragma unroll
        for (int d0 = 0; d0 < 4; ++d0) {
            const bf16x8 kf = *(const LAS bf16x8*)(Kt + (32 * kb + pi) * 128 + (((2 * d0 + h) ^ sw) << 4));
            a = MFMA32(kf, qf[d0], a);
        }
        s[kb] = a;
    }
}
template <int DVB>
__device__ __forceinline__ void softmax_pv(f32x16 (&s)[2], const LAS unsigned char* VTt, f32x16 (&oT)[DVB], float& m_run, float& l_run, int i31, int h) {
    float mx = s[0][0];
#pragma unroll
    for (int r = 1; r < 16; ++r) mx = fmaxf(mx, s[0][r]);
#pragma unroll
    for (int r = 0; r < 16; ++r) mx = fmaxf(mx, s[1][r]);
    mx = fmaxf(mx, __shfl_xor(mx, 32));
    if (__any(mx > m_run)) {
        const float mn = fmaxf(m_run, mx); const float alpha = ex2(m_run - mn); m_run = mn; l_run *= alpha;
#pragma unroll
        for (int db = 0; db < DVB; ++db)
#pragma unroll
            for (int r = 0; r < 16; ++r) oT[db][r] *= alpha;
    }
    float ps = 0.f;
#pragma unroll
    for (int kb = 0; kb < 2; ++kb)
#pragma unroll
        for (int r = 0; r < 16; ++r) { const float p = ex2(s[kb][r] - m_run); s[kb][r] = p; ps += p; }
    l_run += ps;
    const int sw = (i31 >> 1) & 7;
#pragma unroll
    for (int kb = 0; kb < 2; ++kb)
#pragma unroll
        for (int st = 0; st < 2; ++st) {
            u32x4 pw;
            pw.x = pk_bf16(s[kb][8 * st + 0], s[kb][8 * st + 1]); pw.y = pk_bf16(s[kb][8 * st + 2], s[kb][8 * st + 3]);
            pw.z = pk_bf16(s[kb][8 * st + 4], s[kb][8 * st + 5]); pw.w = pk_bf16(s[kb][8 * st + 6], s[kb][8 * st + 7]);
            const bf16x8 pb = __builtin_bit_cast(bf16x8, pw);
#pragma unroll
            for (int db = 0; db < DVB; ++db) {
                const bf16x8 vf = *(const LAS bf16x8*)(VTt + (32 * db + i31) * 128 + (((4 * kb + 2 * st + h) ^ sw) << 4));
                oT[db] = MFMA32(vf, pb, oT[db]);
            }
        }
}


#ifndef THR2V
#define THR2V 6.0f
#endif
constexpr float THR2 = THR2V;
__device__ __forceinline__ void qk_tile2(f32x16 (&s)[2], const LAS unsigned char* Kt, const bf16x8 (&qf)[4], const f32x16& negm, int pi, int h) {
    const int sw = (pi >> 1) & 7;
#pragma unroll
    for (int kb = 0; kb < 2; ++kb) {
        f32x16 a = negm;
#pragma unroll
        for (int d0 = 0; d0 < 4; ++d0) {
            const bf16x8 kf = *(const LAS bf16x8*)(Kt + (32 * kb + pi) * 128 + (((2 * d0 + h) ^ sw) << 4));
            a = MFMA32(kf, qf[d0], a);
        }
        s[kb] = a;
    }
}
template <int DVB>
__device__ __forceinline__ void softmax_pv2(f32x16 (&s)[2], const LAS unsigned char* VTt, f32x16 (&oT)[DVB], f32x16& negm, float& m_run, float& l_run, bool first, int i31, int h) {
    float mx = fmaxf(fmaxf(s[0][0], s[0][1]), s[0][2]);
#pragma unroll
    for (int r = 3; r < 15; r += 2) mx = fmaxf(fmaxf(mx, s[0][r]), s[0][r + 1]);
    mx = fmaxf(mx, s[0][15]);
#pragma unroll
    for (int r = 0; r < 16; r += 2) mx = fmaxf(fmaxf(mx, s[1][r]), s[1][r + 1]);
    if (first || __any(mx > THR2)) {
        mx = fmaxf(mx, __shfl_xor(mx, 32));
        float delta = first ? mx : fmaxf(mx, 0.f);
        if (delta == -INFINITY) delta = 0.f;
        const float alpha = first ? 1.0f : ex2(-delta);
        m_run += delta; l_run *= alpha;
#pragma unroll
        for (int db = 0; db < DVB; ++db)
#pragma unroll
            for (int r = 0; r < 16; ++r) oT[db][r] *= alpha;
#pragma unroll
        for (int kb = 0; kb < 2; ++kb)
#pragma unroll
            for (int r = 0; r < 16; ++r) s[kb][r] -= delta;
        const float nm = -m_run;
#pragma unroll
        for (int r = 0; r < 16; ++r) negm[r] = nm;
    }
    float ps = 0.f;
#pragma unroll
    for (int kb = 0; kb < 2; ++kb)
#pragma unroll
        for (int r = 0; r < 16; ++r) { const float p = ex2(s[kb][r]); s[kb][r] = p; ps += p; }
    l_run += ps;
    const int sw = (i31 >> 1) & 7;
#pragma unroll
    for (int kb = 0; kb < 2; ++kb)
#pragma unroll
        for (int st = 0; st < 2; ++st) {
            u32x4 pw;
            pw.x = pk_bf16(s[kb][8 * st + 0], s[kb][8 * st + 1]); pw.y = pk_bf16(s[kb][8 * st + 2], s[kb][8 * st + 3]);
            pw.z = pk_bf16(s[kb][8 * st + 4], s[kb][8 * st + 5]); pw.w = pk_bf16(s[kb][8 * st + 6], s[kb][8 * st + 7]);
            const bf16x8 pb = __builtin_bit_cast(bf16x8, pw);
#pragma unroll
            for (int db = 0; db < DVB; ++db) {
                const bf16x8 vf = *(const LAS bf16x8*)(VTt + (32 * db + i31) * 128 + (((4 * kb + 2 * st + h) ^ sw) << 4));
                oT[db] = MFMA32(vf, pb, oT[db]);
            }
        }
}


#define ATT_SB() do {} while (0)
#ifdef ATT_PRIO
#define ATT_P1() __builtin_amdgcn_s_setprio(1)
#define ATT_P0() __builtin_amdgcn_s_setprio(0)
#else
#define ATT_P1() do {} while (0)
#define ATT_P0() do {} while (0)
#endif
__device__ __forceinline__ bf16x8 exp_pack8(f32x16& sv, const int st, float& ps) {
    float p[8];
#pragma unroll
    for (int j = 0; j < 8; ++j) { p[j] = ex2(sv[8 * st + j]); }
    ps += ((p[0] + p[1]) + (p[2] + p[3])) + ((p[4] + p[5]) + (p[6] + p[7]));
    u32x4 pw; pw.x = pk_bf16(p[0], p[1]); pw.y = pk_bf16(p[2], p[3]); pw.z = pk_bf16(p[4], p[5]); pw.w = pk_bf16(p[6], p[7]);
    return __builtin_bit_cast(bf16x8, pw);
}
struct NoMask { __device__ __forceinline__ void operator()(f32x16&, f32x16&) const {} };
template <int DVB, class MF = NoMask>
__device__ __forceinline__ void tile_compute(const LAS unsigned char* Kt, const LAS unsigned char* VTt, const bf16x8 (&qf)[4], f32x16 (&oT)[DVB], f32x16& negm,
                                             float& m_run, float& l_run, bool first, int pi, int i31, int h, const MF mf = MF()) {
#ifdef IGLP_ID
    __builtin_amdgcn_iglp_opt(IGLP_ID);
#endif
    const int swk = (pi >> 1) & 7, swv = (i31 >> 1) & 7;
    bf16x8 kf[8];
#pragma unroll
    for (int kb = 0; kb < 2; ++kb)
#pragma unroll
        for (int d0 = 0; d0 < 4; ++d0) kf[kb * 4 + d0] = *(const LAS bf16x8*)(Kt + (32 * kb + pi) * 128 + (((2 * d0 + h) ^ swk) << 4));
    ATT_SB();
    f32x16 s0 = negm, s1 = negm;
    bf16x8 vf[4][DVB];
#pragma unroll
    for (int d0 = 0; d0 < 4; ++d0) { s0 = MFMA32(kf[d0], qf[d0], s0); s1 = MFMA32(kf[4 + d0], qf[d0], s1); }
#pragma unroll
    for (int j = 0; j < 2; ++j)
#pragma unroll
        for (int db = 0; db < DVB; ++db) vf[j][db] = *(const LAS bf16x8*)(VTt + (32 * db + i31) * 128 + (((2 * j + h) ^ swv) << 4));
    ATT_SB();
    mf(s0, s1);
    float mx = fmaxf(fmaxf(s0[0], s0[1]), s0[2]);
#pragma unroll
    for (int r = 3; r < 15; r += 2) mx = fmaxf(fmaxf(mx, s0[r]), s0[r + 1]);
    mx = fmaxf(mx, s0[15]);
#pragma unroll
    for (int r = 0; r < 16; r += 2) mx = fmaxf(fmaxf(mx, s1[r]), s1[r + 1]);
    if (first || __any(mx > THR2)) {
        mx = fmaxf(mx, __shfl_xor(mx, 32));
        float delta = first ? mx : fmaxf(mx, 0.f);
        if (delta == -INFINITY) delta = 0.f;
        const float alpha = first ? 1.0f : ex2(-delta);
        m_run += delta; l_run *= alpha;
#pragma unroll
        for (int db = 0; db < DVB; ++db)
#pragma unroll
            for (int r = 0; r < 16; ++r) oT[db][r] *= alpha;
#pragma unroll
        for (int r = 0; r < 16; ++r) { s0[r] -= delta; s1[r] -= delta; }
        const float nm = -m_run;
#pragma unroll
        for (int r = 0; r < 16; ++r) negm[r] = nm;
    }
    ATT_SB();
    float ps = 0.f;
    bf16x8 pb0 = exp_pack8(s0, 0, ps);
#pragma unroll
    for (int j = 2; j < 4; ++j)
#pragma unroll
        for (int db = 0; db < DVB; ++db) vf[j][db] = *(const LAS bf16x8*)(VTt + (32 * db + i31) * 128 + (((2 * j + h) ^ swv) << 4));
    ATT_SB();
#pragma unroll
    for (int db = 0; db < DVB; ++db) { ATT_P1(); oT[db] = MFMA32(vf[0][db], pb0, oT[db]); ATT_P0(); }
    bf16x8 pb1 = exp_pack8(s0, 1, ps);
    ATT_SB();
#pragma unroll
    for (int db = 0; db < DVB; ++db) { ATT_P1(); oT[db] = MFMA32(vf[1][db], pb1, oT[db]); ATT_P0(); }
    bf16x8 pb2 = exp_pack8(s1, 0, ps);
    ATT_SB();
#pragma unroll
    for (int db = 0; db < DVB; ++db) { ATT_P1(); oT[db] = MFMA32(vf[2][db], pb2, oT[db]); ATT_P0(); }
    bf16x8 pb3 = exp_pack8(s1, 1, ps);
    ATT_SB();
#pragma unroll
    for (int db = 0; db < DVB; ++db) { ATT_P1(); oT[db] = MFMA32(vf[3][db], pb3, oT[db]); ATT_P0(); }
    l_run += ps;
    ATT_SB();
}


template <int DVB>
__device__ __forceinline__ void tile_compute128(const LAS unsigned char* KtA, const LAS unsigned char* VTtA, const LAS unsigned char* KtB, const LAS unsigned char* VTtB, const bf16x8 (&qf)[4],
                                                f32x16 (&oT)[DVB], f32x16& negm, float& m_run, float& l_run, bool first, int pi, int i31, int h, bool young = false) {
    const int swk = (pi >> 1) & 7, swv = (i31 >> 1) & 7;
#ifdef PRIO_FLIP
    if (young) __builtin_amdgcn_s_setprio(PRIO_FIRST);
#endif
    f32x16 a0 = negm, a1 = negm, b0 = negm, b1 = negm;
    {
        bf16x8 kf[8];
#pragma unroll
        for (int kb = 0; kb < 2; ++kb)
#pragma unroll
            for (int d0 = 0; d0 < 4; ++d0) kf[kb * 4 + d0] = *(const LAS bf16x8*)(KtA + (32 * kb + pi) * 128 + (((2 * d0 + h) ^ swk) << 4));
#pragma unroll
        for (int d0 = 0; d0 < 4; ++d0) { a0 = MFMA32(kf[d0], qf[d0], a0); a1 = MFMA32(kf[4 + d0], qf[d0], a1); }
    }
    {
        bf16x8 kf[8];
#pragma unroll
        for (int kb = 0; kb < 2; ++kb)
#pragma unroll
            for (int d0 = 0; d0 < 4; ++d0) kf[kb * 4 + d0] = *(const LAS bf16x8*)(KtB + (32 * kb + pi) * 128 + (((2 * d0 + h) ^ swk) << 4));
#pragma unroll
        for (int d0 = 0; d0 < 4; ++d0) { b0 = MFMA32(kf[d0], qf[d0], b0); b1 = MFMA32(kf[4 + d0], qf[d0], b1); }
    }
    float mx = fmaxf(fmaxf(a0[0], a0[1]), a0[2]), my = fmaxf(fmaxf(b0[0], b0[1]), b0[2]);
#pragma unroll
    for (int r = 3; r < 15; r += 2) { mx = fmaxf(fmaxf(mx, a0[r]), a0[r + 1]); my = fmaxf(fmaxf(my, b0[r]), b0[r + 1]); }
    mx = fmaxf(mx, a0[15]); my = fmaxf(my, b0[15]);
#pragma unroll
    for (int r = 0; r < 16; r += 2) { mx = fmaxf(fmaxf(mx, a1[r]), a1[r + 1]); my = fmaxf(fmaxf(my, b1[r]), b1[r + 1]); }
    mx = fmaxf(mx, my);
    if (first || __any(mx > THR2)) {
        mx = fmaxf(mx, __shfl_xor(mx, 32));
        float delta = first ? mx : fmaxf(mx, 0.f);
        if (delta == -INFINITY) delta = 0.f;
        const float alpha = first ? 1.0f : ex2(-delta);
        m_run += delta; l_run *= alpha;
#pragma unroll
        for (int db = 0; db < DVB; ++db)
#pragma unroll
            for (int r = 0; r < 16; ++r) oT[db][r] *= alpha;
#pragma unroll
        for (int r = 0; r < 16; ++r) { a0[r] -= delta; a1[r] -= delta; b0[r] -= delta; b1[r] -= delta; }
        const float nm = -m_run;
#pragma unroll
        for (int r = 0; r < 16; ++r) negm[r] = nm;
    }
    float ps = 0.f;
#if defined(PRIO_FLIP) && PRIO_FLIP == 1
    if (young) __builtin_amdgcn_s_setprio(1 - PRIO_FIRST);
#endif
    {
#pragma unroll
        for (int jp = 0; jp < 2; ++jp) {
            bf16x8 vf[2][DVB];
#pragma unroll
            for (int j = 0; j < 2; ++j)
#pragma unroll
                for (int db = 0; db < DVB; ++db) vf[j][db] = *(const LAS bf16x8*)(VTtA + (32 * db + i31) * 128 + (((2 * (2 * jp + j) + h) ^ swv) << 4));
            const bf16x8 p0 = exp_pack8(jp == 0 ? a0 : a1, 0, ps), p1 = exp_pack8(jp == 0 ? a0 : a1, 1, ps);
#pragma unroll
            for (int db = 0; db < DVB; ++db) oT[db] = MFMA32(vf[0][db], p0, oT[db]);
#pragma unroll
            for (int db = 0; db < DVB; ++db) oT[db] = MFMA32(vf[1][db], p1, oT[db]);
        }
    }
#if defined(PRIO_FLIP) && PRIO_FLIP == 2
    if (young) __builtin_amdgcn_s_setprio(1 - PRIO_FIRST);
#endif
    {
#pragma unroll
        for (int jp = 0; jp < 2; ++jp) {
            bf16x8 vf[2][DVB];
#pragma unroll
            for (int j = 0; j < 2; ++j)
#pragma unroll
                for (int db = 0; db < DVB; ++db) vf[j][db] = *(const LAS bf16x8*)(VTtB + (32 * db + i31) * 128 + (((2 * (2 * jp + j) + h) ^ swv) << 4));
            const bf16x8 p0 = exp_pack8(jp == 0 ? b0 : b1, 0, ps), p1 = exp_pack8(jp == 0 ? b0 : b1, 1, ps);
#pragma unroll
            for (int db = 0; db < DVB; ++db) oT[db] = MFMA32(vf[0][db], p0, oT[db]);
#pragma unroll
            for (int db = 0; db < DVB; ++db) oT[db] = MFMA32(vf[1][db], p1, oT[db]);
        }
    }
    l_run += ps;
}

constexpr int L0_UNITS = 2176;
constexpr int L0_BUF = 16384;
constexpr int L0_RPB_OFF = 98304;
struct L0Args { const bf16_t* QK; const bf16_t* VT; bf16_t* Y; const float* sink; const float* rpb; };
#define L0_WAIT_BAR(N) asm volatile("s_waitcnt vmcnt(" #N ") lgkmcnt(0)\n\ts_barrier" ::: "memory")
struct L0Mask {
    int mode; const LAS float* tab; int vb; int dq;
    __device__ __forceinline__ void operator()(f32x16& s0, f32x16& s1) const {
        if (mode == 1) {
#pragma unroll
            for (int r = 0; r < 16; ++r) {
                const int kc0 = 16 * (r >> 3) + (r & 7), kc1 = 32 + kc0;
                const float b0 = tab[kc0], b1 = tab[kc1];
                s0[r] = ((unsigned)(kc0 + vb) < 16u) ? s0[r] + b0 : -INFINITY;
                s1[r] = ((unsigned)(kc1 + vb) < 16u) ? s1[r] + b1 : -INFINITY;
            }
        } else if (mode == 2) {
#pragma unroll
            for (int r = 0; r < 16; ++r) {
                const int kc0 = 16 * (r >> 3) + (r & 7), kc1 = 32 + kc0;
                const int d0 = dq - kc0, d1 = dq - kc1;
                if (d0 > 128 || d0 < -128) s0[r] = -INFINITY;
                if (d1 > 128 || d1 < -128) s1[r] = -INFINITY;
            }
        }
    }
};

struct L0Unit { int mode, b, qx, isB, lat0, nlat, nt, qtok0, hq, qcol, kcol, vrow; };
__device__ __forceinline__ L0Unit l0_decode(int u, int g) {
    L0Unit d; int kvh;
    if (u < 1024) { d.mode = 0; d.b = u >> 7; kvh = (u >> 6) & 1; d.qx = u & 63; d.isB = 1; }
    else if (u < 2048) { const int v = u - 1024; d.mode = 1; d.b = v >> 7; kvh = (v >> 6) & 1; d.qx = v & 63; d.isB = 0; }
    else { const int v = u - 2048; d.mode = 2; d.b = v >> 4; kvh = (v >> 2) & 1; d.isB = (v >> 3) & 1; d.qx = v & 3; }
    d.lat0 = 0; d.nlat = 0;
    if (d.mode == 0) { d.lat0 = min(max(d.qx - 4, 0), 56); d.nlat = 8; d.qtok0 = d.b * SEQ + 64 * d.qx; }
    else if (d.mode == 1) { d.lat0 = max(d.qx - 2, 0); d.nlat = min(d.qx + 2, 63) - d.lat0 + 1; d.qtok0 = d.b * SEQ + 64 * d.qx; }
    else { d.qtok0 = MLAT + d.b * CTXL + 64 * d.qx; }
    d.nt = d.nlat + 4;
    d.hq = 4 * kvh + g;
    d.qcol = d.isB * 512 + d.hq * 64; d.kcol = (d.isB ? 1152 : 1024) + 64 * kvh; d.vrow = d.isB * 128 + 64 * kvh;
    return d;
}
constexpr int L0_NSLOT = 6, L0_AHEAD = 4;
constexpr int L0_Q_OFF = L0_NSLOT * L0_BUF;
constexpr int L0_RPB2_OFF = 131072 + 256;
__device__ __forceinline__ void attn_l0_phase(LAS unsigned char* lds, const L0Args P, int bid, int G, int tid) {
    const int lane = tid & 63, wid = __builtin_amdgcn_readfirstlane(tid >> 6), i31 = lane & 31, h = lane >> 5;
    const int pi = (i31 & 0x13) | ((i31 & 4) << 1) | ((i31 & 8) >> 1);
    const int g = wid >> 1, jh = wid & 1;
    LAS float* rpbl = (LAS float*)(lds + L0_RPB2_OFF);
    for (int i = tid; i < 8 * 15 * 31; i += 512) rpbl[i] = P.rpb[i] * LOG2E_F;
    __syncthreads();
    int goff[2];
#pragma unroll
    for (int i = 0; i < 2; ++i) {
        const int p = 2 * wid + i, rl = lane >> 3, sl = lane & 7;
        if (wid < 4) { const int kr = 8 * p + rl, c = sl ^ ((kr >> 1) & 7); goff[i] = kr * NQK0 + c * 8; }
        else { const int e = 8 * (p - 8) + rl, c = sl ^ ((e >> 1) & 7); goff[i] = e * MTOT + c * 8; }
    }
    int qoff[4];
#pragma unroll
    for (int p = 0; p < 4; ++p) { const int row = 8 * p + (lane >> 3), c = (lane & 7) ^ ((row >> 1) & 7); qoff[p] = row * NQK0 + c * 8; }
#define L0_TOK0(D, t_) (((t_) < (D).nlat) ? (D).b * SEQ + 64 * ((D).lat0 + (t_)) : MLAT + (D).b * CTXL + 64 * ((t_) - (D).nlat))
#define L0_ISSUE(D, t_, slot_) do { const int tok0_ = L0_TOK0(D, t_); \
        const bf16_t* gb_ = (wid < 4) ? P.QK + (D).kcol + (size_t)tok0_ * NQK0 : P.VT + (size_t)(D).vrow * MTOT + tok0_; \
        _Pragma("unroll") for (int i_ = 0; i_ < 2; ++i_) __builtin_amdgcn_global_load_lds((const unsigned*)(gb_ + goff[i_]), (LAS unsigned*)(lds + (slot_) * L0_BUF + (2 * wid + i_) * 1024), 16, 0, 0); } while (0)
#define L0_ISSUE_Q(D) do { const bf16_t* gq_ = P.QK + (size_t)((D).qtok0 + 32 * jh) * NQK0 + (D).qcol; \
        _Pragma("unroll") for (int p_ = 0; p_ < 4; ++p_) __builtin_amdgcn_global_load_lds((const unsigned*)(gq_ + qoff[p_]), (LAS unsigned*)(lds + L0_Q_OFF + wid * 4096 + p_ * 1024), 16, 0, 0); } while (0)
    const int vcu = (G % 8 == 0) ? (bid % 8) * (G / 8) + bid / 8 : bid;
    int u = vcu;
    if (u >= L0_UNITS) return;
    L0Unit D = l0_decode(u, g);
    int sp = 0; bool later = false;
    L0_ISSUE(D, 0, 0); L0_ISSUE(D, 1, 1); L0_ISSUE(D, 2, 2); L0_ISSUE(D, 3, 3); L0_ISSUE_Q(D);
    L0_WAIT_BAR(0);
    for (;;) {
        const int un = u + G; const bool has_next = un < L0_UNITS;
        L0Unit Dn = D; if (has_next) Dn = l0_decode(un, g);
        const int nt = D.nt;
        bf16x8 qf[4];
        { const LAS unsigned char* qb = lds + L0_Q_OFF + wid * 4096; const int sw = (i31 >> 1) & 7;
#pragma unroll
          for (int d0 = 0; d0 < 4; ++d0) qf[d0] = *(const LAS bf16x8*)(qb + i31 * 128 + (((2 * d0 + h) ^ sw) << 4)); }
        float m_run, l_run;
        if (!D.isB) { m_run = P.sink[D.hq] * LOG2E_F; l_run = (h == 0) ? 1.f : 0.f; } else { m_run = 0.f; l_run = 0.f; }
        f32x16 negm;
#pragma unroll
        for (int r = 0; r < 16; ++r) negm[r] = -m_run;
        f32x16 oT[2]; oT[0] = f32x16{}; oT[1] = f32x16{};
        for (int t = 0; t < nt; ++t) {
            bool issued = false, issued_q = false;
            { int sl = sp + L0_AHEAD; if (sl >= L0_NSLOT) sl -= L0_NSLOT;
              if (t + L0_AHEAD < nt) { L0_ISSUE(D, t + L0_AHEAD, sl); issued = true; }
              else if (has_next) { L0_ISSUE(Dn, t + L0_AHEAD - nt, sl); issued = true; if (t == nt - 1) { L0_ISSUE_Q(Dn); issued_q = true; } } }
            const LAS unsigned char* buf = lds + sp * L0_BUF;
            L0Mask mk; mk.mode = 0; mk.tab = rpbl; mk.vb = 0; mk.dq = 0;
            if (t < D.nlat) {
                if (D.mode == 0) {
                    const int krow = D.lat0 + t, c = 32 * jh + i31, cstart = min(max(c - 8, 0), 48);
                    mk.mode = 1; mk.tab = rpbl + (D.hq * 15 + (krow - D.qx + 7)) * 31 + (8 * h - c + 15); mk.vb = 8 * h - cstart;
                } else {
                    const int tl = D.lat0 + t;
                    if (tl == D.qx - 2 || tl == D.qx + 2) { mk.mode = 2; mk.dq = 64 * D.qx + 32 * jh + i31 - 64 * tl - 8 * h; }
                }
            }
            tile_compute<2, L0Mask>(buf, buf + 8192, qf, oT, negm, m_run, l_run, D.isB && t == 0, pi, i31, h, mk);
            if (later && t < 3) L0_WAIT_BAR(63); else if (issued_q) L0_WAIT_BAR(10); else if (issued) L0_WAIT_BAR(6); else L0_WAIT_BAR(0);
            sp = (sp + 1 == L0_NSLOT) ? 0 : sp + 1;
        }
        if (has_next) asm volatile("s_waitcnt vmcnt(0)" ::: "memory");
        const float l = l_run + __shfl_xor(l_run, 32);
        const float inv = 1.0f / l;
        bf16_t* yp = P.Y + (size_t)(D.qtok0 + 32 * jh + i31) * DM + D.qcol;
#pragma unroll
        for (int db = 0; db < 2; ++db)
#pragma unroll
            for (int rg = 0; rg < 4; ++rg) {
                u32x2 w; w.x = pk_bf16(oT[db][4 * rg] * inv, oT[db][4 * rg + 1] * inv); w.y = pk_bf16(oT[db][4 * rg + 2] * inv, oT[db][4 * rg + 3] * inv);
                *(u32x2*)(yp + 32 * db + 8 * rg + 4 * h) = w;
            }
        if (!has_next) break;
        u = un; D = Dn; later = true;
    }
#undef L0_ISSUE
#undef L0_ISSUE_Q
#undef L0_TOK0
}
#undef L0_WAIT_BAR

constexpr int DF_SUB = 32768;
constexpr int DF_BUF = 65536;
constexpr int DF_X_OFF = 65536;
struct DiffArgs { const bf16_t* QK; const bf16_t* VT; bf16_t* Y; const float* lq1; const float* lk1; const float* lq2; const float* lk2; const float* subg; };
#define DF_WAIT_BAR(N) asm volatile("s_waitcnt vmcnt(" #N ") lgkmcnt(0)\n\ts_barrier" ::: "memory")

__device__ __forceinline__ void attn_diff_phase(LAS unsigned char* lds, const DiffArgs P, int bid, int G, int tid) {
    const int lane = tid & 63, wid = __builtin_amdgcn_readfirstlane(tid >> 6), i31 = lane & 31, h = lane >> 5;
    const int pi = (i31 & 0x13) | ((i31 & 4) << 1) | ((i31 & 8) >> 1);
    const int msub = wid & 1, jg = wid >> 1;
    const float lam = expf(wave_sum(P.lq1[lane] * P.lk1[lane])) - expf(wave_sum(P.lq2[lane] * P.lk2[lane])) + LAM_INIT;
    int goff[4];
#pragma unroll
    for (int i = 0; i < 4; ++i) {
        const int p = 4 * wid + i, rl = lane >> 3, sl = lane & 7;
        if (wid < 4) { const int kr = 8 * (p & 7) + rl, c = sl ^ ((kr >> 1) & 7); goff[i] = kr * NQK1 + (p >> 3) * 64 + c * 8; }
        else { const int e = 8 * (p - 16) + rl, c = sl ^ ((e >> 1) & 7); goff[i] = e * MTOT + c * 8; }
    }
    LAS float* subg_l = (LAS float*)(lds + 131072 + 256);
    if (tid < 128) subg_l[tid] = P.subg[tid];
    __syncthreads();
    const int nunits = NBATCH * 8 * 32;
#define DF_DECODE(it_, ok_, b_, hd_, qb_) do { int pair_; if (G == 256) { ok_ = (it_) < 8; pair_ = (bid & 7) * 8 + (it_); qb_ = bid >> 3; } \
        else { const int u_ = bid + (it_) * G; ok_ = u_ < nunits; pair_ = u_ >> 5; qb_ = u_ & 31; } b_ = pair_ >> 3; hd_ = pair_ & 7; } while (0)
#define DF_ISSUE(B_, KB_, VB_, st_, bo_) do { _Pragma("unroll") for (int sub_ = 0; sub_ < 2; ++sub_) { const int t_ = 2 * (st_) + sub_; \
            const int tok0_ = (t_ < 64) ? (B_) * SEQ + 64 * t_ : MLAT + (B_) * CTXL + 64 * (t_ - 64); \
            const bf16_t* gb_ = (wid < 4) ? (KB_) + (size_t)tok0_ * NQK1 : (VB_) + tok0_; \
            _Pragma("unroll") for (int i_ = 0; i_ < 4; ++i_) __builtin_amdgcn_global_load_lds((const unsigned*)(gb_ + goff[i_]), (LAS unsigned*)(lds + (bo_) + sub_ * DF_SUB + (4 * wid + i_) * 1024), 16, 0, 0); } } while (0)
    bool ok; int b, hd, qb;
    DF_DECODE(0, ok, b, hd, qb);
    if (!ok) return;
    const bf16_t* kbase = P.QK + 1024 + hd * 128;
    const bf16_t* vbase = P.VT + (size_t)(hd * 128) * MTOT;
    bf16x8 qf[4];
    { const int qtok0 = b * SEQ + 128 * qb + 32 * jg + i31;
#pragma unroll
      for (int d0 = 0; d0 < 4; ++d0) qf[d0] = *(const bf16x8*)(P.QK + (size_t)qtok0 * NQK1 + hd * 128 + msub * 64 + 16 * d0 + 8 * h); }
    DF_ISSUE(b, kbase, vbase, 0, 0);
    for (int it = 0; ; ++it) {
        const int qtok = b * SEQ + 128 * qb + 32 * jg + i31;
        float m_run = 0.f, l_run = 0.f;
        f32x16 oT[4]; oT[0] = f32x16{}; oT[1] = f32x16{}; oT[2] = f32x16{}; oT[3] = f32x16{};
        f32x16 negm = f32x16{};
        int b0 = 0, b1 = DF_BUF;
        asm volatile("" : "+v"(qf[0]), "+v"(qf[1]), "+v"(qf[2]), "+v"(qf[3]));
        DF_WAIT_BAR(0);
        constexpr int NST = 34;
        for (int st = 0; st < NST; ++st) {
            if (st + 1 < NST) DF_ISSUE(b, kbase, vbase, st + 1, b1);
            const LAS unsigned char* buf = lds + b0;
            tile_compute128<4>(buf + msub * 8192, buf + 16384, buf + DF_SUB + msub * 8192, buf + DF_SUB + 16384, qf, oT, negm, m_run, l_run, st == 0, pi, i31, h, wid >= 4);
            DF_WAIT_BAR(0);
            { const int tmp = b0; b0 = b1; b1 = tmp; }
        }
        bool nok; int nb, nhd, nqb;
        DF_DECODE(it + 1, nok, nb, nhd, nqb);
        const int hd_cur = hd;
        if (nok) {
            kbase = P.QK + 1024 + nhd * 128; vbase = P.VT + (size_t)(nhd * 128) * MTOT;
            DF_ISSUE(nb, kbase, vbase, 0, 0);
            const int qtokn = nb * SEQ + 128 * nqb + 32 * jg + i31;
#pragma unroll
            for (int d0 = 0; d0 < 4; ++d0) qf[d0] = *(const bf16x8*)(P.QK + (size_t)qtokn * NQK1 + nhd * 128 + msub * 64 + 16 * d0 + 8 * h);
            b = nb; hd = nhd; qb = nqb;
        }
        const float l = l_run + __shfl_xor(l_run, 32);
        const float inv = 1.0f / l;
        LAS float* X = (LAS float*)(lds + DF_X_OFF) + jg * 4096;
        if (msub == 1) {
            const float f = lam * inv;
#pragma unroll
            for (int db = 0; db < 4; ++db)
#pragma unroll
                for (int r = 0; r < 16; ++r) X[(32 * db + crow(r, h)) * 32 + i31] = oT[db][r] * f;
        }
        __syncthreads();
        if (msub == 0) {
            float ssq = 0.f;
#pragma unroll
            for (int db = 0; db < 4; ++db)
#pragma unroll
                for (int r = 0; r < 16; ++r) { const float d = oT[db][r] * inv - X[(32 * db + crow(r, h)) * 32 + i31]; oT[db][r] = d; ssq += d * d; }
            ssq += __shfl_xor(ssq, 32);
            const float rn = rsqrtf(ssq * (1.0f / 128.0f) + EPS_F) * (1.0f - LAM_INIT);
            bf16_t* yp = P.Y + (size_t)qtok * DM + hd_cur * 128;
            f32x4 gqv[4][4];
#pragma unroll
            for (int db = 0; db < 4; ++db)
#pragma unroll
                for (int rg = 0; rg < 4; ++rg) gqv[db][rg] = *(const LAS f32x4*)(subg_l + 32 * db + 8 * rg + 4 * h);
#pragma unroll
            for (int db = 0; db < 4; ++db)
#pragma unroll
                for (int rg = 0; rg < 4; ++rg) {
                    const int e0 = 32 * db + 8 * rg + 4 * h;
                    const f32x4 gq = gqv[db][rg];
                    u32x2 w; w.x = pk_bf16(oT[db][4 * rg] * rn * gq[0], oT[db][4 * rg + 1] * rn * gq[1]); w.y = pk_bf16(oT[db][4 * rg + 2] * rn * gq[2], oT[db][4 * rg + 3] * rn * gq[3]);
                    *(u32x2*)(yp + e0) = w;
                }
        }
        __syncthreads();
        if (!nok) break;
    }
#undef DF_ISSUE
#undef DF_DECODE
}
#undef DF_WAIT_BAR
#undef MFMA32
}

constexpr size_t MiB = 1u << 20;
constexpr size_t WS_MOD = 0;
constexpr size_t WS_ROPE = 512 * 1024;
constexpr size_t WS_BIAS = 1 * MiB;
constexpr size_t WS_SS = 4 * MiB;
constexpr size_t WS_WQK0 = 8 * MiB, WS_WV0 = 11 * MiB, WS_WO0 = 12 * MiB, WS_W10 = 14 * MiB, WS_W20 = 22 * MiB;
constexpr size_t WS_WQK1 = 30 * MiB, WS_WV1 = 34 * MiB, WS_WO1 = 36 * MiB, WS_W11 = 38 * MiB, WS_W21 = 46 * MiB;
constexpr size_t WS_HR = 56 * MiB;
constexpr size_t WS_QK = 192 * MiB;
constexpr size_t WS_VT = 328 * MiB;
constexpr size_t WS_Y = 396 * MiB;
constexpr size_t WS_H = 192 * MiB;
constexpr size_t WS_SLAB = 464 * MiB;
constexpr size_t WS_END = 512 * MiB;
constexpr int BO_QK0 = 0, BO_V0 = BO_QK0 + 9 * NQK0, BO_UP0 = BO_V0 + 9 * NV0, BO_QK1 = BO_UP0 + 9 * DFF, BO_V1 = BO_QK1 + 9 * NQK1, BO_UP1 = BO_V1 + 9 * NV1;
constexpr int LDS_BYTES = 147456;
constexpr int NPHASE = 15;

__device__ __forceinline__ float silu_f(float v) { return v / (1.0f + expf(-v)); }
__device__ __forceinline__ void even_map(int c, int& isv, int& r) {
    if (c < 512) { isv = 0; r = c; } else if (c < 640) { isv = 0; r = 1024 + (c - 512); } else if (c < 768) { isv = 1; r = c - 640; }
    else if (c < 1280) { isv = 0; r = 512 + (c - 768); } else if (c < 1408) { isv = 0; r = 1152 + (c - 1280); } else { isv = 1; r = 128 + (c - 1408); }
}
__device__ __forceinline__ void gemv9_item(const float* __restrict__ W, int ldw, int csrc0, const LAS float* vec, LAS float* red, float* out, int ostride, int cdst0, const float* addb, int tid) {
    const int lane = tid & 63, kg = tid >> 6, cg = lane & 15, ks = lane >> 4;
    f32x4 a[9];
#pragma unroll
    for (int b = 0; b < 9; ++b) a[b] = (f32x4){0.f, 0.f, 0.f, 0.f};
    const float* wp = W + (size_t)(kg * 128 + ks) * ldw + csrc0 + 4 * cg;
    const LAS float* vp = vec + kg * 128 + ks;
#pragma unroll 8
    for (int i = 0; i < 32; ++i) {
        const f32x4 w = *(const f32x4*)(wp + (size_t)(4 * i) * ldw);
#pragma unroll
        for (int b = 0; b < 9; ++b) a[b] += w * vp[b * 1024 + 4 * i];
    }
    LAS float* rp = red + (kg * 4 + ks) * 576 + 4 * cg;
#pragma unroll
    for (int b = 0; b < 9; ++b) *(LAS f32x4*)(rp + b * 64) = a[b];
    __syncthreads();
    for (int idx = tid; idx < 576; idx += 512) {
        const int c = idx & 63; float s = 0.f;
#pragma unroll
        for (int g2 = 0; g2 < 32; ++g2) s += red[g2 * 576 + idx];
        if (addb) s += addb[csrc0 + c];
        out[(size_t)(idx >> 6) * ostride + cdst0 + c] = s;
    }
    __syncthreads();
}
__device__ __forceinline__ void transpose_item(const float* __restrict__ W, int K, int N, int k0, int n0, bf16_t* dst, LAS float* scr, int lane) {
    f32x4 v[8];
#pragma unroll
    for (int i = 0; i < 8; ++i) v[i] = *(const f32x4*)(W + (size_t)(k0 + 8 * i + (lane >> 3)) * N + n0 + 4 * (lane & 7));
#pragma unroll
    for (int i = 0; i < 8; ++i) { LAS float* sp = scr + (8 * i + (lane >> 3)) * 33 + 4 * (lane & 7); sp[0] = v[i][0]; sp[1] = v[i][1]; sp[2] = v[i][2]; sp[3] = v[i][3]; }
    asm volatile("s_waitcnt lgkmcnt(0)" ::: "memory");
    const int c = lane & 7;
#pragma unroll
    for (int j = 0; j < 4; ++j) { const int n = (lane >> 3) + 8 * j; const LAS float* s = scr + (8 * c) * 33 + n;
        u32x4 o; o.x = pk_bf16(s[0 * 33], s[1 * 33]); o.y = pk_bf16(s[2 * 33], s[3 * 33]); o.z = pk_bf16(s[4 * 33], s[5 * 33]); o.w = pk_bf16(s[6 * 33], s[7 * 33]);
        *(u32x4*)(dst + (size_t)n * K + k0 + 8 * c) = o; }
    asm volatile("s_waitcnt lgkmcnt(0)" ::: "memory");
}
__device__ __forceinline__ void sincos_small(double a, float& c, float& s) {
    const double TWO_PI = 6.283185307179586476925287;
    const double k = __builtin_rint(a / TWO_PI);
    const double x = a - k * TWO_PI, x2 = x * x;
    double ts = 1.0, tc = 1.0;
    for (int j = 15; j >= 1; --j) { ts = 1.0 - x2 / (double)((2 * j) * (2 * j + 1)) * ts; tc = 1.0 - x2 / (double)((2 * j - 1) * (2 * j)) * tc; }
    s = (float)(x * ts); c = (float)tc;
}

#define GAS __attribute__((address_space(1)))
#define XB_TMO      128
#define XB_XCNT(j)  (256  + 64 * (j))
#define XB_XSUB(j)  (1280 + 64 * (j))
#define XB_XGEN(j)  (2304 + 64 * (j))
#define XB_TOP      3328
#define XB_TOPGEN   3392
#define XCD_BAR_WORDS 3456
#define XB_SPIN_CAP (1u << 18)

__device__ __forceinline__ unsigned xb_ld(unsigned* p)              { return __hip_atomic_load(p, __ATOMIC_RELAXED, __HIP_MEMORY_SCOPE_AGENT); }
__device__ __forceinline__ unsigned xb_add(unsigned* p, unsigned v) { return __hip_atomic_fetch_add(p, v, __ATOMIC_RELAXED, __HIP_MEMORY_SCOPE_AGENT); }
__device__ __forceinline__ unsigned xb_xcc_id() { return (unsigned)__builtin_amdgcn_s_getreg((3 << 11) | 20) & 0xFu; }
#define XB_SPIN(cond, bar) do { unsigned _sp = 0; while (cond) { __builtin_amdgcn_s_sleep(1); \
    if ((++_sp & 255u) == 0u) { if (xb_ld(&(bar)[XB_TMO])) break; if (_sp > XB_SPIN_CAP) { atomicAdd(&(bar)[XB_TMO], 1u); break; } } } } while (0)

struct XcdBarrier {
    unsigned* bar; unsigned x;
    volatile LAS unsigned* st;
};

__device__ __forceinline__ XcdBarrier xcd_barrier_post(unsigned* bar, volatile LAS unsigned* st) {
    XcdBarrier b; b.bar = bar; b.x = xb_xcc_id(); b.st = st;
    if (threadIdx.x == 0) (void)xb_add(&bar[XB_XCNT(b.x)], 1u);
    return b;
}
__device__ __forceinline__ void xcd_barrier_complete(unsigned* bar, unsigned x, unsigned& nloc, unsigned& nx) {
    const unsigned G = gridDim.x * gridDim.y * gridDim.z;
    unsigned sum, cnt, mine, sp = 0u;
    for (;;) {
        sum = 0u; cnt = 0u; mine = 0u;
#pragma unroll
        for (unsigned j = 0; j < 16; ++j) { const unsigned c = xb_ld(&bar[XB_XCNT(j)]); sum += c; cnt += (c > 0u) ? 1u : 0u; mine = (j == x) ? c : mine; }
        if (sum == G) break;
        __builtin_amdgcn_s_sleep(1);
        if ((++sp & 255u) == 0u) { if (xb_ld(&bar[XB_TMO])) break; if (sp > XB_SPIN_CAP) { atomicAdd(&bar[XB_TMO], 1u); break; } }
    }
    nloc = mine > 0u ? mine : 1u; nx = cnt > 0u ? cnt : 1u;
}

__device__ __forceinline__ void xcd_barrier(const XcdBarrier& b) {
    asm volatile("s_waitcnt vmcnt(0)" ::: "memory");
    __syncthreads();
    if (threadIdx.x == 0) {
        unsigned* bar = b.bar;
        __builtin_amdgcn_s_waitcnt(0);
        unsigned nloc = b.st[0], nx = b.st[1];
        if (nloc == 0u) { xcd_barrier_complete(bar, b.x, nloc, nx); b.st[0] = nloc; b.st[1] = nx; }
        const unsigned old = xb_add(&bar[XB_XSUB(b.x)], 1u);
        const unsigned gen = old / nloc;
        if (old + 1u == (gen + 1u) * nloc) {
            __builtin_amdgcn_fence(__ATOMIC_RELEASE, "agent");
            asm volatile("s_waitcnt vmcnt(0)" ::: "memory");
            const unsigned og = xb_add(&bar[XB_TOP], 1u);
            const unsigned tg = og / nx;
            if (og + 1u == (tg + 1u) * nx) xb_add(&bar[XB_TOPGEN], 1u);
            else XB_SPIN(xb_ld(&bar[XB_TOPGEN]) == tg, bar);
            __builtin_amdgcn_fence(__ATOMIC_ACQUIRE, "agent");
            xb_add(&bar[XB_XGEN(b.x)], 1u);
            asm volatile("s_waitcnt vmcnt(0)" ::: "memory");
        } else {
            XB_SPIN(xb_ld(&bar[XB_XGEN(b.x)]) == gen, bar);
            __builtin_amdgcn_fence(__ATOMIC_ACQUIRE, "agent");
            asm volatile("s_waitcnt vmcnt(0)" ::: "memory");
        }
    }
    __syncthreads();
}

constexpr size_t WS_BAR = 2 * MiB;
constexpr int LDS_MISC_OFF = 131072;
template <bool HIN_BF> __device__ __forceinline__ void ctx_reduce(const float* slab_lo, const float* slab_hi, const void* hin, const float* gate, const float* scl, const float* ng, bf16_t* hout, bf16_t* xg, float* ss, int gw, int NGW, int lane) {
    for (int r = gw; r < MCTX; r += NGW) {
        f32x4 a[4];
#pragma unroll
        for (int j = 0; j < 4; ++j) a[j] = (f32x4){0.f, 0.f, 0.f, 0.f};
#pragma unroll
        for (int ks = 0; ks < 8; ++ks) {
            const float* sp = (ks < 6 ? slab_lo + (size_t)ks * MCTX * DM : slab_hi + (size_t)(ks - 6) * MCTX * DM) + (size_t)r * DM + 4 * lane;
#pragma unroll
            for (int j = 0; j < 4; ++j) a[j] += *(const f32x4*)(sp + 256 * j);
        }
        float ssum = 0.f;
#pragma unroll
        for (int j = 0; j < 4; ++j) {
            const int k = 4 * lane + 256 * j;
            f32x4 h0; if (HIN_BF) h0 = pg8::ld_bf4((const bf16_t*)hin + (size_t)r * DM + k); else h0 = *(const f32x4*)((const float*)hin + (size_t)r * DM + k);
            const f32x4 v = h0 + *(const f32x4*)(gate + 8 * 6144 + k) * a[j];
            if (hout) { u32x2 w; w.x = pk_bf16(v[0], v[1]); w.y = pk_bf16(v[2], v[3]); *(u32x2*)(hout + (size_t)r * DM + k) = w; }
            ssum += (v[0] * v[0] + v[1] * v[1]) + (v[2] * v[2] + v[3] * v[3]);
            const f32x4 y = v * (*(const f32x4*)(ng + k) * (*(const f32x4*)(scl + 8 * 6144 + k) + 1.0f));
            u32x2 w; w.x = pk_bf16(y[0], y[1]); w.y = pk_bf16(y[2], y[3]);
            *(u32x2*)(xg + (size_t)(MLAT + r) * DM + k) = w;
        }
        ssum = att::wave_sum(ssum);
        if (lane < 16) ss[(size_t)(MLAT + r) * 16 + lane] = (lane == 0) ? ssum : 0.f;
    }
}

__device__ __forceinline__ void transpose_dispatch(int it, LAS float* scr, int lane, const float* even_w_in, const float* even_w_out, const float* odd_w_in, const float* odd_w_out, const float* mlp_w1, const float* mlp_w2,
                                                   bf16_t* Wqk0, bf16_t* Wv0, bf16_t* Wo0, bf16_t* Wqk1, bf16_t* Wv1, bf16_t* Wo1, bf16_t* W10, bf16_t* W11, bf16_t* W20, bf16_t* W21) {
    int r = it;
    if (r < 768) { const int kb = r / 48, nb = r % 48; int isv, dr; even_map(32 * nb, isv, dr);
        transpose_item(even_w_in, DM, 1536, 64 * kb, 32 * nb, (isv ? Wv0 : Wqk0) + (size_t)dr * DM, scr, lane); return; } r -= 768;
    if (r < 512) { const int kb = r / 32, nb = r % 32; transpose_item(even_w_out, DM, DM, 64 * kb, 32 * nb, Wo0 + (size_t)(32 * nb) * DM, scr, lane); return; } r -= 512;
    if (r < 1536) { const int kb = r / 96, nb = r % 96; const int n0 = 32 * nb;
        transpose_item(odd_w_in, DM, 3072, 64 * kb, n0, n0 < 2048 ? Wqk1 + (size_t)n0 * DM : Wv1 + (size_t)(n0 - 2048) * DM, scr, lane); return; } r -= 1536;
    if (r < 512) { const int kb = r / 32, nb = r % 32; transpose_item(odd_w_out, DM, DM, 64 * kb, 32 * nb, Wo1 + (size_t)(32 * nb) * DM, scr, lane); return; } r -= 512;
    if (r < 4096) { const int l = r / 2048, q = r % 2048, kb = q / 128, nb = q % 128;
        transpose_item(mlp_w1 + (size_t)l * DM * DFF, DM, DFF, 64 * kb, 32 * nb, (l ? W11 : W10) + (size_t)(32 * nb) * DM, scr, lane); return; } r -= 4096;
    { const int l = r / 2048, q = r % 2048, kb = q / 32, nb = q % 32;
        transpose_item(mlp_w2 + (size_t)l * DFF * DM, DFF, DM, 64 * kb, 32 * nb, (l ? W21 : W20) + (size_t)(32 * nb) * DFF, scr, lane); }
}

#ifndef USE_FINAL
#define USE_FINAL 0
#endif
struct Args { const float* in[22]; float* out; unsigned char* ws; int ph_lo, ph_hi; };

__global__ void __launch_bounds__(512, 2) dit_fwd(Args args) {
    extern __shared__ __attribute__((aligned(16))) unsigned char lds_raw[];
    LAS unsigned char* lds = (LAS unsigned char*)lds_raw;
    const int tid = threadIdx.x, lane = tid & 63, wave = __builtin_amdgcn_readfirstlane(tid >> 6);
    const int bid = blockIdx.x, G = gridDim.x;
    const int gw = bid * 8 + wave, NGW = G * 8;
    unsigned char* ws = args.ws;
    const float* x = args.in[0]; const float* cvec = args.in[1]; const float* ctx = args.in[2]; const float* c_ctx = args.in[3];
    const float* ada_w = args.in[4]; const float* ada_b = args.in[5]; const float* norm1_g = args.in[6]; const float* norm2_g = args.in[7];
    const float* even_w_in = args.in[8]; const float* even_w_out = args.in[9]; const float* a_sink = args.in[10]; const float* b_rpb = args.in[11];
    const float* odd_w_in = args.in[12]; const float* odd_w_out = args.in[13];
    const float* mlp_w1 = args.in[19]; const float* mlp_w2 = args.in[20]; const float* final_g = args.in[21];
    float* mod = (float*)(ws + WS_MOD); float* ropetab = (float*)(ws + WS_ROPE); float* biasb = (float*)(ws + WS_BIAS); float* ssb = (float*)(ws + WS_SS);
    bf16_t* Wqk0 = (bf16_t*)(ws + WS_WQK0); bf16_t* Wv0 = (bf16_t*)(ws + WS_WV0); bf16_t* Wo0 = (bf16_t*)(ws + WS_WO0); bf16_t* W10 = (bf16_t*)(ws + WS_W10); bf16_t* W20 = (bf16_t*)(ws + WS_W20);
    bf16_t* Wqk1 = (bf16_t*)(ws + WS_WQK1); bf16_t* Wv1 = (bf16_t*)(ws + WS_WV1); bf16_t* Wo1 = (bf16_t*)(ws + WS_WO1); bf16_t* W11 = (bf16_t*)(ws + WS_W11); bf16_t* W21 = (bf16_t*)(ws + WS_W21);
    bf16_t* HR = (bf16_t*)(ws + WS_HR); bf16_t* QK = (bf16_t*)(ws + WS_QK); bf16_t* VT = (bf16_t*)(ws + WS_VT); bf16_t* Y = (bf16_t*)(ws + WS_Y); bf16_t* Hb = (bf16_t*)(ws + WS_H);
    bf16_t* XG = (bf16_t*)args.out;
    const int lo = args.ph_lo, hi = args.ph_hi;
#define IN(k) (lo <= (k) && (k) < hi)
#ifdef PROBE_STAMPS
    unsigned long long* stamps = (unsigned long long*)(ws + 3 * MiB);
    if (bid == 0 && tid == 0) stamps[0] = __builtin_amdgcn_s_memrealtime();
#define SEAM(k) do { if (IN(k) && IN((k) + 1)) { cg::this_grid().sync(); if (bid == 0 && tid == 0) stamps[(k) + 1] = __builtin_amdgcn_s_memrealtime(); } } while (0)
#else
    volatile LAS unsigned* misc = (volatile LAS unsigned*)(lds + LDS_MISC_OFF);
    if (tid < 4) misc[tid] = 0u;
    __syncthreads();
    XcdBarrier xbar; xbar.bar = (unsigned*)(ws + WS_BAR); xbar.x = 0; xbar.st = nullptr;
    if (hi - lo > 1) xbar = xcd_barrier_post((unsigned*)(ws + WS_BAR), misc);
#define SEAM(k) do { if (IN(k) && IN((k) + 1)) { xcd_barrier(xbar); } } while (0)
#endif

    if (IN(0)) {
        if (bid < 192) {
            LAS float* vec = (LAS float*)lds; LAS float* red = (LAS float*)(lds + 40960);
            for (int i = tid; i < 9 * 1024; i += 512) { const float v = (i < 8192) ? cvec[i] : c_ctx[i - 8192]; vec[i] = silu_f(v); }
            __syncthreads();
            const int l = bid / 96, cb = bid % 96;
            gemv9_item(ada_w + (size_t)l * DM * 6144, 6144, cb * 64, vec, red, mod + (size_t)l * 9 * 6144, 6144, cb * 64, ada_b + (size_t)l * 6144, tid);
        }
        if (bid == G - 1) {
            for (int idx = tid; idx < 1024; idx += 512) {
                const int pos = idx >> 4, i = idx & 15; double f = 1.0;
                for (int q = 0; q < i; ++q) f *= 0.56234132519034908;
                float c, s; sincos_small((double)pos * f, c, s);
                ropetab[2 * idx] = c; ropetab[2 * idx + 1] = s;
            }
        }
        __syncthreads();
        LAS float* scr = (LAS float*)(lds + wave * 8448);
        const bool defer = (G == 256);
        for (int it = gw; it < (defer ? 768 : 11520); it += NGW) transpose_dispatch(it, scr, lane, even_w_in, even_w_out, odd_w_in, odd_w_out, mlp_w1, mlp_w2, Wqk0, Wv0, Wo0, Wqk1, Wv1, Wo1, W10, W11, W20, W21);
    }
    SEAM(0);
    if (IN(1)) {
        if (bid < 200) {
            LAS float* vec = (LAS float*)lds; LAS float* red = (LAS float*)(lds + 40960);
            int l, soff; if (bid < 24) { l = 0; soff = 0; } else if (bid < 88) { l = 0; soff = 3072; } else if (bid < 136) { l = 1; soff = 0; } else { l = 1; soff = 3072; }
            for (int i = tid; i < 9 * 1024; i += 512) vec[i] = mod[(size_t)(l * 9 + (i >> 10)) * 6144 + soff + (i & 1023)];
            __syncthreads();
            if (bid < 24) { const int c0 = 64 * bid; int isv, dr; even_map(c0, isv, dr);
                gemv9_item(even_w_in, 1536, c0, vec, red, biasb + (isv ? BO_V0 : BO_QK0), isv ? NV0 : NQK0, dr, nullptr, tid); }
            else if (bid < 88) { const int c0 = 64 * (bid - 24); gemv9_item(mlp_w1, DFF, c0, vec, red, biasb + BO_UP0, DFF, c0, nullptr, tid); }
            else if (bid < 136) { const int c0 = 64 * (bid - 88);
                if (c0 < 2048) gemv9_item(odd_w_in, 3072, c0, vec, red, biasb + BO_QK1, NQK1, c0, nullptr, tid);
                else gemv9_item(odd_w_in, 3072, c0, vec, red, biasb + BO_V1, NV1, c0 - 2048, nullptr, tid); }
            else { const int c0 = 64 * (bid - 136); gemv9_item(mlp_w1 + (size_t)DM * DFF, DFF, c0, vec, red, biasb + BO_UP1, DFF, c0, nullptr, tid); }
        }
        for (int r4 = gw; r4 < MTOT / 4; r4 += NGW) {
            const int row0 = 4 * r4;
            const float* src = row0 < MLAT ? x + (size_t)row0 * DM : ctx + (size_t)(row0 - MLAT) * DM;
            const int b = row0 < MLAT ? (row0 >> 12) : 8;
            const float* scl = mod + (size_t)b * 6144 + 1024;
            f32x4 v[4][4];
#pragma unroll
            for (int rr = 0; rr < 4; ++rr)
#pragma unroll
                for (int j = 0; j < 4; ++j) v[rr][j] = *(const f32x4*)(src + (size_t)rr * DM + 4 * lane + 256 * j);
            f32x4 gp[4];
#pragma unroll
            for (int j = 0; j < 4; ++j) { const int k = 4 * lane + 256 * j; gp[j] = *(const f32x4*)(norm1_g + k) * (*(const f32x4*)(scl + k) + 1.0f); }
#pragma unroll
            for (int rr = 0; rr < 4; ++rr) {
                float ssum = 0.f;
#pragma unroll
                for (int j = 0; j < 4; ++j) {
                    const f32x4 t = v[rr][j];
                    ssum += (t[0] * t[0] + t[1] * t[1]) + (t[2] * t[2] + t[3] * t[3]);
                    const f32x4 y = t * gp[j];
                    u32x2 w; w.x = pk_bf16(y[0], y[1]); w.y = pk_bf16(y[2], y[3]);
                    *(u32x2*)(XG + (size_t)(row0 + rr) * DM + 4 * lane + 256 * j) = w;
                }
                ssum = att::wave_sum(ssum);
                if (lane < 16) ssb[(size_t)(row0 + rr) * 16 + lane] = (lane == 0) ? ssum : 0.f;
            }
        }
    }
    SEAM(1);
    if (IN(2)) {
        { pg8::Gemm g{XG, Wqk0, MTOT, NQK0, DM}; pg8::StaticOrder S; S.init(MTOT, NQK0, G, bid, DM);
          pg8::EpiQK E{QK, NQK0, ssb, biasb + BO_QK0, 0x10Fu, 0x0FFu, ropetab, lds}; pg8::fill_rstd_table<pg8::StaticOrder, false>(lds, S, ssb);
          pg8::gemm_phase<pg8::EpiQK, pg8::StaticOrder, true, true>(lds, g, S, E); }
        { pg8::Gemm g{Wv0, XG, NV0, MTOT, DM}; pg8::StaticOrder S; S.init(NV0, MTOT, G, bid, DM);
          pg8::EpiVT E{VT, MTOT, ssb, biasb + BO_V0, NV0, lds}; pg8::fill_rstd_table<pg8::StaticOrder, true>(lds, S, ssb);
          pg8::gemm_phase<pg8::EpiVT, pg8::StaticOrder, true, true>(lds, g, S, E); }
        if (G == 256 && bid >= 168) {
            LAS float* scr = (LAS float*)(lds + wave * 8448);
            for (int it = 768 + (bid - 168) * 8 + wave; it < 11520; it += 88 * 8) transpose_dispatch(it, scr, lane, even_w_in, even_w_out, odd_w_in, odd_w_out, mlp_w1, mlp_w2, Wqk0, Wv0, Wo0, Wqk1, Wv1, Wo1, W10, W11, W20, W21);
        }
    }
    SEAM(2);
    if (IN(3)) { att::L0Args P{QK, VT, Y, a_sink, b_rpb}; att::attn_l0_phase(lds, P, bid, G, tid); }
    SEAM(3);
    if (IN(4)) {
        pg8::Gemm g{Y, Wo0, MTOT, DM, DM};
        pg8::EpiResT<false, true> E{x, ctx, HR, XG, ssb, mod + 2048, mod + 4096, norm2_g};
        { pg8::StaticOrder S; S.init(G == 256 ? MLAT : MTOT, DM, G, bid, DM); pg8::gemm_phase<pg8::EpiResT<false, true>, pg8::StaticOrder, true, true>(lds, g, S, E); }
        if (G == 256) { pg8::SplitCtxOrder S; S.init(bid, DM);
            pg8::EpiSlab E2{(float*)(ws + WS_QK), (float*)(ws + WS_QK) + (size_t)6 * MCTX * DM};
            pg8::gemm_phase<pg8::EpiSlab, pg8::SplitCtxOrder, true, true>(lds, g, S, E2); }
    }
    SEAM(4);
    if (IN(5)) { if (G == 256) ctx_reduce<false>((const float*)(ws + WS_QK), (const float*)(ws + WS_QK) + (size_t)6 * MCTX * DM, ctx, mod + 2048, mod + 4096, norm2_g, HR + (size_t)MLAT * DM, XG, ssb, gw, NGW, lane); }
    SEAM(5);
    if (IN(6)) {
        pg8::Gemm g{XG, W10, MTOT, DFF, DM}; pg8::StaticOrder S; S.init(MTOT, DFF, G, bid, DM);
        pg8::EpiUp E{Hb, ssb, biasb + BO_UP0, lds}; pg8::fill_rstd_table<pg8::StaticOrder, false>(lds, S, ssb);
        pg8::gemm_phase<pg8::EpiUp, pg8::StaticOrder, true, true>(lds, g, S, E);
    }
    SEAM(6);
    if (IN(7)) {
        pg8::Gemm g{Hb, W20, MTOT, DM, DFF};
        pg8::EpiResT<true, true> E{HR, HR + (size_t)MLAT * DM, HR, XG, ssb, mod + 5120, mod + 9 * 6144 + 1024, norm1_g + DM};
        { pg8::StaticOrder S; S.init(G == 256 ? MLAT : MTOT, DM, G, bid, DFF); pg8::gemm_phase<pg8::EpiResT<true, true>, pg8::StaticOrder, true, true>(lds, g, S, E); }
        if (G == 256) { pg8::SplitCtxOrder S; S.init(bid, DFF);
            pg8::EpiSlab E2{(float*)(ws + WS_SLAB), (float*)((unsigned char*)args.out + 72 * MiB)};
            pg8::gemm_phase<pg8::EpiSlab, pg8::SplitCtxOrder, true, true>(lds, g, S, E2); }
    }
    SEAM(7);
    if (IN(8)) { if (G == 256) ctx_reduce<true>((const float*)(ws + WS_SLAB), (const float*)((const unsigned char*)args.out + 72 * MiB), HR + (size_t)MLAT * DM, mod + 5120, mod + 9 * 6144 + 1024, norm1_g + DM, nullptr, XG, ssb, gw, NGW, lane); }
    SEAM(8);
    if (IN(9)) {
        { pg8::Gemm g{XG, Wqk1, MTOT, NQK1, DM}; pg8::StaticOrder S; S.init(MTOT, NQK1, G, bid, DM);
          pg8::EpiQK E{QK, NQK1, ssb, biasb + BO_QK1, 0xFFFFu, 0x00FFu, ropetab, lds}; pg8::fill_rstd_table<pg8::StaticOrder, false>(lds, S, ssb);
          pg8::gemm_phase<pg8::EpiQK, pg8::StaticOrder, true, true>(lds, g, S, E); }
        { pg8::Gemm g{Wv1, XG, NV1, MTOT, DM}; pg8::StaticOrder S; S.init(NV1, MTOT, G, (bid + G / 2) % G, DM);
          pg8::EpiVT E{VT, MTOT, ssb, biasb + BO_V1, NV1, lds}; pg8::fill_rstd_table<pg8::StaticOrder, true>(lds, S, ssb);
          pg8::gemm_phase<pg8::EpiVT, pg8::StaticOrder, true, true>(lds, g, S, E); }
    }
    SEAM(9);
    if (IN(10)) { att::DiffArgs P{QK, VT, Y, args.in[14], args.in[15], args.in[16], args.in[17], args.in[18]}; att::attn_diff_phase(lds, P, bid, G, tid); }
    SEAM(10);
    if (IN(11)) {
        pg8::Gemm g{Y, Wo1, MLAT, DM, DM}; pg8::StaticOrder S; S.init(MLAT, DM, G, bid, DM);
        pg8::EpiResT<true, true> E{HR, HR, HR, XG, ssb, mod + 9 * 6144 + 2048, mod + 9 * 6144 + 4096, norm2_g + DM};
        pg8::gemm_phase<pg8::EpiResT<true, true>, pg8::StaticOrder, true, true>(lds, g, S, E);
    }
    SEAM(11);
    if (IN(12)) {
        pg8::Gemm g{XG, W11, MLAT, DFF, DM}; pg8::StaticOrder S; S.init(MLAT, DFF, G, bid, DM);
        pg8::EpiUp E{Hb, ssb, biasb + BO_UP1, lds}; pg8::fill_rstd_table<pg8::StaticOrder, false>(lds, S, ssb);
        pg8::gemm_phase<pg8::EpiUp, pg8::StaticOrder, true, true>(lds, g, S, E);
    }
    SEAM(12);
    if (IN(13)) {
        pg8::Gemm g{Hb, W21, MLAT, DM, DFF}; pg8::StaticOrder S; S.init(MLAT, DM, G, bid, DFF);
        if (G == 256 && USE_FINAL) {
            pg8::EpiFinal E{(const float*)HR, args.out, ssb, mod + 9 * 6144 + 5120, final_g, (unsigned*)(ws + WS_BAR) + 4096};
            pg8::gemm_phase<pg8::EpiFinal, pg8::StaticOrder, true, true>(lds, g, S, E);
        } else {
            pg8::EpiResT<true, false> E{HR, HR, args.out, nullptr, ssb, mod + 9 * 6144 + 5120, nullptr, nullptr};
            pg8::gemm_phase<pg8::EpiResT<true, false>, pg8::StaticOrder, true, true>(lds, g, S, E);
        }
    }
    if (G != 256 || !USE_FINAL) { SEAM(13); }
    if (IN(14) && (G != 256 || !USE_FINAL)) {
        for (int row = gw; row < MLAT; row += NGW) {
            const float rs = pg8::row_rstd(ssb, row);
            float* op = args.out + (size_t)row * DM;
#pragma unroll
            for (int j = 0; j < 4; ++j) { const int k = 4 * lane + 256 * j; const f32x4 v = *(const f32x4*)(op + k), g = *(const f32x4*)(final_g + k); *(f32x4*)(op + k) = v * rs * g; }
        }
    }
#ifdef PROBE_STAMPS
    cg::this_grid().sync();
    if (bid == 0 && tid == 0) stamps[13] = __builtin_amdgcn_s_memrealtime();
    cg::this_grid().sync();
    {
        const float da = (float)(stamps[PA_HI] - stamps[PA_LO]) * 0.01f, db = (float)(stamps[PB_HI] - stamps[PB_LO]) * 0.01f;
        for (size_t i = (size_t)bid * 512 + tid; i < (size_t)(1u << 22); i += (size_t)G * 512) args.out[i] += (i == 0) ? 0.1f * da : 1e-3f * db;
    }
#endif
#undef IN
#undef SEAM
}

#ifndef N_LAUNCH_MODE
#define N_LAUNCH_MODE 0
#endif
extern "C" void kernel_launch(void* const* d_in, const int* in_sizes, int n_in, void* d_out, int out_size, void* d_ws, size_t ws_size, hipStream_t stream) {
    static int grid = 0;
    if (grid == 0) {
        if (n_in != 22 || out_size != MLAT * DM || ws_size < WS_END) { fprintf(stderr, "kernel_launch: unexpected shapes (n_in %d out %d ws %zu)\n", n_in, out_size, ws_size); grid = -1; return; }
        int dev = 0, cus = 0, per_cu = 0;
        if (hipGetDevice(&dev) != hipSuccess || hipDeviceGetAttribute(&cus, hipDeviceAttributeMultiprocessorCount, dev) != hipSuccess) { grid = -1; return; }
        if (hipFuncSetAttribute((const void*)dit_fwd, hipFuncAttributeMaxDynamicSharedMemorySize, LDS_BYTES) != hipSuccess) { fprintf(stderr, "kernel_launch: hipFuncSetAttribute failed\n"); grid = -1; return; }
        if (hipOccupancyMaxActiveBlocksPerMultiprocessor(&per_cu, (const void*)dit_fwd, 512, LDS_BYTES) != hipSuccess || per_cu < 1) { fprintf(stderr, "kernel_launch: occupancy query says %d\n", per_cu); per_cu = 1; }
        (void)hipGetLastError();
        grid = cus;
        if (grid % 8 != 0 || grid < 8) { fprintf(stderr, "kernel_launch: unexpected CU count %d\n", cus); }
    }
    if (grid < 0) return;
    (void)hipMemsetAsync((unsigned char*)d_ws + WS_BAR, 0, 65536, stream);
    Args a{};
    for (int i = 0; i < 22; ++i) a.in[i] = (const float*)d_in[i];
    a.out = (float*)d_out; a.ws = (unsigned char*)d_ws;
#if N_LAUNCH_MODE == 0
    a.ph_lo = 0; a.ph_hi = NPHASE;
    void* kargs[] = {&a};
    hipError_t e = hipLaunchCooperativeKernel((const void*)dit_fwd, dim3(grid), dim3(512), kargs, LDS_BYTES, stream);
    if (e != hipSuccess) fprintf(stderr, "kernel_launch: cooperative launch failed: %s (grid %d)\n", hipGetErrorString(e), grid);
#else
    for (int p = 0; p < NPHASE; ++p) { a.ph_lo = p; a.ph_hi = p + 1; hipLaunchKernelGGL(dit_fwd, dim3(grid), dim3(512), LDS_BYTES, stream, a); }
#endif
}
```

```cpp
#ifndef PRIO_FLIP
#define PRIO_FLIP 3
#define PRIO_FIRST 1
#endif
#include <hip/hip_runtime.h>
#include <hip/hip_cooperative_groups.h>
#include <cstdio>
#include <cstdint>
namespace cg = cooperative_groups;

#define LAS __attribute__((address_space(3)))
typedef unsigned short bf16_t;
typedef short bf16x8 __attribute__((ext_vector_type(8)));
typedef float f32x4 __attribute__((ext_vector_type(4)));
typedef float f32x16 __attribute__((ext_vector_type(16)));
typedef unsigned u32x4 __attribute__((ext_vector_type(4)));
typedef unsigned u32x2 __attribute__((ext_vector_type(2)));
typedef float f32x2_t __attribute__((ext_vector_type(2)));
typedef __bf16 bf16x2_t __attribute__((ext_vector_type(2)));
__device__ __forceinline__ unsigned pk_bf16(float lo, float hi) { f32x2_t v = {lo, hi}; bf16x2_t b = __builtin_convertvector(v, bf16x2_t); return __builtin_bit_cast(unsigned, b); }

constexpr int DM = 1024, NBATCH = 8, SEQ = 4096, CTXL = 256, DFF = 4096;
constexpr int MLAT = NBATCH * SEQ;
constexpr int MCTX = NBATCH * CTXL;
constexpr int MTOT = MLAT + MCTX;
constexpr float EPS_F = 1e-6f;
constexpr float LOG2E_F = 1.4426950408889634f;
constexpr float QSCALE = 0.125f * LOG2E_F;
constexpr float LAM_INIT = 0.35550906759096926f;
constexpr int NQK0 = 1280, NV0 = 256, NQK1 = 2048, NV1 = 1024;

#ifndef STAG_TILES
#define STAG_TILES 8
#endif
namespace pg8 {
#define PG8_LAS __attribute__((address_space(3)))
constexpr int BM = 256, BK = 64, HALF = 128, HTB = HALF * BK * 2  , STAGE_BYTES = 8 * HTB, NXCD = 8, WGM = 8;

__host__ __device__ __forceinline__ int lds_byte(int r, int c) { const int st = (r >> 4) * 2 + (c >> 5), rr = r & 15, cc = c & 31, ob = rr * 64 + cc * 2; return st * 1024 + (ob ^ (((ob >> 9) & 1) << 5)); }
__host__ __device__ __forceinline__ void stage_rc(int b, int& R, int& C) { const int st = b / 1024, sb = b % 1024, swz = sb ^ (((sb >> 9) & 1) << 5); R = (st >> 1) * 16 + swz / 64; C = (st & 1) * 32 + (swz % 64) / 2; }
__host__ __device__ __forceinline__ int perm32(int rho) { const int n = rho >> 4, i = rho & 15; return 8 * (i >> 2) + 4 * n + (i & 3); }

struct Unit { int pm, pn, koff, nt, ord; };
struct Gemm { const bf16_t* A; const bf16_t* Bt; int M, N, K; };

struct StaticOrder {
    int nM, nN, nwg, G, c, ntf;
    __host__ __device__ void init(int M, int N, int G_, int c_, int K_) { nM = M / BM; nN = N / BM; nwg = nM * nN; G = G_; c = c_; ntf = K_ / BK; }
    __host__ __device__ bool next(int i, Unit& u) const {
        const long L = (long)i * G + c; if (L >= nwg) return false;
        int wgid = (int)L; { const int q = nwg / NXCD, r = nwg % NXCD, xcd = wgid % NXCD; int off = wgid / NXCD;
          if (STAG_TILES && nN == 16 && r == 0 && q % 128 == 0) off = (off + STAG_TILES * xcd) % q;
          wgid = (xcd < r ? xcd * (q + 1) : r * (q + 1) + (xcd - r) * q) + off; }
        const int nig = WGM * nN, gid = wgid / nig, fm = gid * WGM, gsz = (nM - fm) < WGM ? (nM - fm) : WGM;
        u.pm = fm + ((wgid % nig) % gsz); u.pn = (wgid % nig) / gsz; u.koff = 0; u.nt = ntf; u.ord = i; return true;
    }
    __device__ __forceinline__ void a_ready(const Unit&) const {}
    __device__ __forceinline__ void done(const Unit&) const {}
};

__device__ __forceinline__ int batch_of_tile(int p) { return p < 128 ? (p >> 4) : 8; }
__device__ __forceinline__ float row_rstd(const float* ss, int row) {
    const f32x4* sp = (const f32x4*)(ss + (size_t)row * 16);
    const f32x4 a = sp[0], b = sp[1], c = sp[2], d = sp[3];
    const f32x4 t = (a + b) + (c + d);
    const float tot = (t[0] + t[1]) + (t[2] + t[3]);
    return rsqrtf(tot * (1.0f / 1024.0f) + EPS_F);
}

__device__ __forceinline__ void rows_rstd8(float (&rsv)[2][4], const float* ss, int row0, int fq) {
    f32x4 a[2][4];
#pragma unroll
    for (int ai = 0; ai < 2; ++ai)
#pragma unroll
        for (int m = 0; m < 4; ++m) a[ai][m] = *(const f32x4*)(ss + (size_t)(row0 + ai * HALF + m * 16) * 16 + 4 * fq);
#pragma unroll
    for (int ai = 0; ai < 2; ++ai)
#pragma unroll
        for (int m = 0; m < 4; ++m) {
            float t = (a[ai][m][0] + a[ai][m][1]) + (a[ai][m][2] + a[ai][m][3]);
            t += __shfl_xor(t, 16); t += __shfl_xor(t, 32);
            rsv[ai][m] = rsqrtf(t * (1.0f / 1024.0f) + EPS_F);
        }
}
constexpr int RSTAB_OFF = 131072 + 256, RSTAB_MAX_UNITS = 15, ROPE_LDS_OFF = RSTAB_OFF + 6144, BIASTAB_OFF = RSTAB_OFF + 15360;
template <class Sched, bool BY_PN>
__device__ __forceinline__ void fill_rstd_table(PG8_LAS unsigned char* lds, const Sched& S, const float* ss, const float* ropetab = nullptr, const float* bias = nullptr, int bstride = 0) {
    PG8_LAS float* tab = (PG8_LAS float*)(lds + RSTAB_OFF);
    PG8_LAS float* btab = (PG8_LAS float*)(lds + BIASTAB_OFF);
    const int t = threadIdx.x;
    if (ropetab) { *(PG8_LAS f32x4*)(lds + ROPE_LDS_OFF + t * 16) = *(const f32x4*)(ropetab + t * 4); }
#pragma unroll 4
    for (int i0 = 0; i0 < RSTAB_MAX_UNITS + 1; i0 += 2) {
        Unit u; const int i = i0 + (t >> 8);
        if (i < RSTAB_MAX_UNITS && S.next(i, u)) {
            tab[i * 256 + (t & 255)] = row_rstd(ss, (BY_PN ? u.pn : u.pm) * BM + (t & 255));
            if (bias) btab[i * 256 + (t & 255)] = bias[(size_t)batch_of_tile(BY_PN ? u.pn : u.pm) * bstride + (BY_PN ? u.pm : u.pn) * BM + (t & 255)];
        }
    }
    __syncthreads();
}
struct EpiQK {
    static constexpr bool PERM = false, AFTER_DRAIN = false;
    bf16_t* O; int ldc; const float* ss; const float* bias; unsigned ropemask, scalemask; const float* ropetab; PG8_LAS unsigned char* lds_base;
    __device__ __forceinline__ void operator()(const f32x4 (&acc)[2][2][4][2], const Unit& u, int wr, int wc, int fr, int fq) const {
        const int bidx = batch_of_tile(u.pm);
        const int colb = u.pn * BM + wc * 32 + 4 * fq;
        f32x4 bv[2][2];
#pragma unroll
        for (int bj = 0; bj < 2; ++bj)
#pragma unroll
            for (int n = 0; n < 2; ++n) bv[bj][n] = *(const PG8_LAS f32x4*)(lds_base + BIASTAB_OFF + (u.ord * 256 + wc * 32 + 4 * fq + bj * HALF + n * 16) * 4);
        const PG8_LAS float* rtab = (const PG8_LAS float*)(lds_base + RSTAB_OFF) + u.ord * 256 + wr * 64 + fr;
#pragma unroll
        for (int ai = 0; ai < 2; ++ai) {
#pragma unroll
            for (int m = 0; m < 4; ++m) {
                const int row = u.pm * BM + ai * HALF + wr * 64 + m * 16 + fr;
                const float rs = rtab[ai * HALF + m * 16];
                const bool islat = row < MLAT;
                const int tpos = row & (SEQ - 1);
                const int pos = (wc & 1) ? (tpos & 63) : (tpos >> 6);
                const PG8_LAS f32x4* rt = (const PG8_LAS f32x4*)(lds_base + ROPE_LDS_OFF + (pos * 16 + 4 * fq) * 8);
                const f32x4 c0 = rt[0], c1 = rt[1];
                const float cc[4] = {c0[0], c0[2], c1[0], c1[2]}, sn[4] = {c0[1], c0[3], c1[1], c1[3]};
                bf16_t* rowp = O + (size_t)row * ldc + colb;
#pragma unroll
                for (int bj = 0; bj < 2; ++bj) {
                    const int c128 = u.pn * 2 + bj;
                    f32x4 v0 = acc[ai][bj][m][0] * rs + bv[bj][0], v1 = acc[ai][bj][m][1] * rs + bv[bj][1];
                    if (((ropemask >> c128) & 1u) && islat) {
#pragma unroll
                        for (int e = 0; e < 4; ++e) { const float x0 = v0[e], x1 = v1[e]; v0[e] = x0 * cc[e] - x1 * sn[e]; v1[e] = x1 * cc[e] + x0 * sn[e]; }
                    }
                    if ((scalemask >> c128) & 1u) { v0 = v0 * QSCALE; v1 = v1 * QSCALE; }
                    unsigned ax = pk_bf16(v0[0], v0[1]), ay = pk_bf16(v0[2], v0[3]), bx = pk_bf16(v1[0], v1[1]), by = pk_bf16(v1[2], v1[3]);
                    { auto r0 = __builtin_amdgcn_permlane16_swap(ax, bx, false, false); ax = r0[0]; bx = r0[1]; auto r1 = __builtin_amdgcn_permlane16_swap(ay, by, false, false); ay = r1[0]; by = r1[1]; }
                    u32x4 w; w.x = ax; w.y = ay; w.z = bx; w.w = by;
                    *(u32x4*)(rowp - 4 * fq + ((fq & 1) ? 16 + 4 * (fq - 1) : 4 * fq) + bj * HALF) = w;
                }
            }
        }
    }
};

struct EpiVT {
    static constexpr bool PERM = true, AFTER_DRAIN = false;
    bf16_t* O; int ldc; const float* ss; const float* bias; int NV; PG8_LAS unsigned char* lds_base;
    __device__ __forceinline__ void operator()(const f32x4 (&acc)[2][2][4][2], const Unit& u, int wr, int wc, int fr, int fq) const {
        const int bidx = batch_of_tile(u.pn);
        const int tok0 = u.pn * BM + wc * 32 + 8 * fq;
        float rr[2][8];
        { const PG8_LAS float* rtab = (const PG8_LAS float*)(lds_base + RSTAB_OFF) + u.ord * 256 + wc * 32 + 8 * fq;
#pragma unroll
          for (int bj = 0; bj < 2; ++bj) { const f32x4 a = *(const PG8_LAS f32x4*)(rtab + bj * HALF), b2 = *(const PG8_LAS f32x4*)(rtab + bj * HALF + 4);
              rr[bj][0] = a[0]; rr[bj][1] = a[1]; rr[bj][2] = a[2]; rr[bj][3] = a[3]; rr[bj][4] = b2[0]; rr[bj][5] = b2[1]; rr[bj][6] = b2[2]; rr[bj][7] = b2[3]; } }
        float bb[2][4];
#pragma unroll
        for (int ai = 0; ai < 2; ++ai)
#pragma unroll
            for (int m = 0; m < 4; ++m) bb[ai][m] = *(const PG8_LAS float*)(lds_base + BIASTAB_OFF + (u.ord * 256 + ai * HALF + wr * 64 + m * 16 + fr) * 4);
#pragma unroll
        for (int ai = 0; ai < 2; ++ai)
#pragma unroll
            for (int m = 0; m < 4; ++m) {
                const int nrow = u.pm * BM + ai * HALF + wr * 64 + m * 16 + fr;
                const float b = bb[ai][m];
                bf16_t* rowp = O + (size_t)nrow * ldc + tok0;
#pragma unroll
                for (int bj = 0; bj < 2; ++bj) {
                    const f32x4 a0 = acc[ai][bj][m][0], a1 = acc[ai][bj][m][1];
                    u32x4 w;
                    w.x = pk_bf16(a0[0] * rr[bj][0] + b, a0[1] * rr[bj][1] + b); w.y = pk_bf16(a0[2] * rr[bj][2] + b, a0[3] * rr[bj][3] + b);
                    w.z = pk_bf16(a1[0] * rr[bj][4] + b, a1[1] * rr[bj][5] + b); w.w = pk_bf16(a1[2] * rr[bj][6] + b, a1[3] * rr[bj][7] + b);
                    *(u32x4*)(rowp + bj * HALF) = w;
                }
            }
    }
};

struct EpiUp {
    static constexpr bool PERM = true, AFTER_DRAIN = false;
    bf16_t* O; const float* ss; const float* bias; PG8_LAS unsigned char* lds_base;
    __device__ __forceinline__ void operator()(const f32x4 (&acc)[2][2][4][2], const Unit& u, int wr, int wc, int fr, int fq) const {
        const int bidx = batch_of_tile(u.pm);
        const int colb = u.pn * BM + wc * 32 + 8 * fq;
        f32x4 bv[2][2];
#pragma unroll
        for (int bj = 0; bj < 2; ++bj)
#pragma unroll
            for (int n = 0; n < 2; ++n) bv[bj][n] = *(const PG8_LAS f32x4*)(lds_base + BIASTAB_OFF + (u.ord * 256 + wc * 32 + 8 * fq + bj * HALF + 4 * n) * 4);
        const PG8_LAS float* rtab = (const PG8_LAS float*)(lds_base + RSTAB_OFF) + u.ord * 256 + wr * 64 + fr;
#pragma unroll
        for (int ai = 0; ai < 2; ++ai)
#pragma unroll
            for (int m = 0; m < 4; ++m) {
                const int row = u.pm * BM + ai * HALF + wr * 64 + m * 16 + fr;
                const float rs = rtab[ai * HALF + m * 16];
                bf16_t* rowp = O + (size_t)row * DFF + colb;
#pragma unroll
                for (int bj = 0; bj < 2; ++bj) {
                    f32x4 v0 = acc[ai][bj][m][0] * rs + bv[bj][0], v1 = acc[ai][bj][m][1] * rs + bv[bj][1];
#pragma unroll
                    for (int e = 0; e < 4; ++e) { const float a = fmaxf(v0[e], 0.f), b = fmaxf(v1[e], 0.f); v0[e] = a * a; v1[e] = b * b; }
                    u32x4 w; w.x = pk_bf16(v0[0], v0[1]); w.y = pk_bf16(v0[2], v0[3]); w.z = pk_bf16(v1[0], v1[1]); w.w = pk_bf16(v1[2], v1[3]);
                    *(u32x4*)(rowp + bj * HALF) = w;
                }
            }
    }
};

__device__ __forceinline__ f32x4 ld_bf4(const bf16_t* p) { const u32x2 w = *(const u32x2*)p; f32x4 v; v[0] = __uint_as_float(w.x << 16); v[1] = __uint_as_float(w.x & 0xffff0000u); v[2] = __uint_as_float(w.y << 16); v[3] = __uint_as_float(w.y & 0xffff0000u); return v; }
template <bool HIN_BF, bool HOUT_BF>
struct EpiResT {
    static constexpr bool PERM = true, AFTER_DRAIN = false;
    const void* hin_lat; const void* hin_ctx; void* hout; bf16_t* xg; float* ss;
    const float* gate; const float* scl; const float* ng;
    __device__ __forceinline__ void operator()(const f32x4 (&acc)[2][2][4][2], const Unit& u, int wr, int wc, int fr, int fq) const {
        const int bidx = batch_of_tile(u.pm);
        const int colb = u.pn * BM + wc * 32 + 8 * fq;
        f32x4 gv[2][2], gp[2][2];
#pragma unroll
        for (int bj = 0; bj < 2; ++bj)
#pragma unroll
            for (int n = 0; n < 2; ++n) {
                const int c = colb + bj * HALF + n * 4;
                gv[bj][n] = *(const f32x4*)(gate + (size_t)bidx * 6144 + c);
                if (xg) { const f32x4 s = *(const f32x4*)(scl + (size_t)bidx * 6144 + c); const f32x4 g = *(const f32x4*)(ng + c); gp[bj][n] = g * (s + 1.0f); }
                else gp[bj][n] = (f32x4){0.f, 0.f, 0.f, 0.f};
            }
        constexpr int RB = 2;
#pragma unroll
        for (int ab = 0; ab < 8 / RB; ++ab) {
            f32x4 hv[RB][2][2]; u32x4 hr[RB][2];
#pragma unroll
            for (int q = 0; q < RB; ++q) {
                const int am = ab * RB + q, ai = am >> 2, m = am & 3;
                const int row = u.pm * BM + ai * HALF + wr * 64 + m * 16 + fr;
                const size_t hoff = (row < MLAT ? (size_t)row : (size_t)(row - MLAT)) * DM + colb;
                const void* hb = row < MLAT ? hin_lat : hin_ctx;
#pragma unroll
                for (int bj = 0; bj < 2; ++bj) {
                    if (HIN_BF) hr[q][bj] = *(const u32x4*)((const bf16_t*)hb + hoff + bj * HALF);
                    else { hv[q][bj][0] = *(const f32x4*)((const float*)hb + hoff + bj * HALF); hv[q][bj][1] = *(const f32x4*)((const float*)hb + hoff + bj * HALF + 4); }
                }
            }
#pragma unroll
            for (int q = 0; q < RB; ++q) {
                const int am = ab * RB + q, ai = am >> 2, m = am & 3;
                const int row = u.pm * BM + ai * HALF + wr * 64 + m * 16 + fr;
                float ssum = 0.f;
#pragma unroll
                for (int bj = 0; bj < 2; ++bj) {
                    f32x4 v[2];
#pragma unroll
                    for (int n = 0; n < 2; ++n) {
                        f32x4 hq;
                        if (HIN_BF) { const unsigned w0 = n ? hr[q][bj].z : hr[q][bj].x, w1 = n ? hr[q][bj].w : hr[q][bj].y;
                            hq[0] = __uint_as_float(w0 << 16); hq[1] = __uint_as_float(w0 & 0xffff0000u); hq[2] = __uint_as_float(w1 << 16); hq[3] = __uint_as_float(w1 & 0xffff0000u); }
                        else hq = hv[q][bj][n];
                        v[n] = hq + gv[bj][n] * acc[ai][bj][m][n];
                        ssum += (v[n][0] * v[n][0] + v[n][1] * v[n][1]) + (v[n][2] * v[n][2] + v[n][3] * v[n][3]);
                    }
                    const size_t oo = (size_t)row * DM + colb + bj * HALF;
                    if (HOUT_BF) { u32x4 w; w.x = pk_bf16(v[0][0], v[0][1]); w.y = pk_bf16(v[0][2], v[0][3]); w.z = pk_bf16(v[1][0], v[1][1]); w.w = pk_bf16(v[1][2], v[1][3]); *(u32x4*)((bf16_t*)hout + oo) = w; }
                    else { *(f32x4*)((float*)hout + oo) = v[0]; *(f32x4*)((float*)hout + oo + 4) = v[1]; }
                    if (xg) { const f32x4 y0 = v[0] * gp[bj][0], y1 = v[1] * gp[bj][1]; u32x4 w; w.x = pk_bf16(y0[0], y0[1]); w.y = pk_bf16(y0[2], y0[3]); w.z = pk_bf16(y1[0], y1[1]); w.w = pk_bf16(y1[2], y1[3]); *(u32x4*)(xg + oo) = w; }
                }
                ssum += __shfl_xor(ssum, 16); ssum += __shfl_xor(ssum, 32);
                if (fq == 0) ss[(size_t)row * 16 + u.pn * 4 + wc] = ssum;
            }
        }
    }
};
typedef EpiResT<false, false> EpiRes;

struct EpiFinal {
    static constexpr bool PERM = false, AFTER_DRAIN = false;
    const float* hin; float* out; float* ss; const float* gate; const float* fg; unsigned* cnt;
    __device__ __forceinline__ void operator()(f32x4 (&acc)[2][2][4][2], const Unit& u, int wr, int wc, int fr, int fq) const {
        const int bidx = batch_of_tile(u.pm);
        const int colb = u.pn * BM + wc * 32 + 4 * fq;
        f32x4 gv[2][2];
#pragma unroll
        for (int bj = 0; bj < 2; ++bj)
#pragma unroll
            for (int n = 0; n < 2; ++n) gv[bj][n] = *(const f32x4*)(gate + (size_t)bidx * 6144 + colb + bj * HALF + n * 16);
#pragma unroll
        for (int ai = 0; ai < 2; ++ai)
#pragma unroll
            for (int m = 0; m < 4; ++m) {
                const int row = u.pm * BM + ai * HALF + wr * 64 + m * 16 + fr;
                const float* hp = hin + (size_t)row * DM + colb;
                float ssum = 0.f;
#pragma unroll
                for (int bj = 0; bj < 2; ++bj)
#pragma unroll
                    for (int n = 0; n < 2; ++n) {
                        const f32x4 v = *(const f32x4*)(hp + bj * HALF + n * 16) + gv[bj][n] * acc[ai][bj][m][n];
                        acc[ai][bj][m][n] = v;
                        ssum += (v[0] * v[0] + v[1] * v[1]) + (v[2] * v[2] + v[3] * v[3]);
                    }
                ssum += __shfl_xor(ssum, 16); ssum += __shfl_xor(ssum, 32);
                if (fq == 0) __hip_atomic_store(ss + (size_t)row * 16 + u.pn * 4 + wc, ssum, __ATOMIC_RELAXED, __HIP_MEMORY_SCOPE_AGENT);
            }
        asm volatile("s_waitcnt vmcnt(0)" ::: "memory");
        unsigned* cw = cnt + 64 * u.pm;
        if ((threadIdx.x & 63) == 0) __hip_atomic_fetch_add(cw, 1u, __ATOMIC_RELAXED, __HIP_MEMORY_SCOPE_AGENT);
        { const unsigned long long t0 = __builtin_amdgcn_s_memrealtime();
          while ((unsigned)__builtin_amdgcn_readfirstlane(__hip_atomic_load(cw, __ATOMIC_RELAXED, __HIP_MEMORY_SCOPE_AGENT)) < 32u) {
              if (__builtin_amdgcn_s_memrealtime() - t0 > 1000000ull) break;
              __builtin_amdgcn_s_sleep(2); } }
        __builtin_amdgcn_fence(__ATOMIC_ACQUIRE, "agent");
        asm volatile("s_waitcnt vmcnt(0)" ::: "memory");
        f32x4 fv[2][2];
#pragma unroll
        for (int bj = 0; bj < 2; ++bj)
#pragma unroll
            for (int n = 0; n < 2; ++n) fv[bj][n] = *(const f32x4*)(fg + colb + bj * HALF + n * 16);
#pragma unroll
        for (int ai = 0; ai < 2; ++ai)
#pragma unroll
            for (int m = 0; m < 4; ++m) {
                const int row = u.pm * BM + ai * HALF + wr * 64 + m * 16 + fr;
                const float rs = row_rstd(ss, row);
                float* op = out + (size_t)row * DM + colb;
#pragma unroll
                for (int bj = 0; bj < 2; ++bj)
#pragma unroll
                    for (int n = 0; n < 2; ++n) *(f32x4*)(op + bj * HALF + n * 16) = acc[ai][bj][m][n] * rs * fv[bj][n];
            }
    }
};

struct SplitCtxOrder {
    int c, nts;
    __host__ __device__ void init(int c_, int K_) { c = c_; nts = K_ / BK / 8; }
    __host__ __device__ bool next(int i, Unit& u) const {
        if (i != 0) return false;
        const int ti = c >> 3, ks = c & 7;
        u.pm = 128 + (ti >> 2); u.pn = ti & 3; u.nt = nts; u.koff = ks * nts * BK; u.ord = 0; return true;
    }
    __device__ __forceinline__ void a_ready(const Unit&) const {}
    __device__ __forceinline__ void done(const Unit&) const {}
};
struct EpiSlab {
    static constexpr bool PERM = true, AFTER_DRAIN = false;
    float* slab_lo; float* slab_hi;
    __device__ __forceinline__ void operator()(const f32x4 (&acc)[2][2][4][2], const Unit& u, int wr, int wc, int fr, int fq) const {
        const int ks = u.koff / (u.nt * BK);
        bf16_t* sl = (bf16_t*)slab_lo + (size_t)ks * MCTX * DM;
        const int colb = u.pn * BM + wc * 32 + 8 * fq;
#pragma unroll
        for (int ai = 0; ai < 2; ++ai)
#pragma unroll
            for (int m = 0; m < 4; ++m) {
                const int row = (u.pm - 128) * BM + ai * HALF + wr * 64 + m * 16 + fr;
                bf16_t* op = sl + (size_t)row * DM + colb;
#pragma unroll
                for (int bj = 0; bj < 2; ++bj) {
                    const f32x4 a0 = acc[ai][bj][m][0], a1 = acc[ai][bj][m][1];
                    u32x4 w; w.x = pk_bf16(a0[0], a0[1]); w.y = pk_bf16(a0[2], a0[3]); w.z = pk_bf16(a1[0], a1[1]); w.w = pk_bf16(a1[2], a1[3]);
                    *(u32x4*)(op + bj * HALF) = w;
                }
            }
    }
};

template <class Epi, class Sched, bool ALIGN_EPI = false, bool SP2 = false>
__device__ __forceinline__ void gemm_phase(PG8_LAS unsigned char* lds, const Gemm g, const Sched& S, const Epi& E) {
    const int tid = threadIdx.x, wid = __builtin_amdgcn_readfirstlane(tid >> 6), lane = tid & 63, wr = wid >> 2, wc = wid & 3, fr = lane & 15, fq = lane >> 4;
    const int K = g.K;
    unsigned voffA[2], voffB[2];
#pragma unroll
    for (int i = 0; i < 2; ++i) { int R, C; stage_rc(tid * 16 + i * 8192, R, C); const int Rb = Epi::PERM ? ((R & ~31) + perm32(R & 31)) : R;
        voffA[i] = (unsigned)(R * K + C) * 2u; voffB[i] = (unsigned)(Rb * K + C) * 2u; }
    const size_t kstep = (size_t)(BK * 2);
    const size_t hstep = (size_t)HALF * K * 2;
    const size_t tstep = 2 * hstep;
    const unsigned ldsw = (unsigned)wid * 1024u;
    const int aoff = lds_byte(wr * 64 + fr, fq * 8), boff = lds_byte(wc * 32 + fr, fq * 8);
#define PG8_SA(b, h) (((b) * 2 + (h)) * HTB)
#define PG8_SB(b, h) ((4 + (b) * 2 + (h)) * HTB)
#define PG8_STAGE(bufoff, gbase, voff) do { _Pragma("unroll") for (int _i = 0; _i < 2; ++_i) \
        __builtin_amdgcn_global_load_lds((const unsigned*)((const char*)(gbase) + (voff)[_i]), (PG8_LAS unsigned*)(lds + (bufoff) + ldsw + _i * 8192), 16, 0, 0); } while (0)
#define PG8_LDA(dst, b, h) do { _Pragma("unroll") for (int m = 0; m < 4; ++m) _Pragma("unroll") for (int k = 0; k < 2; ++k) dst[m][k] = *(const PG8_LAS bf16x8*)(lds + PG8_SA(b, h) + aoff + m * 2048 + k * 1024); } while (0)
#define PG8_LDB(dst, b, h) do { _Pragma("unroll") for (int n = 0; n < 2; ++n) _Pragma("unroll") for (int k = 0; k < 2; ++k) dst[n][k] = *(const PG8_LAS bf16x8*)(lds + PG8_SB(b, h) + boff + n * 2048 + k * 1024); } while (0)
#define PG8_MMA(ai, bj, At, Bt) do { __builtin_amdgcn_s_setprio(1); _Pragma("unroll") for (int m = 0; m < 4; ++m) _Pragma("unroll") for (int n = 0; n < 2; ++n) _Pragma("unroll") for (int k = 0; k < 2; ++k) \
        acc[ai][bj][m][n] = __builtin_amdgcn_mfma_f32_16x16x32_bf16(Bt[n][k], At[m][k], acc[ai][bj][m][n], 0, 0, 0); __builtin_amdgcn_s_setprio(0); } while (0)
#define PG8_WAIT_V(n) asm volatile("s_waitcnt vmcnt(" #n ")" ::: "memory")
#define PG8_WAIT_L(n) asm volatile("s_waitcnt lgkmcnt(" #n ")" ::: "memory")
#define PG8_BAR __builtin_amdgcn_s_barrier()
#define PG8_SCHED __builtin_amdgcn_sched_barrier(0)
    Unit cur, nxt; int ui = 0;
    if (!S.next(0, cur)) return;
    f32x4 acc[2][2][4][2];
#pragma unroll
    for (int a = 0; a < 2; ++a)
#pragma unroll
        for (int b = 0; b < 2; ++b)
#pragma unroll
            for (int m = 0; m < 4; ++m)
#pragma unroll
                for (int n = 0; n < 2; ++n) acc[a][b][m][n] = (f32x4){0.f, 0.f, 0.f, 0.f};
    bf16x8 At[4][2], B0[2][2], B1[2][2];
    const char* cA = (const char*)g.A + (size_t)cur.pm * tstep + (size_t)cur.koff * 2; const char* cB = (const char*)g.Bt + (size_t)cur.pn * tstep + (size_t)cur.koff * 2;
    S.a_ready(cur);
    if constexpr (SP2) {
        PG8_STAGE(PG8_SB(0, 0), cB, voffB); PG8_STAGE(PG8_SB(0, 1), cB + hstep, voffB); PG8_STAGE(PG8_SA(0, 0), cA, voffA); PG8_STAGE(PG8_SA(0, 1), cA + hstep, voffA);
        if (wr == 1) PG8_BAR;
        PG8_WAIT_V(2); PG8_BAR;
        PG8_STAGE(PG8_SB(1, 0), cB + kstep, voffB); PG8_STAGE(PG8_SA(1, 0), cA + kstep, voffA); PG8_STAGE(PG8_SB(1, 1), cB + hstep + kstep, voffB);
        PG8_WAIT_V(6); PG8_BAR;
    } else {
        PG8_STAGE(PG8_SB(0, 0), cB, voffB); PG8_STAGE(PG8_SA(0, 0), cA, voffA); PG8_STAGE(PG8_SB(0, 1), cB + hstep, voffB); PG8_STAGE(PG8_SA(0, 1), cA + hstep, voffA);
        if (wr == 1) PG8_BAR;
        PG8_WAIT_V(4); PG8_BAR;
        PG8_STAGE(PG8_SB(1, 0), cB + kstep, voffB); PG8_STAGE(PG8_SA(1, 0), cA + kstep, voffA); PG8_STAGE(PG8_SB(1, 1), cB + hstep + kstep, voffB);
        PG8_WAIT_V(6); PG8_BAR;
    }
    for (;;) {
        const bool has_next = S.next(ui + 1, nxt);
        const char* nA = has_next ? (const char*)g.A + (size_t)nxt.pm * tstep + (size_t)nxt.koff * 2 : cA; const char* nB = has_next ? (const char*)g.Bt + (size_t)nxt.pn * tstep + (size_t)nxt.koff * 2 : cB;
        const int nt = cur.nt;
        for (int t = 0; t < nt; t += 2) {
            const bool last = (t == nt - 2);
            const char* a1 = cA + (size_t)(t + 1) * kstep;
            const char* a2 = last ? nA : cA + (size_t)(t + 2) * kstep; const char* b2 = last ? nB : cB + (size_t)(t + 2) * kstep;
            const char* a3 = a2 + kstep; const char* b3 = b2 + kstep;
            if (last && has_next) S.a_ready(nxt);
            if constexpr (SP2) {
            PG8_LDB(B0, 0, 0); PG8_LDB(B1, 0, 1); PG8_SCHED; PG8_LDA(At, 0, 0); PG8_STAGE(PG8_SA(1, 1), a1 + hstep, voffA);
            PG8_WAIT_V(8); PG8_WAIT_L(0); PG8_BAR; PG8_MMA(0, 0, At, B0); PG8_MMA(0, 1, At, B1); PG8_BAR; PG8_SCHED;
            PG8_LDA(At, 0, 1); PG8_STAGE(PG8_SB(0, 0), b2, voffB); PG8_STAGE(PG8_SB(0, 1), b2 + hstep, voffB); PG8_STAGE(PG8_SA(0, 0), a2, voffA);
            PG8_WAIT_V(8); PG8_WAIT_L(0); PG8_BAR; PG8_MMA(1, 0, At, B0); PG8_MMA(1, 1, At, B1); PG8_BAR; PG8_SCHED;
            PG8_LDB(B0, 1, 0); PG8_LDB(B1, 1, 1); PG8_SCHED; PG8_LDA(At, 1, 0); PG8_STAGE(PG8_SA(0, 1), a2 + hstep, voffA);
            PG8_WAIT_V(8); PG8_WAIT_L(0); PG8_BAR; PG8_MMA(0, 0, At, B0); PG8_MMA(0, 1, At, B1); PG8_BAR; PG8_SCHED;
            PG8_LDA(At, 1, 1); PG8_STAGE(PG8_SB(1, 0), b3, voffB); PG8_STAGE(PG8_SB(1, 1), b3 + hstep, voffB); PG8_STAGE(PG8_SA(1, 0), a3, voffA);
            PG8_WAIT_V(8); PG8_WAIT_L(0); PG8_BAR; PG8_MMA(1, 0, At, B0); PG8_MMA(1, 1, At, B1); PG8_BAR; PG8_SCHED;
            } else {
            PG8_LDB(B0, 0, 0); PG8_SCHED; PG8_LDA(At, 0, 0); PG8_STAGE(PG8_SA(1, 1), a1 + hstep, voffA);
            PG8_WAIT_L(8); PG8_BAR; PG8_WAIT_L(0); PG8_MMA(0, 0, At, B0); PG8_BAR; PG8_SCHED;
            PG8_LDB(B1, 0, 1); PG8_STAGE(PG8_SB(0, 0), b2, voffB);
            PG8_BAR; PG8_WAIT_L(0); PG8_MMA(0, 1, At, B1); PG8_BAR;
            PG8_LDA(At, 0, 1); PG8_STAGE(PG8_SA(0, 0), a2, voffA);
            PG8_BAR; PG8_WAIT_L(0); PG8_MMA(1, 0, At, B0); PG8_BAR; PG8_SCHED;
            PG8_STAGE(PG8_SB(0, 1), b2 + hstep, voffB);
            PG8_WAIT_V(6); PG8_BAR; PG8_MMA(1, 1, At, B1); PG8_BAR;
            PG8_LDB(B0, 1, 0); PG8_SCHED; PG8_LDA(At, 1, 0); PG8_STAGE(PG8_SA(0, 1), a2 + hstep, voffA);
            PG8_WAIT_L(8); PG8_BAR; PG8_WAIT_L(0); PG8_MMA(0, 0, At, B0); PG8_BAR; PG8_SCHED;
            PG8_LDB(B1, 1, 1); PG8_STAGE(PG8_SB(1, 0), b3, voffB);
            PG8_BAR; PG8_WAIT_L(0); PG8_MMA(0, 1, At, B1); PG8_BAR;
            PG8_LDA(At, 1, 1); PG8_STAGE(PG8_SA(1, 0), a3, voffA);
            PG8_BAR; PG8_WAIT_L(0); PG8_MMA(1, 0, At, B0); PG8_BAR; PG8_SCHED;
            PG8_STAGE(PG8_SB(1, 1), b3 + hstep, voffB);
            PG8_WAIT_V(6); PG8_BAR; PG8_MMA(1, 1, At, B1); PG8_BAR;
            }
        }
        if constexpr (ALIGN_EPI) { if (wr == 0) PG8_BAR; }
        if constexpr (!Epi::AFTER_DRAIN) { E(acc, cur, wr, wc, fr, fq); S.done(cur); }
        if (!has_next) break;
#pragma unroll
        for (int a = 0; a < 2; ++a)
#pragma unroll
            for (int b = 0; b < 2; ++b)
#pragma unroll
                for (int m = 0; m < 4; ++m)
#pragma unroll
                    for (int n = 0; n < 2; ++n) acc[a][b][m][n] = (f32x4){0.f, 0.f, 0.f, 0.f};
        cur = nxt; cA = nA; cB = nB; ++ui;
        if constexpr (ALIGN_EPI) { if (wr == 1) PG8_BAR; }
    }
    PG8_WAIT_V(0);
    if constexpr (!ALIGN_EPI) { if (wr == 0) PG8_BAR; }
    PG8_BAR;
    if constexpr (Epi::AFTER_DRAIN) { E.fused(acc, cur, wr, wc, fr, fq, lds, wid, lane); S.done(cur); }
#undef PG8_SA
#undef PG8_SB
#undef PG8_STAGE
#undef PG8_LDA
#undef PG8_LDB
#undef PG8_MMA
#undef PG8_WAIT_V
#undef PG8_WAIT_L
#undef PG8_BAR
#undef PG8_SCHED
}
}

namespace att {
#define MFMA32(a, b, c) __builtin_amdgcn_mfma_f32_32x32x16_bf16((a), (b), (c), 0, 0, 0)
__device__ __forceinline__ int koff(int r, int h) { return 16 * (r >> 3) + 8 * h + (r & 7); }
__device__ __forceinline__ int crow(int r, int h) { return (r & 3) + 8 * (r >> 2) + 4 * h; }
__device__ __forceinline__ float ex2(float x) { return __builtin_amdgcn_exp2f(x); }
__device__ __forceinline__ float wave_sum(float v) {
#pragma unroll
    for (int o = 1; o < 64; o <<= 1) v += __shfl_xor(v, o);
    return v;
}

__device__ __forceinline__ void qk_tile(f32x16 (&s)[2], const LAS unsigned char* Kt, const bf16x8 (&qf)[4], int pi, int h) {
    const int sw = (pi >> 1) & 7;
#pragma unroll
    for (int kb = 0; kb < 2; ++kb) {
        f32x16 a = {};
#pragma unroll
        for (int d0 = 0; d0 < 4; ++d0) {
            const bf16x8 kf = *(const LAS bf16x8*)(Kt + (32 * kb + pi) * 128 + (((2 * d0 + h) ^ sw) << 4));
            a = MFMA32(kf, qf[d0], a);
        }
        s[kb] = a;
    }
}
template <int DVB>
__device__ __forceinline__ void softmax_pv(f32x16 (&s)[2], const LAS unsigned char* VTt, f32x16 (&oT)[DVB], float& m_run, float& l_run, int i31, int h) {
    float mx = s[0][0];
#pragma unroll
    for (int r = 1; r < 16; ++r) mx = fmaxf(mx, s[0][r]);
#pragma unroll
    for (int r = 0; r < 16; ++r) mx = fmaxf(mx, s[1][r]);
    mx = fmaxf(mx, __shfl_xor(mx, 32));
    if (__any(mx > m_run)) {
        const float mn = fmaxf(m_run, mx); const float alpha = ex2(m_run - mn); m_run = mn; l_run *= alpha;
#pragma unroll
        for (int db = 0; db < DVB; ++db)
#pragma unroll
            for (int r = 0; r < 16; ++r) oT[db][r] *= alpha;
    }
    float ps = 0.f;
#pragma unroll
    for (int kb = 0; kb < 2; ++kb)
#pragma unroll
        for (int r = 0; r < 16; ++r) { const float p = ex2(s[kb][r] - m_run); s[kb][r] = p; ps += p; }
    l_run += ps;
    const int sw = (i31 >> 1) & 7;
#pragma unroll
    for (int kb = 0; kb < 2; ++kb)
#pragma unroll
        for (int st = 0; st < 2; ++st) {
            u32x4 pw;
            pw.x = pk_bf16(s[kb][8 * st + 0], s[kb][8 * st + 1]); pw.y = pk_bf16(s[kb][8 * st + 2], s[kb][8 * st + 3]);
            pw.z = pk_bf16(s[kb][8 * st + 4], s[kb][8 * st + 5]); pw.w = pk_bf16(s[kb][8 * st + 6], s[kb][8 * st + 7]);
            const bf16x8 pb = __builtin_bit_cast(bf16x8, pw);
#pragma unroll
            for (int db = 0; db < DVB; ++db) {
                const bf16x8 vf = *(const LAS bf16x8*)(VTt + (32 * db + i31) * 128 + (((4 * kb + 2 * st + h) ^ sw) << 4));
                oT[db] = MFMA32(vf, pb, oT[db]);
            }
        }
}


#ifndef THR2V
#define THR2V 6.0f
#endif
constexpr float THR2 = THR2V;
__device__ __forceinline__ void qk_tile2(f32x16 (&s)[2], const LAS unsigned char* Kt, const bf16x8 (&qf)[4], const f32x16& negm, int pi, int h) {
    const int sw = (pi >> 1) & 7;
#pragma unroll
    for (int kb = 0; kb < 2; ++kb) {
        f32x16 a = negm;
#pragma unroll
        for (int d0 = 0; d0 < 4; ++d0) {
            const bf16x8 kf = *(const LAS bf16x8*)(Kt + (32 * kb + pi) * 128 + (((2 * d0 + h) ^ sw) << 4));
            a = MFMA32(kf, qf[d0], a);
        }
        s[kb] = a;
    }
}
template <int DVB>
__device__ __forceinline__ void softmax_pv2(f32x16 (&s)[2], const LAS unsigned char* VTt, f32x16 (&oT)[DVB], f32x16& negm, float& m_run, float& l_run, bool first, int i31, int h) {
    float mx = fmaxf(fmaxf(s[0][0], s[0][1]), s[0][2]);
#pragma unroll
    for (int r = 3; r < 15; r += 2) mx = fmaxf(fmaxf(mx, s[0][r]), s[0][r + 1]);
    mx = fmaxf(mx, s[0][15]);
#pragma unroll
    for (int r = 0; r < 16; r += 2) mx = fmaxf(fmaxf(mx, s[1][r]), s[1][r + 1]);
    if (first || __any(mx > THR2)) {
        mx = fmaxf(mx, __shfl_xor(mx, 32));
        float delta = first ? mx : fmaxf(mx, 0.f);
        if (delta == -INFINITY) delta = 0.f;
        const float alpha = first ? 1.0f : ex2(-delta);
        m_run += delta; l_run *= alpha;
#pragma unroll
        for (int db = 0; db < DVB; ++db)
#pragma unroll
            for (int r = 0; r < 16; ++r) oT[db][r] *= alpha;
#pragma unroll
        for (int kb = 0; kb < 2; ++kb)
#pragma unroll
            for (int r = 0; r < 16; ++r) s[kb][r] -= delta;
        const float nm = -m_run;
#pragma unroll
        for (int r = 0; r < 16; ++r) negm[r] = nm;
    }
    float ps = 0.f;
#pragma unroll
    for (int kb = 0; kb < 2; ++kb)
#pragma unroll
        for (int r = 0; r < 16; ++r) { const float p = ex2(s[kb][r]); s[kb][r] = p; ps += p; }
    l_run += ps;
    const int sw = (i31 >> 1) & 7;
#pragma unroll
    for (int kb = 0; kb < 2; ++kb)
#pragma unroll
        for (int st = 0; st < 2; ++st) {
            u32x4 pw;
            pw.x = pk_bf16(s[kb][8 * st + 0], s[kb][8 * st + 1]); pw.y = pk_bf16(s[kb][8 * st + 2], s[kb][8 * st + 3]);
            pw.z = pk_bf16(s[kb][8 * st + 4], s[kb][8 * st + 5]); pw.w = pk_bf16(s[kb][8 * st + 6], s[kb][8 * st + 7]);
            const bf16x8 pb = __builtin_bit_cast(bf16x8, pw);
#pragma unroll
            for (int db = 0; db < DVB; ++db) {
                const bf16x8 vf = *(const LAS bf16x8*)(VTt + (32 * db + i31) * 128 + (((4 * kb + 2 * st + h) ^ sw) << 4));
                oT[db] = MFMA32(vf, pb, oT[db]);
            }
        }
}


#define ATT_SB() do {} while (0)
#ifdef ATT_PRIO
#define ATT_P1() __builtin_amdgcn_s_setprio(1)
#define ATT_P0() __builtin_amdgcn_s_setprio(0)
#else
#define ATT_P1() do {} while (0)
#define ATT_P0() do {} while (0)
#endif
__device__ __forceinline__ bf16x8 exp_pack8(f32x16& sv, const int st, float& ps) {
    float p[8];
#pragma unroll
    for (int j = 0; j < 8; ++j) { p[j] = ex2(sv[8 * st + j]); }
    ps += ((p[0] + p[1]) + (p[2] + p[3])) + ((p[4] + p[5]) + (p[6] + p[7]));
    u32x4 pw; pw.x = pk_bf16(p[0], p[1]); pw.y = pk_bf16(p[2], p[3]); pw.z = pk_bf16(p[4], p[5]); pw.w = pk_bf16(p[6], p[7]);
    return __builtin_bit_cast(bf16x8, pw);
}
struct NoMask { __device__ __forceinline__ void operator()(f32x16&, f32x16&) const {} };
template <int DVB, class MF = NoMask>
__device__ __forceinline__ void tile_compute(const LAS unsigned char* Kt, const LAS unsigned char* VTt, const bf16x8 (&qf)[4], f32x16 (&oT)[DVB], f32x16& negm,
                                             float& m_run, float& l_run, bool first, int pi, int i31, int h, const MF mf = MF()) {
#ifdef IGLP_ID
    __builtin_amdgcn_iglp_opt(IGLP_ID);
#endif
    const int swk = (pi >> 1) & 7, swv = (i31 >> 1) & 7;
    bf16x8 kf[8];
#pragma unroll
    for (int kb = 0; kb < 2; ++kb)
#pragma unroll
        for (int d0 = 0; d0 < 4; ++d0) kf[kb * 4 + d0] = *(const LAS bf16x8*)(Kt + (32 * kb + pi) * 128 + (((2 * d0 + h) ^ swk) << 4));
    ATT_SB();
    f32x16 s0 = negm, s1 = negm;
    bf16x8 vf[4][DVB];
#pragma unroll
    for (int d0 = 0; d0 < 4; ++d0) { s0 = MFMA32(kf[d0], qf[d0], s0); s1 = MFMA32(kf[4 + d0], qf[d0], s1); }
#pragma unroll
    for (int j = 0; j < 2; ++j)
#pragma unroll
        for (int db = 0; db < DVB; ++db) vf[j][db] = *(const LAS bf16x8*)(VTt + (32 * db + i31) * 128 + (((2 * j + h) ^ swv) << 4));
    ATT_SB();
    mf(s0, s1);
    float mx = fmaxf(fmaxf(s0[0], s0[1]), s0[2]);
#pragma unroll
    for (int r = 3; r < 15; r += 2) mx = fmaxf(fmaxf(mx, s0[r]), s0[r + 1]);
    mx = fmaxf(mx, s0[15]);
#pragma unroll
    for (int r = 0; r < 16; r += 2) mx = fmaxf(fmaxf(mx, s1[r]), s1[r + 1]);
    if (first || __any(mx > THR2)) {
        mx = fmaxf(mx, __shfl_xor(mx, 32));
        float delta = first ? mx : fmaxf(mx, 0.f);
        if (delta == -INFINITY) delta = 0.f;
        const float alpha = first ? 1.0f : ex2(-delta);
        m_run += delta; l_run *= alpha;
#pragma unroll
        for (int db = 0; db < DVB; ++db)
#pragma unroll
            for (int r = 0; r < 16; ++r) oT[db][r] *= alpha;
#pragma unroll
        for (int r = 0; r < 16; ++r) { s0[r] -= delta; s1[r] -= delta; }
        const float nm = -m_run;
#pragma unroll
        for (int r = 0; r < 16; ++r) negm[r] = nm;
    }
    ATT_SB();
    float ps = 0.f;
    bf16x8 pb0 = exp_pack8(s0, 0, ps);
#pragma unroll
    for (int j = 2; j < 4; ++j)
#pragma unroll
        for (int db = 0; db < DVB; ++db) vf[j][db] = *(const LAS bf16x8*)(VTt + (32 * db + i31) * 128 + (((2 * j + h) ^ swv) << 4));
    ATT_SB();
#pragma unroll
    for (int db = 0; db < DVB; ++db) { ATT_P1(); oT[db] = MFMA32(vf[0][db], pb0, oT[db]); ATT_P0(); }
    bf16x8 pb1 = exp_pack8(s0, 1, ps);
    ATT_SB();
#pragma unroll
    for (int db = 0; db < DVB; ++db) { ATT_P1(); oT[db] = MFMA32(vf[1][db], pb1, oT[db]); ATT_P0(); }
    bf16x8 pb2 = exp_pack8(s1, 0, ps);
    ATT_SB();
#pragma unroll
    for (int db = 0; db < DVB; ++db) { ATT_P1(); oT[db] = MFMA32(vf[2][db], pb2, oT[db]); ATT_P0(); }
    bf16x8 pb3 = exp_pack8(s1, 1, ps);
    ATT_SB();
#pragma unroll
    for (int db = 0; db < DVB; ++db) { ATT_P1(); oT[db] = MFMA32(vf[3][db], pb3, oT[db]); ATT_P0(); }
    l_run += ps;
    ATT_SB();
}


template <int DVB>
__device__ __forceinline__ void tile_compute128(const LAS unsigned char* KtA, const LAS unsigned char* VTtA, const LAS unsigned char* KtB, const LAS unsigned char* VTtB, const bf16x8 (&qf)[4],
                                                f32x16 (&oT)[DVB], f32x16& negm, float& m_run, float& l_run, bool first, int pi, int i31, int h, bool young = false) {
    const int swk = (pi >> 1) & 7, swv = (i31 >> 1) & 7;
#ifdef PRIO_FLIP
    if (young) __builtin_amdgcn_s_setprio(PRIO_FIRST);
#endif
    f32x16 a0 = negm, a1 = negm, b0 = negm, b1 = negm;
    {
        bf16x8 kf[8];
#pragma unroll
        for (int kb = 0; kb < 2; ++kb)
#pragma unroll
            for (int d0 = 0; d0 < 4; ++d0) kf[kb * 4 + d0] = *(const LAS bf16x8*)(KtA + (32 * kb + pi) * 128 + (((2 * d0 + h) ^ swk) << 4));
#pragma unroll
        for (int d0 = 0; d0 < 4; ++d0) { a0 = MFMA32(kf[d0], qf[d0], a0); a1 = MFMA32(kf[4 + d0], qf[d0], a1); }
    }
    {
        bf16x8 kf[8];
#pragma unroll
        for (int kb = 0; kb < 2; ++kb)
#pragma unroll
            for (int d0 = 0; d0 < 4; ++d0) kf[kb * 4 + d0] = *(const LAS bf16x8*)(KtB + (32 * kb + pi) * 128 + (((2 * d0 + h) ^ swk) << 4));
#pragma unroll
        for (int d0 = 0; d0 < 4; ++d0) { b0 = MFMA32(kf[d0], qf[d0], b0); b1 = MFMA32(kf[4 + d0], qf[d0], b1); }
    }
    float mx = fmaxf(fmaxf(a0[0], a0[1]), a0[2]), my = fmaxf(fmaxf(b0[0], b0[1]), b0[2]);
#pragma unroll
    for (int r = 3; r < 15; r += 2) { mx = fmaxf(fmaxf(mx, a0[r]), a0[r + 1]); my = fmaxf(fmaxf(my, b0[r]), b0[r + 1]); }
    mx = fmaxf(mx, a0[15]); my = fmaxf(my, b0[15]);
#pragma unroll
    for (int r = 0; r < 16; r += 2) { mx = fmaxf(fmaxf(mx, a1[r]), a1[r + 1]); my = fmaxf(fmaxf(my, b1[r]), b1[r + 1]); }
    mx = fmaxf(mx, my);
    if (first || __any(mx > THR2)) {
        mx = fmaxf(mx, __shfl_xor(mx, 32));
        float delta = first ? mx : fmaxf(mx, 0.f);
        if (delta == -INFINITY) delta = 0.f;
        const float alpha = first ? 1.0f : ex2(-delta);
        m_run += delta; l_run *= alpha;
#pragma unroll
        for (int db = 0; db < DVB; ++db)
#pragma unroll
            for (int r = 0; r < 16; ++r) oT[db][r] *= alpha;
#pragma unroll
        for (int r = 0; r < 16; ++r) { a0[r] -= delta; a1[r] -= delta; b0[r] -= delta; b1[r] -= delta; }
        const float nm = -m_run;
#pragma unroll
        for (int r = 0; r < 16; ++r) negm[r] = nm;
    }
    float ps = 0.f;
#if defined(PRIO_FLIP) && PRIO_FLIP == 1
    if (young) __builtin_amdgcn_s_setprio(1 - PRIO_FIRST);
#endif
    {
#pragma unroll
        for (int jp = 0; jp < 2; ++jp) {
#if defined(PRIO_FLIP) && PRIO_FLIP == 3
            if (jp == 1 && young) __builtin_amdgcn_s_setprio(1 - PRIO_FIRST);
#endif
            bf16x8 vf[2][DVB];
#pragma unroll
            for (int j = 0; j < 2; ++j)
#pragma unroll
                for (int db = 0; db < DVB; ++db) vf[j][db] = *(const LAS bf16x8*)(VTtA + (32 * db + i31) * 128 + (((2 * (2 * jp + j) + h) ^ swv) << 4));
            const bf16x8 p0 = exp_pack8(jp == 0 ? a0 : a1, 0, ps), p1 = exp_pack8(jp == 0 ? a0 : a1, 1, ps);
#pragma unroll
            for (int db = 0; db < DVB; ++db) oT[db] = MFMA32(vf[0][db], p0, oT[db]);
#pragma unroll
            for (int db = 0; db < DVB; ++db) oT[db] = MFMA32(vf[1][db], p1, oT[db]);
        }
    }
#if defined(PRIO_FLIP) && PRIO_FLIP == 2
    if (young) __builtin_amdgcn_s_setprio(1 - PRIO_FIRST);
#endif
    {
#pragma unroll
        for (int jp = 0; jp < 2; ++jp) {
            bf16x8 vf[2][DVB];
#pragma unroll
            for (int j = 0; j < 2; ++j)
#pragma unroll
                for (int db = 0; db < DVB; ++db) vf[j][db] = *(const LAS bf16x8*)(VTtB + (32 * db + i31) * 128 + (((2 * (2 * jp + j) + h) ^ swv) << 4));
            const bf16x8 p0 = exp_pack8(jp == 0 ? b0 : b1, 0, ps), p1 = exp_pack8(jp == 0 ? b0 : b1, 1, ps);
#pragma unroll
            for (int db = 0; db < DVB; ++db) oT[db] = MFMA32(vf[0][db], p0, oT[db]);
#pragma unroll
            for (int db = 0; db < DVB; ++db) oT[db] = MFMA32(vf[1][db], p1, oT[db]);
        }
    }
    l_run += ps;
}

constexpr int L0_UNITS = 2176;
constexpr int L0_BUF = 16384;
constexpr int L0_RPB_OFF = 98304;
struct L0Args { const bf16_t* QK; const bf16_t* VT; bf16_t* Y; const float* sink; const float* rpb; };
#define L0_WAIT_BAR(N) asm volatile("s_waitcnt vmcnt(" #N ") lgkmcnt(0)\n\ts_barrier" ::: "memory")
struct L0Mask {
    int mode; const LAS float* tab; int vb; int dq;
    __device__ __forceinline__ void operator()(f32x16& s0, f32x16& s1) const {
        if (mode == 1) {
#pragma unroll
            for (int r = 0; r < 16; ++r) {
                const int kc0 = 16 * (r >> 3) + (r & 7), kc1 = 32 + kc0;
                const float b0 = tab[kc0], b1 = tab[kc1];
                s0[r] = ((unsigned)(kc0 + vb) < 16u) ? s0[r] + b0 : -INFINITY;
                s1[r] = ((unsigned)(kc1 + vb) < 16u) ? s1[r] + b1 : -INFINITY;
            }
        } else if (mode == 2) {
#pragma unroll
            for (int r = 0; r < 16; ++r) {
                const int kc0 = 16 * (r >> 3) + (r & 7), kc1 = 32 + kc0;
                const int d0 = dq - kc0, d1 = dq - kc1;
                if (d0 > 128 || d0 < -128) s0[r] = -INFINITY;
                if (d1 > 128 || d1 < -128) s1[r] = -INFINITY;
            }
        }
    }
};

struct L0Unit { int mode, b, qx, isB, lat0, nlat, nt, qtok0, hq, qcol, kcol, vrow; };
__device__ __forceinline__ L0Unit l0_decode(int u, int g) {
    L0Unit d; int kvh;
    if (u < 1024) { d.mode = 0; d.b = u >> 7; kvh = (u >> 6) & 1; d.qx = u & 63; d.isB = 1; }
    else if (u < 2048) { const int v = u - 1024; d.mode = 1; d.b = v >> 7; kvh = (v >> 6) & 1; d.qx = v & 63; d.isB = 0; }
    else { const int v = u - 2048; d.mode = 2; d.b = v >> 4; kvh = (v >> 2) & 1; d.isB = (v >> 3) & 1; d.qx = v & 3; }
    d.lat0 = 0; d.nlat = 0;
    if (d.mode == 0) { d.lat0 = min(max(d.qx - 4, 0), 56); d.nlat = 8; d.qtok0 = d.b * SEQ + 64 * d.qx; }
    else if (d.mode == 1) { d.lat0 = max(d.qx - 2, 0); d.nlat = min(d.qx + 2, 63) - d.lat0 + 1; d.qtok0 = d.b * SEQ + 64 * d.qx; }
    else { d.qtok0 = MLAT + d.b * CTXL + 64 * d.qx; }
    d.nt = d.nlat + 4;
    d.hq = 4 * kvh + g;
    d.qcol = d.isB * 512 + d.hq * 64; d.kcol = (d.isB ? 1152 : 1024) + 64 * kvh; d.vrow = d.isB * 128 + 64 * kvh;
    return d;
}
constexpr int L0_NSLOT = 6, L0_AHEAD = 4;
constexpr int L0_Q_OFF = L0_NSLOT * L0_BUF;
constexpr int L0_RPB2_OFF = 131072 + 256;
__device__ __forceinline__ void attn_l0_phase(LAS unsigned char* lds, const L0Args P, int bid, int G, int tid) {
    const int lane = tid & 63, wid = __builtin_amdgcn_readfirstlane(tid >> 6), i31 = lane & 31, h = lane >> 5;
    const int pi = (i31 & 0x13) | ((i31 & 4) << 1) | ((i31 & 8) >> 1);
    const int g = wid >> 1, jh = wid & 1;
    LAS float* rpbl = (LAS float*)(lds + L0_RPB2_OFF);
    for (int i = tid; i < 8 * 15 * 31; i += 512) rpbl[i] = P.rpb[i] * LOG2E_F;
    __syncthreads();
    int goff[2];
#pragma unroll
    for (int i = 0; i < 2; ++i) {
        const int p = 2 * wid + i, rl = lane >> 3, sl = lane & 7;
        if (wid < 4) { const int kr = 8 * p + rl, c = sl ^ ((kr >> 1) & 7); goff[i] = kr * NQK0 + c * 8; }
        else { const int e = 8 * (p - 8) + rl, c = sl ^ ((e >> 1) & 7); goff[i] = e * MTOT + c * 8; }
    }
    int qoff[4];
#pragma unroll
    for (int p = 0; p < 4; ++p) { const int row = 8 * p + (lane >> 3), c = (lane & 7) ^ ((row >> 1) & 7); qoff[p] = row * NQK0 + c * 8; }
#define L0_TOK0(D, t_) (((t_) < (D).nlat) ? (D).b * SEQ + 64 * ((D).lat0 + (t_)) : MLAT + (D).b * CTXL + 64 * ((t_) - (D).nlat))
#define L0_ISSUE(D, t_, slot_) do { const int tok0_ = L0_TOK0(D, t_); \
        const bf16_t* gb_ = (wid < 4) ? P.QK + (D).kcol + (size_t)tok0_ * NQK0 : P.VT + (size_t)(D).vrow * MTOT + tok0_; \
        _Pragma("unroll") for (int i_ = 0; i_ < 2; ++i_) __builtin_amdgcn_global_load_lds((const unsigned*)(gb_ + goff[i_]), (LAS unsigned*)(lds + (slot_) * L0_BUF + (2 * wid + i_) * 1024), 16, 0, 0); } while (0)
#define L0_ISSUE_Q(D) do { const bf16_t* gq_ = P.QK + (size_t)((D).qtok0 + 32 * jh) * NQK0 + (D).qcol; \
        _Pragma("unroll") for (int p_ = 0; p_ < 4; ++p_) __builtin_amdgcn_global_load_lds((const unsigned*)(gq_ + qoff[p_]), (LAS unsigned*)(lds + L0_Q_OFF + wid * 4096 + p_ * 1024), 16, 0, 0); } while (0)
    const int vcu = (G % 8 == 0) ? (bid % 8) * (G / 8) + bid / 8 : bid;
    int u = vcu;
    if (u >= L0_UNITS) return;
    L0Unit D = l0_decode(u, g);
    int sp = 0; bool later = false;
    L0_ISSUE(D, 0, 0); L0_ISSUE(D, 1, 1); L0_ISSUE(D, 2, 2); L0_ISSUE(D, 3, 3); L0_ISSUE_Q(D);
    L0_WAIT_BAR(0);
    for (;;) {
        const int un = u + G; const bool has_next = un < L0_UNITS;
        L0Unit Dn = D; if (has_next) Dn = l0_decode(un, g);
        const int nt = D.nt;
        bf16x8 qf[4];
        { const LAS unsigned char* qb = lds + L0_Q_OFF + wid * 4096; const int sw = (i31 >> 1) & 7;
#pragma unroll
          for (int d0 = 0; d0 < 4; ++d0) qf[d0] = *(const LAS bf16x8*)(qb + i31 * 128 + (((2 * d0 + h) ^ sw) << 4)); }
        float m_run, l_run;
        if (!D.isB) { m_run = P.sink[D.hq] * LOG2E_F; l_run = (h == 0) ? 1.f : 0.f; } else { m_run = 0.f; l_run = 0.f; }
        f32x16 negm;
#pragma unroll
        for (int r = 0; r < 16; ++r) negm[r] = -m_run;
        f32x16 oT[2]; oT[0] = f32x16{}; oT[1] = f32x16{};
        for (int t = 0; t < nt; ++t) {
            bool issued = false, issued_q = false;
            { int sl = sp + L0_AHEAD; if (sl >= L0_NSLOT) sl -= L0_NSLOT;
              if (t + L0_AHEAD < nt) { L0_ISSUE(D, t + L0_AHEAD, sl); issued = true; }
              else if (has_next) { L0_ISSUE(Dn, t + L0_AHEAD - nt, sl); issued = true; if (t == nt - 1) { L0_ISSUE_Q(Dn); issued_q = true; } } }
            const LAS unsigned char* buf = lds + sp * L0_BUF;
            L0Mask mk; mk.mode = 0; mk.tab = rpbl; mk.vb = 0; mk.dq = 0;
            if (t < D.nlat) {
                if (D.mode == 0) {
                    const int krow = D.lat0 + t, c = 32 * jh + i31, cstart = min(max(c - 8, 0), 48);
                    mk.mode = 1; mk.tab = rpbl + (D.hq * 15 + (krow - D.qx + 7)) * 31 + (8 * h - c + 15); mk.vb = 8 * h - cstart;
                } else {
                    const int tl = D.lat0 + t;
                    if (tl == D.qx - 2 || tl == D.qx + 2) { mk.mode = 2; mk.dq = 64 * D.qx + 32 * jh + i31 - 64 * tl - 8 * h; }
                }
            }
            tile_compute<2, L0Mask>(buf, buf + 8192, qf, oT, negm, m_run, l_run, D.isB && t == 0, pi, i31, h, mk);
            if (later && t < 3) L0_WAIT_BAR(63); else if (issued_q) L0_WAIT_BAR(10); else if (issued) L0_WAIT_BAR(6); else L0_WAIT_BAR(0);
            sp = (sp + 1 == L0_NSLOT) ? 0 : sp + 1;
        }
        if (has_next) asm volatile("s_waitcnt vmcnt(0)" ::: "memory");
        const float l = l_run + __shfl_xor(l_run, 32);
        const float inv = 1.0f / l;
        bf16_t* yp = P.Y + (size_t)(D.qtok0 + 32 * jh + i31) * DM + D.qcol;
#pragma unroll
        for (int db = 0; db < 2; ++db)
#pragma unroll
            for (int rp = 0; rp < 2; ++rp) {
                unsigned ax = pk_bf16(oT[db][8 * rp] * inv, oT[db][8 * rp + 1] * inv), ay = pk_bf16(oT[db][8 * rp + 2] * inv, oT[db][8 * rp + 3] * inv);
                unsigned bx = pk_bf16(oT[db][8 * rp + 4] * inv, oT[db][8 * rp + 5] * inv), by = pk_bf16(oT[db][8 * rp + 6] * inv, oT[db][8 * rp + 7] * inv);
                { auto r0 = __builtin_amdgcn_permlane32_swap(ax, bx, false, false); ax = r0[0]; bx = r0[1]; auto r1 = __builtin_amdgcn_permlane32_swap(ay, by, false, false); ay = r1[0]; by = r1[1]; }
                u32x4 w; w.x = ax; w.y = ay; w.z = bx; w.w = by;
                *(u32x4*)(yp + 32 * db + 16 * rp + 8 * h) = w;
            }
        if (!has_next) break;
        u = un; D = Dn; later = true;
    }
#undef L0_ISSUE
#undef L0_ISSUE_Q
#undef L0_TOK0
}
#undef L0_WAIT_BAR

constexpr int DF_SUB = 32768;
constexpr int DF_BUF = 65536;
constexpr int DF_X_OFF = 65536;
struct DiffArgs { const bf16_t* QK; const bf16_t* VT; bf16_t* Y; const float* lq1; const float* lk1; const float* lq2; const float* lk2; const float* subg; };
#define DF_WAIT_BAR(N) asm volatile("s_waitcnt vmcnt(" #N ") lgkmcnt(0)\n\ts_barrier" ::: "memory")

__device__ __forceinline__ void attn_diff_phase(LAS unsigned char* lds, const DiffArgs P, int bid, int G, int tid) {
    const int lane = tid & 63, wid = __builtin_amdgcn_readfirstlane(tid >> 6), i31 = lane & 31, h = lane >> 5;
    const int pi = (i31 & 0x13) | ((i31 & 4) << 1) | ((i31 & 8) >> 1);
    const int msub = wid & 1, jg = wid >> 1;
    const float lam = expf(wave_sum(P.lq1[lane] * P.lk1[lane])) - expf(wave_sum(P.lq2[lane] * P.lk2[lane])) + LAM_INIT;
    int goff[4];
#pragma unroll
    for (int i = 0; i < 4; ++i) {
        const int p = 4 * wid + i, rl = lane >> 3, sl = lane & 7;
        if (wid < 4) { const int kr = 8 * (p & 7) + rl, c = sl ^ ((kr >> 1) & 7); goff[i] = kr * NQK1 + (p >> 3) * 64 + c * 8; }
        else { const int e = 8 * (p - 16) + rl, c = sl ^ ((e >> 1) & 7); goff[i] = e * MTOT + c * 8; }
    }
    LAS float* subg_l = (LAS float*)(lds + 131072 + 256);
    if (tid < 128) subg_l[tid] = P.subg[tid];
    __syncthreads();
    const int nunits = NBATCH * 8 * 32;
#define DF_DECODE(it_, ok_, b_, hd_, qb_) do { int pair_; if (G == 256) { ok_ = (it_) < 8; pair_ = (bid & 7) * 8 + (it_); qb_ = bid >> 3; } \
        else { const int u_ = bid + (it_) * G; ok_ = u_ < nunits; pair_ = u_ >> 5; qb_ = u_ & 31; } b_ = pair_ >> 3; hd_ = pair_ & 7; } while (0)
#define DF_ISSUE(B_, KB_, VB_, st_, bo_) do { _Pragma("unroll") for (int sub_ = 0; sub_ < 2; ++sub_) { const int t_ = 2 * (st_) + sub_; \
            const int tok0_ = (t_ < 64) ? (B_) * SEQ + 64 * t_ : MLAT + (B_) * CTXL + 64 * (t_ - 64); \
            const bf16_t* gb_ = (wid < 4) ? (KB_) + (size_t)tok0_ * NQK1 : (VB_) + tok0_; \
            _Pragma("unroll") for (int i_ = 0; i_ < 4; ++i_) __builtin_amdgcn_global_load_lds((const unsigned*)(gb_ + goff[i_]), (LAS unsigned*)(lds + (bo_) + sub_ * DF_SUB + (4 * wid + i_) * 1024), 16, 0, 0); } } while (0)
    bool ok; int b, hd, qb;
    DF_DECODE(0, ok, b, hd, qb);
    if (!ok) return;
    const bf16_t* kbase = P.QK + 1024 + hd * 128;
    const bf16_t* vbase = P.VT + (size_t)(hd * 128) * MTOT;
    bf16x8 qf[4];
    { const int qtok0 = b * SEQ + 128 * qb + 32 * jg + i31;
#pragma unroll
      for (int d0 = 0; d0 < 4; ++d0) qf[d0] = *(const bf16x8*)(P.QK + (size_t)qtok0 * NQK1 + hd * 128 + msub * 64 + 16 * d0 + 8 * h); }
    DF_ISSUE(b, kbase, vbase, 0, 0);
    for (int it = 0; ; ++it) {
        const int qtok = b * SEQ + 128 * qb + 32 * jg + i31;
        float m_run = 0.f, l_run = 0.f;
        f32x16 oT[4]; oT[0] = f32x16{}; oT[1] = f32x16{}; oT[2] = f32x16{}; oT[3] = f32x16{};
        f32x16 negm = f32x16{};
        int b0 = 0, b1 = DF_BUF;
        asm volatile("" : "+v"(qf[0]), "+v"(qf[1]), "+v"(qf[2]), "+v"(qf[3]));
        DF_WAIT_BAR(0);
        constexpr int NST = 34;
        for (int st = 0; st < NST; ++st) {
            if (st + 1 < NST) DF_ISSUE(b, kbase, vbase, st + 1, b1);
            const LAS unsigned char* buf = lds + b0;
            tile_compute128<4>(buf + msub * 8192, buf + 16384, buf + DF_SUB + msub * 8192, buf + DF_SUB + 16384, qf, oT, negm, m_run, l_run, st == 0, pi, i31, h, wid >= 4);
            DF_WAIT_BAR(0);
            { const int tmp = b0; b0 = b1; b1 = tmp; }
        }
        bool nok; int nb, nhd, nqb;
        DF_DECODE(it + 1, nok, nb, nhd, nqb);
        const int hd_cur = hd;
        if (nok) {
            kbase = P.QK + 1024 + nhd * 128; vbase = P.VT + (size_t)(nhd * 128) * MTOT;
            DF_ISSUE(nb, kbase, vbase, 0, 0);
            const int qtokn = nb * SEQ + 128 * nqb + 32 * jg + i31;
#pragma unroll
            for (int d0 = 0; d0 < 4; ++d0) qf[d0] = *(const bf16x8*)(P.QK + (size_t)qtokn * NQK1 + nhd * 128 + msub * 64 + 16 * d0 + 8 * h);
            b = nb; hd = nhd; qb = nqb;
        }
        const float l = l_run + __shfl_xor(l_run, 32);
        const float inv = 1.0f / l;
        const float myscale = (msub == 0) ? inv : -lam * inv;
        LAS float* XA = (LAS float*)(lds + DF_X_OFF) + jg * 4096;
        LAS float* XB = XA + 2048;
        LAS float* XS = (LAS float*)(lds + 131072 + 256 + 1024) + jg * 64;
        {
            LAS float* Xw = (msub == 0) ? XA : XB;
#pragma unroll
            for (int d2 = 0; d2 < 2; ++d2)
#pragma unroll
                for (int r = 0; r < 16; ++r) {
                    const float v = (msub == 0) ? oT[2 + d2][r] : oT[d2][r];
                    Xw[(32 * d2 + crow(r, h)) * 32 + i31] = v * myscale;
                }
        }
        __syncthreads();
        float dv[2][16]; float ssq = 0.f;
        {
            const LAS float* Xr = (msub == 0) ? XB : XA;
#pragma unroll
            for (int d2 = 0; d2 < 2; ++d2)
#pragma unroll
                for (int r = 0; r < 16; ++r) {
                    const float mine = ((msub == 0) ? oT[d2][r] : oT[2 + d2][r]) * myscale;
                    const float d = mine + Xr[(32 * d2 + crow(r, h)) * 32 + i31];
                    dv[d2][r] = d; ssq += d * d;
                }
        }
        ssq += __shfl_xor(ssq, 32);
        if (h == 0) XS[msub * 32 + i31] = ssq;
        __syncthreads();
        {
            const float tot = XS[i31] + XS[32 + i31];
            const float rn = rsqrtf(tot * (1.0f / 128.0f) + EPS_F) * (1.0f - LAM_INIT);
            const int fbase = 64 * msub;
            bf16_t* yp = P.Y + (size_t)qtok * DM + hd_cur * 128 + fbase;
#pragma unroll
            for (int d2 = 0; d2 < 2; ++d2)
#pragma unroll
                for (int rp = 0; rp < 2; ++rp) {
                    unsigned ax, ay, bx, by;
                    { const int rg = 2 * rp; const f32x4 gq = *(const LAS f32x4*)(subg_l + fbase + 32 * d2 + 8 * rg + 4 * h);
                      ax = pk_bf16(dv[d2][4 * rg] * rn * gq[0], dv[d2][4 * rg + 1] * rn * gq[1]); ay = pk_bf16(dv[d2][4 * rg + 2] * rn * gq[2], dv[d2][4 * rg + 3] * rn * gq[3]); }
                    { const int rg = 2 * rp + 1; const f32x4 gq = *(const LAS f32x4*)(subg_l + fbase + 32 * d2 + 8 * rg + 4 * h);
                      bx = pk_bf16(dv[d2][4 * rg] * rn * gq[0], dv[d2][4 * rg + 1] * rn * gq[1]); by = pk_bf16(dv[d2][4 * rg + 2] * rn * gq[2], dv[d2][4 * rg + 3] * rn * gq[3]); }
                    { auto r0 = __builtin_amdgcn_permlane32_swap(ax, bx, false, false); ax = r0[0]; bx = r0[1]; auto r1 = __builtin_amdgcn_permlane32_swap(ay, by, false, false); ay = r1[0]; by = r1[1]; }
                    u32x4 w; w.x = ax; w.y = ay; w.z = bx; w.w = by;
                    *(u32x4*)(yp + 32 * d2 + 16 * rp + 8 * h) = w;
                }
        }
        __syncthreads();
        if (!nok) break;
    }
#undef DF_ISSUE
#undef DF_DECODE
}
#undef DF_WAIT_BAR
#undef MFMA32
}

constexpr size_t MiB = 1u << 20;
constexpr size_t WS_MOD = 0;
constexpr size_t WS_ROPE = 512 * 1024;
constexpr size_t WS_BIAS = 1 * MiB;
constexpr size_t WS_SS = 4 * MiB;
constexpr size_t WS_WQK0 = 8 * MiB, WS_WV0 = 11 * MiB, WS_WO0 = 12 * MiB, WS_W10 = 14 * MiB, WS_W20 = 22 * MiB;
constexpr size_t WS_WQK1 = 30 * MiB, WS_WV1 = 34 * MiB, WS_WO1 = 36 * MiB, WS_W11 = 38 * MiB, WS_W21 = 46 * MiB;
constexpr size_t WS_HR = 56 * MiB;
constexpr size_t WS_QK = 192 * MiB;
constexpr size_t WS_VT = 328 * MiB;
constexpr size_t WS_Y = 396 * MiB;
constexpr size_t WS_H = 192 * MiB;
constexpr size_t WS_SLAB = 464 * MiB;
constexpr size_t WS_END = 512 * MiB;
constexpr int BO_QK0 = 0, BO_V0 = BO_QK0 + 9 * NQK0, BO_UP0 = BO_V0 + 9 * NV0, BO_QK1 = BO_UP0 + 9 * DFF, BO_V1 = BO_QK1 + 9 * NQK1, BO_UP1 = BO_V1 + 9 * NV1;
constexpr int LDS_BYTES = 163840;
constexpr int NPHASE = 15;

__device__ __forceinline__ float silu_f(float v) { return v / (1.0f + expf(-v)); }
__device__ __forceinline__ void even_map(int c, int& isv, int& r) {
    if (c < 512) { isv = 0; r = c; } else if (c < 640) { isv = 0; r = 1024 + (c - 512); } else if (c < 768) { isv = 1; r = c - 640; }
    else if (c < 1280) { isv = 0; r = 512 + (c - 768); } else if (c < 1408) { isv = 0; r = 1152 + (c - 1280); } else { isv = 1; r = 128 + (c - 1408); }
}
__device__ __forceinline__ void gemv9_item(const float* __restrict__ W, int ldw, int csrc0, const LAS float* vec, LAS float* red, float* out, int ostride, int cdst0, const float* addb, int tid) {
    const int lane = tid & 63, kg = tid >> 6, cg = lane & 15, ks = lane >> 4;
    f32x4 a[9];
#pragma unroll
    for (int b = 0; b < 9; ++b) a[b] = (f32x4){0.f, 0.f, 0.f, 0.f};
    const float* wp = W + (size_t)(kg * 128 + ks) * ldw + csrc0 + 4 * cg;
    const LAS float* vp = vec + kg * 128 + ks;
#pragma unroll 8
    for (int i = 0; i < 32; ++i) {
        const f32x4 w = __builtin_nontemporal_load((const f32x4*)(wp + (size_t)(4 * i) * ldw));
#pragma unroll
        for (int b = 0; b < 9; ++b) a[b] += w * vp[b * 1024 + 4 * i];
    }
    LAS float* rp = red + (kg * 4 + ks) * 576 + 4 * cg;
#pragma unroll
    for (int b = 0; b < 9; ++b) *(LAS f32x4*)(rp + b * 64) = a[b];
    __syncthreads();
    for (int idx = tid; idx < 576; idx += 512) {
        const int c = idx & 63; float s = 0.f;
#pragma unroll
        for (int g2 = 0; g2 < 32; ++g2) s += red[g2 * 576 + idx];
        if (addb) s += addb[csrc0 + c];
        out[(size_t)(idx >> 6) * ostride + cdst0 + c] = s;
    }
    __syncthreads();
}
__device__ __forceinline__ void transpose_item(const float* __restrict__ W, int K, int N, int k0, int n0, bf16_t* dst, LAS float* scr, int lane) {
    f32x4 v[8];
#pragma unroll
    for (int i = 0; i < 8; ++i) v[i] = __builtin_nontemporal_load((const f32x4*)(W + (size_t)(k0 + 8 * i + (lane >> 3)) * N + n0 + 4 * (lane & 7)));
#pragma unroll
    for (int i = 0; i < 8; ++i) { LAS float* sp = scr + (8 * i + (lane >> 3)) * 33 + 4 * (lane & 7); sp[0] = v[i][0]; sp[1] = v[i][1]; sp[2] = v[i][2]; sp[3] = v[i][3]; }
    asm volatile("s_waitcnt lgkmcnt(0)" ::: "memory");
    const int c = lane & 7;
#pragma unroll
    for (int j = 0; j < 4; ++j) { const int n = (lane >> 3) + 8 * j; const LAS float* s = scr + (8 * c) * 33 + n;
        u32x4 o; o.x = pk_bf16(s[0 * 33], s[1 * 33]); o.y = pk_bf16(s[2 * 33], s[3 * 33]); o.z = pk_bf16(s[4 * 33], s[5 * 33]); o.w = pk_bf16(s[6 * 33], s[7 * 33]);
        *(u32x4*)(dst + (size_t)n * K + k0 + 8 * c) = o; }
    asm volatile("s_waitcnt lgkmcnt(0)" ::: "memory");
}
__device__ __forceinline__ void sincos_small(double a, float& c, float& s) {
    const double TWO_PI = 6.283185307179586476925287;
    const double k = __builtin_rint(a / TWO_PI);
    const double x = a - k * TWO_PI, x2 = x * x;
    double ts = 1.0, tc = 1.0;
    for (int j = 15; j >= 1; --j) { ts = 1.0 - x2 / (double)((2 * j) * (2 * j + 1)) * ts; tc = 1.0 - x2 / (double)((2 * j - 1) * (2 * j)) * tc; }
    s = (float)(x * ts); c = (float)tc;
}

#define GAS __attribute__((address_space(1)))
#define XB_TMO      128
#define XB_XCNT(j)  (256  + 64 * (j))
#define XB_XSUB(j)  (1280 + 64 * (j))
#define XB_XGEN(j)  (2304 + 64 * (j))
#define XB_TOP      3328
#define XB_TOPGEN   3392
#define XCD_BAR_WORDS 3456
#define XB_SPIN_CAP (1u << 18)

__device__ __forceinline__ unsigned xb_ld(unsigned* p)              { return __hip_atomic_load(p, __ATOMIC_RELAXED, __HIP_MEMORY_SCOPE_AGENT); }
__device__ __forceinline__ unsigned xb_add(unsigned* p, unsigned v) { return __hip_atomic_fetch_add(p, v, __ATOMIC_RELAXED, __HIP_MEMORY_SCOPE_AGENT); }
__device__ __forceinline__ unsigned xb_xcc_id() { return (unsigned)__builtin_amdgcn_s_getreg((3 << 11) | 20) & 0xFu; }
#define XB_SPIN(cond, bar) do { unsigned _sp = 0; while (cond) { __builtin_amdgcn_s_sleep(1); \
    if ((++_sp & 255u) == 0u) { if (xb_ld(&(bar)[XB_TMO])) break; if (_sp > XB_SPIN_CAP) { atomicAdd(&(bar)[XB_TMO], 1u); break; } } } } while (0)

struct XcdBarrier {
    unsigned* bar; unsigned x;
    volatile LAS unsigned* st;
};

__device__ __forceinline__ XcdBarrier xcd_barrier_post(unsigned* bar, volatile LAS unsigned* st) {
    XcdBarrier b; b.bar = bar; b.x = xb_xcc_id(); b.st = st;
    if (threadIdx.x == 0) (void)xb_add(&bar[XB_XCNT(b.x)], 1u);
    return b;
}
__device__ __forceinline__ void xcd_barrier_complete(unsigned* bar, unsigned x, unsigned& nloc, unsigned& nx) {
    const unsigned G = gridDim.x * gridDim.y * gridDim.z;
    unsigned sum, cnt, mine, sp = 0u;
    for (;;) {
        sum = 0u; cnt = 0u; mine = 0u;
#pragma unroll
        for (unsigned j = 0; j < 16; ++j) { const unsigned c = xb_ld(&bar[XB_XCNT(j)]); sum += c; cnt += (c > 0u) ? 1u : 0u; mine = (j == x) ? c : mine; }
        if (sum == G) break;
        __builtin_amdgcn_s_sleep(1);
        if ((++sp & 255u) == 0u) { if (xb_ld(&bar[XB_TMO])) break; if (sp > XB_SPIN_CAP) { atomicAdd(&bar[XB_TMO], 1u); break; } }
    }
    nloc = mine > 0u ? mine : 1u; nx = cnt > 0u ? cnt : 1u;
}

__device__ __forceinline__ void xcd_barrier(const XcdBarrier& b) {
    asm volatile("s_waitcnt vmcnt(0)" ::: "memory");
    __syncthreads();
    if (threadIdx.x == 0) {
        unsigned* bar = b.bar;
        __builtin_amdgcn_s_waitcnt(0);
        unsigned nloc = b.st[0], nx = b.st[1];
        if (nloc == 0u) { xcd_barrier_complete(bar, b.x, nloc, nx); b.st[0] = nloc; b.st[1] = nx; }
        const unsigned old = xb_add(&bar[XB_XSUB(b.x)], 1u);
        const unsigned gen = old / nloc;
        if (old + 1u == (gen + 1u) * nloc) {
            __builtin_amdgcn_fence(__ATOMIC_RELEASE, "agent");
            asm volatile("s_waitcnt vmcnt(0)" ::: "memory");
            const unsigned og = xb_add(&bar[XB_TOP], 1u);
            const unsigned tg = og / nx;
            if (og + 1u == (tg + 1u) * nx) xb_add(&bar[XB_TOPGEN], 1u);
            else XB_SPIN(xb_ld(&bar[XB_TOPGEN]) == tg, bar);
            __builtin_amdgcn_fence(__ATOMIC_ACQUIRE, "agent");
            xb_add(&bar[XB_XGEN(b.x)], 1u);
            asm volatile("s_waitcnt vmcnt(0)" ::: "memory");
        } else {
            XB_SPIN(xb_ld(&bar[XB_XGEN(b.x)]) == gen, bar);
            __builtin_amdgcn_fence(__ATOMIC_ACQUIRE, "agent");
            asm volatile("s_waitcnt vmcnt(0)" ::: "memory");
        }
    }
    __syncthreads();
}

constexpr size_t WS_BAR = 2 * MiB;
constexpr int LDS_MISC_OFF = 131072;
template <bool HIN_BF> __device__ __forceinline__ void ctx_reduce(const float* slab_lo, const float* slab_hi, const void* hin, const float* gate, const float* scl, const float* ng, bf16_t* hout, bf16_t* xg, float* ss, int gw, int NGW, int lane) {
    for (int r = gw; r < MCTX; r += NGW) {
        f32x4 a[4];
#pragma unroll
        for (int j = 0; j < 4; ++j) a[j] = (f32x4){0.f, 0.f, 0.f, 0.f};
#pragma unroll
        for (int ks = 0; ks < 8; ++ks) {
            const bf16_t* sp = (const bf16_t*)slab_lo + (size_t)ks * MCTX * DM + (size_t)r * DM + 4 * lane;
#pragma unroll
            for (int j = 0; j < 4; ++j) a[j] += pg8::ld_bf4(sp + 256 * j);
        }
        float ssum = 0.f;
#pragma unroll
        for (int j = 0; j < 4; ++j) {
            const int k = 4 * lane + 256 * j;
            f32x4 h0; if (HIN_BF) h0 = pg8::ld_bf4((const bf16_t*)hin + (size_t)r * DM + k); else h0 = *(const f32x4*)((const float*)hin + (size_t)r * DM + k);
            const f32x4 v = h0 + *(const f32x4*)(gate + 8 * 6144 + k) * a[j];
            if (hout) { u32x2 w; w.x = pk_bf16(v[0], v[1]); w.y = pk_bf16(v[2], v[3]); *(u32x2*)(hout + (size_t)r * DM + k) = w; }
            ssum += (v[0] * v[0] + v[1] * v[1]) + (v[2] * v[2] + v[3] * v[3]);
            const f32x4 y = v * (*(const f32x4*)(ng + k) * (*(const f32x4*)(scl + 8 * 6144 + k) + 1.0f));
            u32x2 w; w.x = pk_bf16(y[0], y[1]); w.y = pk_bf16(y[2], y[3]);
            *(u32x2*)(xg + (size_t)(MLAT + r) * DM + k) = w;
        }
        ssum = att::wave_sum(ssum);
        if (lane < 16) ss[(size_t)(MLAT + r) * 16 + lane] = (lane == 0) ? ssum : 0.f;
    }
}

__device__ __forceinline__ void transpose_dispatch(int it, LAS float* scr, int lane, const float* even_w_in, const float* even_w_out, const float* odd_w_in, const float* odd_w_out, const float* mlp_w1, const float* mlp_w2,
                                                   bf16_t* Wqk0, bf16_t* Wv0, bf16_t* Wo0, bf16_t* Wqk1, bf16_t* Wv1, bf16_t* Wo1, bf16_t* W10, bf16_t* W11, bf16_t* W20, bf16_t* W21) {
    int r = it;
    if (r < 768) { const int kb = r / 48, nb = r % 48; int isv, dr; even_map(32 * nb, isv, dr);
        transpose_item(even_w_in, DM, 1536, 64 * kb, 32 * nb, (isv ? Wv0 : Wqk0) + (size_t)dr * DM, scr, lane); return; } r -= 768;
    if (r < 512) { const int kb = r / 32, nb = r % 32; transpose_item(even_w_out, DM, DM, 64 * kb, 32 * nb, Wo0 + (size_t)(32 * nb) * DM, scr, lane); return; } r -= 512;
    if (r < 1536) { const int kb = r / 96, nb = r % 96; const int n0 = 32 * nb;
        transpose_item(odd_w_in, DM, 3072, 64 * kb, n0, n0 < 2048 ? Wqk1 + (size_t)n0 * DM : Wv1 + (size_t)(n0 - 2048) * DM, scr, lane); return; } r -= 1536;
    if (r < 512) { const int kb = r / 32, nb = r % 32; transpose_item(odd_w_out, DM, DM, 64 * kb, 32 * nb, Wo1 + (size_t)(32 * nb) * DM, scr, lane); return; } r -= 512;
    if (r < 4096) { const int l = r / 2048, q = r % 2048, kb = q / 128, nb = q % 128;
        transpose_item(mlp_w1 + (size_t)l * DM * DFF, DM, DFF, 64 * kb, 32 * nb, (l ? W11 : W10) + (size_t)(32 * nb) * DM, scr, lane); return; } r -= 4096;
    { const int l = r / 2048, q = r % 2048, kb = q / 32, nb = q % 32;
        transpose_item(mlp_w2 + (size_t)l * DFF * DM, DFF, DM, 64 * kb, 32 * nb, (l ? W21 : W20) + (size_t)(32 * nb) * DFF, scr, lane); }
}

#ifndef USE_FINAL
#define USE_FINAL 0
#endif
struct Args { const float* in[22]; float* out; unsigned char* ws; int ph_lo, ph_hi; };

__global__ void __launch_bounds__(512, 2) dit_fwd(Args args) {
    extern __shared__ __attribute__((aligned(16))) unsigned char lds_raw[];
    LAS unsigned char* lds = (LAS unsigned char*)lds_raw;
    const int tid = threadIdx.x, lane = tid & 63, wave = __builtin_amdgcn_readfirstlane(tid >> 6);
    const int bid = blockIdx.x, G = gridDim.x;
    const int gw = bid * 8 + wave, NGW = G * 8;
    unsigned char* ws = args.ws;
    const float* x = args.in[0]; const float* cvec = args.in[1]; const float* ctx = args.in[2]; const float* c_ctx = args.in[3];
    const float* ada_w = args.in[4]; const float* ada_b = args.in[5]; const float* norm1_g = args.in[6]; const float* norm2_g = args.in[7];
    const float* even_w_in = args.in[8]; const float* even_w_out = args.in[9]; const float* a_sink = args.in[10]; const float* b_rpb = args.in[11];
    const float* odd_w_in = args.in[12]; const float* odd_w_out = args.in[13];
    const float* mlp_w1 = args.in[19]; const float* mlp_w2 = args.in[20]; const float* final_g = args.in[21];
    float* mod = (float*)(ws + WS_MOD); float* ropetab = (float*)(ws + WS_ROPE); float* biasb = (float*)(ws + WS_BIAS); float* ssb = (float*)(ws + WS_SS);
    bf16_t* Wqk0 = (bf16_t*)(ws + WS_WQK0); bf16_t* Wv0 = (bf16_t*)(ws + WS_WV0); bf16_t* Wo0 = (bf16_t*)(ws + WS_WO0); bf16_t* W10 = (bf16_t*)(ws + WS_W10); bf16_t* W20 = (bf16_t*)(ws + WS_W20);
    bf16_t* Wqk1 = (bf16_t*)(ws + WS_WQK1); bf16_t* Wv1 = (bf16_t*)(ws + WS_WV1); bf16_t* Wo1 = (bf16_t*)(ws + WS_WO1); bf16_t* W11 = (bf16_t*)(ws + WS_W11); bf16_t* W21 = (bf16_t*)(ws + WS_W21);
    bf16_t* HR = (bf16_t*)(ws + WS_HR); bf16_t* QK = (bf16_t*)(ws + WS_QK); bf16_t* VT = (bf16_t*)(ws + WS_VT); bf16_t* Y = (bf16_t*)(ws + WS_Y); bf16_t* Hb = (bf16_t*)(ws + WS_H);
    bf16_t* XG = (bf16_t*)args.out;
    const int lo = args.ph_lo, hi = args.ph_hi;
#define IN(k) (lo <= (k) && (k) < hi)
#ifdef PROBE_STAMPS
    unsigned long long* stamps = (unsigned long long*)(ws + 3 * MiB);
    if (bid == 0 && tid == 0) stamps[0] = __builtin_amdgcn_s_memrealtime();
#define SEAM(k) do { if (IN(k) && IN((k) + 1)) { cg::this_grid().sync(); if (bid == 0 && tid == 0) stamps[(k) + 1] = __builtin_amdgcn_s_memrealtime(); } } while (0)
#else
    volatile LAS unsigned* misc = (volatile LAS unsigned*)(lds + LDS_MISC_OFF);
    if (tid < 4) misc[tid] = 0u;
    __syncthreads();
    XcdBarrier xbar; xbar.bar = (unsigned*)(ws + WS_BAR); xbar.x = 0; xbar.st = nullptr;
    if (hi - lo > 1) xbar = xcd_barrier_post((unsigned*)(ws + WS_BAR), misc);
#define SEAM(k) do { if (IN(k) && IN((k) + 1)) { xcd_barrier(xbar); } } while (0)
#endif

    if (IN(0)) {
        if (bid < 192) {
            LAS float* vec = (LAS float*)lds; LAS float* red = (LAS float*)(lds + 40960);
            for (int i = tid; i < 9 * 1024; i += 512) { const float v = (i < 8192) ? cvec[i] : c_ctx[i - 8192]; vec[i] = silu_f(v); }
            __syncthreads();
            const int l = bid / 96, cb = bid % 96;
            gemv9_item(ada_w + (size_t)l * DM * 6144, 6144, cb * 64, vec, red, mod + (size_t)l * 9 * 6144, 6144, cb * 64, ada_b + (size_t)l * 6144, tid);
        }
        if (bid == G - 1) {
            for (int idx = tid; idx < 1024; idx += 512) {
                const int pos = idx >> 4, i = idx & 15; double f = 1.0;
                for (int q = 0; q < i; ++q) f *= 0.56234132519034908;
                float c, s; sincos_small((double)pos * f, c, s);
                ropetab[2 * idx] = c; ropetab[2 * idx + 1] = s;
            }
        }
        __syncthreads();
        LAS float* scr = (LAS float*)(lds + wave * 8448);
        const bool defer = (G == 256);
        for (int it = gw; it < (defer ? 768 : 11520); it += NGW) transpose_dispatch(it, scr, lane, even_w_in, even_w_out, odd_w_in, odd_w_out, mlp_w1, mlp_w2, Wqk0, Wv0, Wo0, Wqk1, Wv1, Wo1, W10, W11, W20, W21);
    }
    SEAM(0);
    if (IN(1)) {
        if (bid < 200) {
            LAS float* vec = (LAS float*)lds; LAS float* red = (LAS float*)(lds + 40960);
            int l, soff; if (bid < 24) { l = 0; soff = 0; } else if (bid < 88) { l = 0; soff = 3072; } else if (bid < 136) { l = 1; soff = 0; } else { l = 1; soff = 3072; }
            for (int i = tid; i < 9 * 1024; i += 512) vec[i] = mod[(size_t)(l * 9 + (i >> 10)) * 6144 + soff + (i & 1023)];
            __syncthreads();
            if (bid < 24) { const int c0 = 64 * bid; int isv, dr; even_map(c0, isv, dr);
                gemv9_item(even_w_in, 1536, c0, vec, red, biasb + (isv ? BO_V0 : BO_QK0), isv ? NV0 : NQK0, dr, nullptr, tid); }
            else if (bid < 88) { const int c0 = 64 * (bid - 24); gemv9_item(mlp_w1, DFF, c0, vec, red, biasb + BO_UP0, DFF, c0, nullptr, tid); }
            else if (bid < 136) { const int c0 = 64 * (bid - 88);
                if (c0 < 2048) gemv9_item(odd_w_in, 3072, c0, vec, red, biasb + BO_QK1, NQK1, c0, nullptr, tid);
                else gemv9_item(odd_w_in, 3072, c0, vec, red, biasb + BO_V1, NV1, c0 - 2048, nullptr, tid); }
            else { const int c0 = 64 * (bid - 136); gemv9_item(mlp_w1 + (size_t)DM * DFF, DFF, c0, vec, red, biasb + BO_UP1, DFF, c0, nullptr, tid); }
        }
        for (int r4 = gw; r4 < MTOT / 4; r4 += NGW) {
            const int row0 = 4 * r4;
            const float* src = row0 < MLAT ? x + (size_t)row0 * DM : ctx + (size_t)(row0 - MLAT) * DM;
            const int b = row0 < MLAT ? (row0 >> 12) : 8;
            const float* scl = mod + (size_t)b * 6144 + 1024;
            f32x4 v[4][4];
#pragma unroll
            for (int rr = 0; rr < 4; ++rr)
#pragma unroll
                for (int j = 0; j < 4; ++j) v[rr][j] = __builtin_nontemporal_load((const f32x4*)(src + (size_t)rr * DM + 4 * lane + 256 * j));
            f32x4 gp[4];
#pragma unroll
            for (int j = 0; j < 4; ++j) { const int k = 4 * lane + 256 * j; gp[j] = *(const f32x4*)(norm1_g + k) * (*(const f32x4*)(scl + k) + 1.0f); }
#pragma unroll
            for (int rr = 0; rr < 4; ++rr) {
                float ssum = 0.f;
#pragma unroll
                for (int j = 0; j < 4; ++j) {
                    const f32x4 t = v[rr][j];
                    ssum += (t[0] * t[0] + t[1] * t[1]) + (t[2] * t[2] + t[3] * t[3]);
                    const f32x4 y = t * gp[j];
                    u32x2 w; w.x = pk_bf16(y[0], y[1]); w.y = pk_bf16(y[2], y[3]);
                    *(u32x2*)(XG + (size_t)(row0 + rr) * DM + 4 * lane + 256 * j) = w;
                }
                ssum = att::wave_sum(ssum);
                if (lane < 16) ssb[(size_t)(row0 + rr) * 16 + lane] = (lane == 0) ? ssum : 0.f;
            }
        }
    }
    SEAM(1);
    if (IN(2)) {
        { pg8::Gemm g{XG, Wqk0, MTOT, NQK0, DM}; pg8::StaticOrder S; S.init(MTOT, NQK0, G, bid, DM);
          pg8::EpiQK E{QK, NQK0, ssb, biasb + BO_QK0, 0x10Fu, 0x0FFu, ropetab, lds}; pg8::fill_rstd_table<pg8::StaticOrder, false>(lds, S, ssb, ropetab, biasb + BO_QK0, NQK0);
          pg8::gemm_phase<pg8::EpiQK, pg8::StaticOrder, true, true>(lds, g, S, E); }
        { pg8::Gemm g{Wv0, XG, NV0, MTOT, DM}; pg8::StaticOrder S; S.init(NV0, MTOT, G, bid, DM);
          pg8::EpiVT E{VT, MTOT, ssb, biasb + BO_V0, NV0, lds}; pg8::fill_rstd_table<pg8::StaticOrder, true>(lds, S, ssb, nullptr, biasb + BO_V0, NV0);
          pg8::gemm_phase<pg8::EpiVT, pg8::StaticOrder, true, true>(lds, g, S, E); }
        if (G == 256 && bid >= 168) {
            LAS float* scr = (LAS float*)(lds + wave * 8448);
            for (int it = 768 + (bid - 168) * 8 + wave; it < 11520; it += 88 * 8) transpose_dispatch(it, scr, lane, even_w_in, even_w_out, odd_w_in, odd_w_out, mlp_w1, mlp_w2, Wqk0, Wv0, Wo0, Wqk1, Wv1, Wo1, W10, W11, W20, W21);
        }
    }
    SEAM(2);
    if (IN(3)) { att::L0Args P{QK, VT, Y, a_sink, b_rpb}; att::attn_l0_phase(lds, P, bid, G, tid); }
    SEAM(3);
    if (IN(4)) {
        pg8::Gemm g{Y, Wo0, MTOT, DM, DM};
        pg8::EpiResT<false, true> E{x, ctx, HR, XG, ssb, mod + 2048, mod + 4096, norm2_g};
        { pg8::StaticOrder S; S.init(G == 256 ? MLAT : MTOT, DM, G, bid, DM); pg8::gemm_phase<pg8::EpiResT<false, true>, pg8::StaticOrder, true, true>(lds, g, S, E); }
        if (G == 256) { pg8::SplitCtxOrder S; S.init(bid, DM);
            pg8::EpiSlab E2{(float*)(ws + WS_QK), (float*)(ws + WS_QK) + (size_t)6 * MCTX * DM};
            pg8::gemm_phase<pg8::EpiSlab, pg8::SplitCtxOrder, true, true>(lds, g, S, E2); }
    }
    SEAM(4);
    if (IN(5)) { if (G == 256) ctx_reduce<false>((const float*)(ws + WS_QK), (const float*)(ws + WS_QK) + (size_t)6 * MCTX * DM, ctx, mod + 2048, mod + 4096, norm2_g, HR + (size_t)MLAT * DM, XG, ssb, gw, NGW, lane); }
    SEAM(5);
    if (IN(6)) {
        pg8::Gemm g{XG, W10, MTOT, DFF, DM}; pg8::StaticOrder S; S.init(MTOT, DFF, G, bid, DM);
        pg8::EpiUp E{Hb, ssb, biasb + BO_UP0, lds}; pg8::fill_rstd_table<pg8::StaticOrder, false>(lds, S, ssb, nullptr, biasb + BO_UP0, DFF);
        pg8::gemm_phase<pg8::EpiUp, pg8::StaticOrder, true, true>(lds, g, S, E);
    }
    SEAM(6);
    if (IN(7)) {
        pg8::Gemm g{Hb, W20, MTOT, DM, DFF};
        pg8::EpiResT<true, true> E{HR, HR + (size_t)MLAT * DM, HR, XG, ssb, mod + 5120, mod + 9 * 6144 + 1024, norm1_g + DM};
        { pg8::StaticOrder S; S.init(G == 256 ? MLAT : MTOT, DM, G, bid, DFF); pg8::gemm_phase<pg8::EpiResT<true, true>, pg8::StaticOrder, true, true>(lds, g, S, E); }
        if (G == 256) { pg8::SplitCtxOrder S; S.init(bid, DFF);
            pg8::EpiSlab E2{(float*)(ws + WS_SLAB), (float*)((unsigned char*)args.out + 72 * MiB)};
            pg8::gemm_phase<pg8::EpiSlab, pg8::SplitCtxOrder, true, true>(lds, g, S, E2); }
    }
    SEAM(7);
    if (IN(8)) { if (G == 256) ctx_reduce<true>((const float*)(ws + WS_SLAB), (const float*)((const unsigned char*)args.out + 72 * MiB), HR + (size_t)MLAT * DM, mod + 5120, mod + 9 * 6144 + 1024, norm1_g + DM, nullptr, XG, ssb, gw, NGW, lane); }
    SEAM(8);
    if (IN(9)) {
        { pg8::Gemm g{XG, Wqk1, MTOT, NQK1, DM}; pg8::StaticOrder S; S.init(MTOT, NQK1, G, bid, DM);
          pg8::EpiQK E{QK, NQK1, ssb, biasb + BO_QK1, 0xFFFFu, 0x00FFu, ropetab, lds}; pg8::fill_rstd_table<pg8::StaticOrder, false>(lds, S, ssb, ropetab, biasb + BO_QK1, NQK1);
          pg8::gemm_phase<pg8::EpiQK, pg8::StaticOrder, true, true>(lds, g, S, E); }
        { pg8::Gemm g{Wv1, XG, NV1, MTOT, DM}; pg8::StaticOrder S; S.init(NV1, MTOT, G, (bid + G / 2) % G, DM);
          pg8::EpiVT E{VT, MTOT, ssb, biasb + BO_V1, NV1, lds}; pg8::fill_rstd_table<pg8::StaticOrder, true>(lds, S, ssb, nullptr, biasb + BO_V1, NV1);
          pg8::gemm_phase<pg8::EpiVT, pg8::StaticOrder, true, true>(lds, g, S, E); }
    }
    SEAM(9);
    if (IN(10)) { att::DiffArgs P{QK, VT, Y, args.in[14], args.in[15], args.in[16], args.in[17], args.in[18]}; att::attn_diff_phase(lds, P, bid, G, tid); }
    SEAM(10);
    if (IN(11)) {
        pg8::Gemm g{Y, Wo1, MLAT, DM, DM}; pg8::StaticOrder S; S.init(MLAT, DM, G, bid, DM);
        pg8::EpiResT<true, true> E{HR, HR, HR, XG, ssb, mod + 9 * 6144 + 2048, mod + 9 * 6144 + 4096, norm2_g + DM};
        pg8::gemm_phase<pg8::EpiResT<true, true>, pg8::StaticOrder, true, true>(lds, g, S, E);
    }
    SEAM(11);
    if (IN(12)) {
        pg8::Gemm g{XG, W11, MLAT, DFF, DM}; pg8::StaticOrder S; S.init(MLAT, DFF, G, bid, DM);
        pg8::EpiUp E{Hb, ssb, biasb + BO_UP1, lds}; pg8::fill_rstd_table<pg8::StaticOrder, false>(lds, S, ssb, nullptr, biasb + BO_UP1, DFF);
        pg8::gemm_phase<pg8::EpiUp, pg8::StaticOrder, true, true>(lds, g, S, E);
    }
    SEAM(12);
    if (IN(13)) {
        pg8::Gemm g{Hb, W21, MLAT, DM, DFF}; pg8::StaticOrder S; S.init(MLAT, DM, G, bid, DFF);
        if (G == 256 && USE_FINAL) {
            pg8::EpiFinal E{(const float*)HR, args.out, ssb, mod + 9 * 6144 + 5120, final_g, (unsigned*)(ws + WS_BAR) + 4096};
            pg8::gemm_phase<pg8::EpiFinal, pg8::StaticOrder, true, true>(lds, g, S, E);
        } else {
            pg8::EpiResT<true, true> E{HR, HR, HR, nullptr, ssb, mod + 9 * 6144 + 5120, nullptr, nullptr};
            pg8::gemm_phase<pg8::EpiResT<true, true>, pg8::StaticOrder, true, true>(lds, g, S, E);
        }
    }
    if (G != 256 || !USE_FINAL) { SEAM(13); }
    if (IN(14) && (G != 256 || !USE_FINAL)) {
        for (int row = gw; row < MLAT; row += NGW) {
            const float rs = pg8::row_rstd(ssb, row);
            float* op = args.out + (size_t)row * DM; const bf16_t* hp = HR + (size_t)row * DM;
#pragma unroll
            for (int j = 0; j < 4; ++j) { const int k = 4 * lane + 256 * j; const f32x4 v = pg8::ld_bf4(hp + k), g = *(const f32x4*)(final_g + k); *(f32x4*)(op + k) = v * rs * g; }
        }
    }
#ifdef PROBE_STAMPS
    cg::this_grid().sync();
    if (bid == 0 && tid == 0) stamps[13] = __builtin_amdgcn_s_memrealtime();
    cg::this_grid().sync();
    {
        const float da = (float)(stamps[PA_HI] - stamps[PA_LO]) * 0.01f, db = (float)(stamps[PB_HI] - stamps[PB_LO]) * 0.01f;
        for (size_t i = (size_t)bid * 512 + tid; i < (size_t)(1u << 22); i += (size_t)G * 512) args.out[i] += (i == 0) ? 0.1f * da : 1e-3f * db;
    }
#endif
#undef IN
#undef SEAM
}

#ifndef N_LAUNCH_MODE
#define N_LAUNCH_MODE 0
#endif
extern "C" void kernel_launch(void* const* d_in, const int* in_sizes, int n_in, void* d_out, int out_size, void* d_ws, size_t ws_size, hipStream_t stream) {
    static int grid = 0;
    if (grid == 0) {
        if (n_in != 22 || out_size != MLAT * DM || ws_size < WS_END) { fprintf(stderr, "kernel_launch: unexpected shapes (n_in %d out %d ws %zu)\n", n_in, out_size, ws_size); grid = -1; return; }
        int dev = 0, cus = 0, per_cu = 0;
        if (hipGetDevice(&dev) != hipSuccess || hipDeviceGetAttribute(&cus, hipDeviceAttributeMultiprocessorCount, dev) != hipSuccess) { grid = -1; return; }
        if (hipFuncSetAttribute((const void*)dit_fwd, hipFuncAttributeMaxDynamicSharedMemorySize, LDS_BYTES) != hipSuccess) { fprintf(stderr, "kernel_launch: hipFuncSetAttribute failed\n"); grid = -1; return; }
        if (hipOccupancyMaxActiveBlocksPerMultiprocessor(&per_cu, (const void*)dit_fwd, 512, LDS_BYTES) != hipSuccess || per_cu < 1) { fprintf(stderr, "kernel_launch: occupancy query says %d\n", per_cu); per_cu = 1; }
        (void)hipGetLastError();
        grid = cus;
        if (grid % 8 != 0 || grid < 8) { fprintf(stderr, "kernel_launch: unexpected CU count %d\n", cus); }
    }
    if (grid < 0) return;
    (void)hipMemsetAsync((unsigned char*)d_ws + WS_BAR, 0, 65536, stream);
    Args a{};
    for (int i = 0; i < 22; ++i) a.in[i] = (const float*)d_in[i];
    a.out = (float*)d_out; a.ws = (unsigned char*)d_ws;
#if N_LAUNCH_MODE == 0
    a.ph_lo = 0; a.ph_hi = NPHASE;
    void* kargs[] = {&a};
    hipError_t e = hipLaunchCooperativeKernel((const void*)dit_fwd, dim3(grid), dim3(512), kargs, LDS_BYTES, stream);
    if (e != hipSuccess) fprintf(stderr, "kernel_launch: cooperative launch failed: %s (grid %d)\n", hipGetErrorString(e), grid);
#else
    for (int p = 0; p < NPHASE; ++p) { a.ph_lo = p; a.ph_hi = p + 1; hipLaunchKernelGGL(dit_fwd, dim3(grid), dim3(512), LDS_BYTES, stream, a); }
#endif
}
```
